# Optimizing an MI355X kernel written in HIP

```python
import math
import jax, jax.numpy as jnp
from jax import lax
import numpy as np

D_MODEL = 2048
BATCH = 4
SEQ = 4096
DEPTH = 2

PLE_DIM = 256
SG_HEADS = 4
SG_HEAD_DIM = 128
SG_WIDTH = SG_HEADS * SG_HEAD_DIM
SG_CHUNK = 128
SC_GROUPS = 4
SC_GROUP_DIM = 128
SC_WIDTH = SC_GROUPS * SC_GROUP_DIM
SC_KERNEL = 3
GDN_HEADS = 8
GDN_HEAD_DIM = 128
GDN_WIDTH = GDN_HEADS * GDN_HEAD_DIM
GDN_CONV = 4
GDN_CHUNK = 64

MIX_WIDTH = SG_WIDTH + SC_WIDTH + GDN_WIDTH
D_FF = 4 * D_MODEL
EPS = 1e-6

IN_SIZES = (2 * SG_WIDTH, 3 * SC_WIDTH, 3 * GDN_WIDTH, GDN_WIDTH, GDN_HEADS, GDN_HEADS)
IN_COLS = int(sum(IN_SIZES))
IN_SPLITS = [int(s) for s in np.cumsum(IN_SIZES)[:-1]]

kernel_name = "hybrid_sgu_shortconv_gdn_block"


def rmsnorm(x, g):
    x32 = x.astype(jnp.float32)
    y = x32 * lax.rsqrt(jnp.mean(x32 * x32, axis=-1, keepdims=True) + EPS)
    return (y * g).astype(x.dtype)


def group_rmsnorm(x, g, n_groups):
    shp = x.shape
    xg = x.reshape(shp[:-1] + (n_groups, shp[-1] // n_groups))
    y = rmsnorm(xg, g.reshape(n_groups, shp[-1] // n_groups))
    return y.reshape(shp)


def layernorm(x, g, b):
    x32 = x.astype(jnp.float32)
    mu = jnp.mean(x32, axis=-1, keepdims=True)
    var = jnp.mean(jnp.square(x32 - mu), axis=-1, keepdims=True)
    return ((x32 - mu) * lax.rsqrt(var + EPS) * g + b).astype(x.dtype)


def causal_dwconv(x, w):
    K = w.shape[0]
    S = x.shape[1]
    xp = jnp.pad(x, ((0, 0), (K - 1, 0), (0, 0)))
    y = xp[:, 0:S] * w[0]
    for j in range(1, K):
        y = y + xp[:, j:j + S] * w[j]
    return y


def spatial_gating(u, v, ln_g, ln_b, w_s, b_s):
    Bsz, S, _ = v.shape
    nc = S // SG_CHUNK
    vh = v.reshape(Bsz, nc, SG_CHUNK, SG_HEADS, SG_HEAD_DIM)
    vh = layernorm(vh, ln_g.reshape(SG_HEADS, SG_HEAD_DIM), ln_b.reshape(SG_HEADS, SG_HEAD_DIM))
    w_causal = jnp.tril(w_s)
    f = jnp.einsum('hts,bnshd->bnthd', w_causal, vh) + jnp.transpose(b_s)[None, None, :, :, None]
    return u * f.reshape(Bsz, S, SG_WIDTH)


def gated_delta_chunked(q, k, v, g, beta):
    Bsz, S, H, Dk = q.shape
    Dv = v.shape[-1]
    L = GDN_CHUNK
    nc = S // L

    def chunk4(t):
        return t.reshape(Bsz, nc, L, H, t.shape[-1]).transpose(0, 3, 1, 2, 4)

    def chunk3(t):
        return t.reshape(Bsz, nc, L, H).transpose(0, 3, 1, 2)

    q = chunk4(q.astype(jnp.float32)) * (Dk ** -0.5)
    k = chunk4(k.astype(jnp.float32))
    v = chunk4(v.astype(jnp.float32))
    gc = jnp.cumsum(chunk3(g.astype(jnp.float32)), axis=-1)
    beta = chunk3(beta.astype(jnp.float32))

    incl = jnp.tril(jnp.ones((L, L), dtype=bool))
    strict = jnp.tril(jnp.ones((L, L), dtype=bool), -1)
    diff = gc[..., :, None] - gc[..., None, :]
    decay_incl = jnp.where(incl, jnp.exp(jnp.where(incl, diff, 0.0)), 0.0)
    decay_strict = jnp.where(strict, decay_incl, 0.0)

    kb = k * beta[..., None]
    vb = v * beta[..., None]
    A = jnp.einsum('bhnid,bhnjd->bhnij', kb, k) * decay_strict
    eye = jnp.eye(L, dtype=jnp.float32)
    rhs = jnp.concatenate([vb, kb * jnp.exp(gc)[..., None]], axis=-1)
    sol = lax.linalg.triangular_solve(A + eye, rhs, left_side=True, lower=True,
                                      transpose_a=False, conjugate_a=False, unit_diagonal=True)
    value, kcd = sol[..., :Dv], sol[..., Dv:]

    intra = jnp.einsum('bhnid,bhnjd->bhnij', q, k) * decay_incl
    q_exp = q * jnp.exp(gc)[..., None]
    k_tail = k * jnp.exp(gc[..., -1:] - gc)[..., None]
    g_last = jnp.exp(gc[..., -1])

    def step(state, inp):
        qe, kc, val, intra_c, kt, gl = inp
        v_new = val - jnp.einsum('bhld,bhdv->bhlv', kc, state)
        o = jnp.einsum('bhld,bhdv->bhlv', qe, state) + jnp.einsum('bhij,bhjv->bhiv', intra_c, v_new)
        state = state * gl[..., None, None] + jnp.einsum('bhld,bhlv->bhdv', kt, v_new)
        return state, o

    xs = (jnp.moveaxis(q_exp, 2, 0), jnp.moveaxis(kcd, 2, 0), jnp.moveaxis(value, 2, 0),
          jnp.moveaxis(intra, 2, 0), jnp.moveaxis(k_tail, 2, 0), jnp.moveaxis(g_last, 2, 0))
    s0 = jnp.zeros((Bsz, H, Dk, Dv), jnp.float32)
    _, o = lax.scan(step, s0, xs)
    return o.transpose(1, 0, 3, 2, 4).reshape(Bsz, S, H, Dv)


def l2norm(x):
    x32 = x.astype(jnp.float32)
    return x32 * lax.rsqrt(jnp.sum(x32 * x32, axis=-1, keepdims=True) + EPS)


def hybrid_layer(h, p_i, norm_mix, w_in, sg_ln_g, sg_ln_b, sg_w, sg_b, sc_conv, gdn_conv,
                 gdn_a_log, gdn_dt_bias, gdn_norm, out_norm_a, out_norm_b, w_o, norm_ffn,
                 w_ff1, w_ff2, norm_ple, w_ple_gate, w_ple_proj):
    Bsz, S, _ = h.shape
    xn = rmsnorm(h, norm_mix)
    proj = xn @ w_in
    sg_uv, sc_bcx, gdn_qkv, gdn_z, gdn_a, gdn_b = jnp.split(proj, IN_SPLITS, axis=-1)

    u, v = jnp.split(jax.nn.gelu(sg_uv), 2, axis=-1)
    ya = spatial_gating(u, v, sg_ln_g, sg_ln_b, sg_w, sg_b)
    ya = group_rmsnorm(ya, out_norm_a, SG_HEADS)

    gb, gc_, xin = jnp.split(sc_bcx, 3, axis=-1)
    yb = gb * causal_dwconv(gc_ * xin, sc_conv)
    yb = group_rmsnorm(yb, out_norm_b, SC_GROUPS)

    qkv = jax.nn.silu(causal_dwconv(gdn_qkv, gdn_conv))
    q, k, vv = jnp.split(qkv, 3, axis=-1)
    q = l2norm(q.reshape(Bsz, S, GDN_HEADS, GDN_HEAD_DIM))
    k = l2norm(k.reshape(Bsz, S, GDN_HEADS, GDN_HEAD_DIM))
    vv = vv.reshape(Bsz, S, GDN_HEADS, GDN_HEAD_DIM)
    g = -jnp.exp(gdn_a_log.astype(jnp.float32)) * jax.nn.softplus(
        gdn_a.astype(jnp.float32) + gdn_dt_bias.astype(jnp.float32))
    beta = jax.nn.sigmoid(gdn_b.astype(jnp.float32))
    o = gated_delta_chunked(q, k, vv, g, beta)
    z = gdn_z.reshape(Bsz, S, GDN_HEADS, GDN_HEAD_DIM).astype(jnp.float32)
    yc = (rmsnorm(o, gdn_norm) * jax.nn.silu(z)).reshape(Bsz, S, GDN_WIDTH).astype(h.dtype)

    h = h + jnp.concatenate([ya, yb, yc], axis=-1) @ w_o

    hn = rmsnorm(h, norm_ffn)
    h = h + jnp.square(jax.nn.relu(hn @ w_ff1)) @ w_ff2

    hn = rmsnorm(h, norm_ple)
    h = h + (p_i @ w_ple_proj) * jax.nn.sigmoid(hn @ w_ple_gate)
    return h


def setup_inputs(seed: int = 0) -> dict:
    key = jax.random.key(seed)
    ks = jax.random.split(key, 24)

    def nrm(k, shape, scale):
        return jax.random.normal(k, shape, jnp.float32) * scale

    def gain(k, w):
        return 1.0 + nrm(k, (DEPTH, w), 0.02)

    dt = jnp.exp(jax.random.uniform(ks[11], (DEPTH, GDN_HEADS), jnp.float32,
                                    math.log(1e-3), math.log(1e-1)))
    return {
        "x": nrm(ks[0], (BATCH, SEQ, D_MODEL), 1.0),
        "p": nrm(ks[1], (DEPTH, BATCH, SEQ, PLE_DIM), 1.0),
        "norm_mix": gain(ks[2], D_MODEL),
        "w_in": nrm(ks[3], (DEPTH, D_MODEL, IN_COLS), D_MODEL ** -0.5),
        "sg_ln_g": gain(ks[4], SG_WIDTH),
        "sg_ln_b": nrm(ks[5], (DEPTH, SG_WIDTH), 0.02),
        "sg_w": nrm(ks[6], (DEPTH, SG_HEADS, SG_CHUNK, SG_CHUNK), 0.5 * SG_CHUNK ** -0.5),
        "sg_b": 1.0 + nrm(ks[7], (DEPTH, SG_HEADS, SG_CHUNK), 0.1),
        "sc_conv": nrm(ks[8], (DEPTH, SC_KERNEL, SC_WIDTH), SC_KERNEL ** -0.5),
        "gdn_conv": nrm(ks[9], (DEPTH, GDN_CONV, 3 * GDN_WIDTH), GDN_CONV ** -0.5),
        "gdn_a_log": jnp.log(jax.random.uniform(ks[10], (DEPTH, GDN_HEADS), jnp.float32, 1.0, 16.0)),
        "gdn_dt_bias": dt + jnp.log(-jnp.expm1(-dt)),
        "gdn_norm": gain(ks[12], GDN_HEAD_DIM),
        "out_norm_a": gain(ks[13], SG_WIDTH),
        "out_norm_b": gain(ks[14], SC_WIDTH),
        "w_o": nrm(ks[15], (DEPTH, MIX_WIDTH, D_MODEL), MIX_WIDTH ** -0.5),
        "norm_ffn": gain(ks[16], D_MODEL),
        "w_ff1": nrm(ks[17], (DEPTH, D_MODEL, D_FF), D_MODEL ** -0.5),
        "w_ff2": nrm(ks[18], (DEPTH, D_FF, D_MODEL), D_FF ** -0.5),
        "norm_ple": gain(ks[19], D_MODEL),
        "w_ple_gate": nrm(ks[20], (DEPTH, D_MODEL, D_MODEL), D_MODEL ** -0.5),
        "w_ple_proj": nrm(ks[21], (DEPTH, PLE_DIM, D_MODEL), PLE_DIM ** -0.5),
        "norm_final": 1.0 + nrm(ks[22], (D_MODEL,), 0.02),
    }


def reference(x, p, norm_mix, w_in, sg_ln_g, sg_ln_b, sg_w, sg_b, sc_conv, gdn_conv,
              gdn_a_log, gdn_dt_bias, gdn_norm, out_norm_a, out_norm_b, w_o, norm_ffn,
              w_ff1, w_ff2, norm_ple, w_ple_gate, w_ple_proj, norm_final):
    h = x
    for i in range(DEPTH):
        h = hybrid_layer(h, p[i], norm_mix[i], w_in[i], sg_ln_g[i], sg_ln_b[i], sg_w[i], sg_b[i],
                         sc_conv[i], gdn_conv[i], gdn_a_log[i], gdn_dt_bias[i], gdn_norm[i],
                         out_norm_a[i], out_norm_b[i], w_o[i], norm_ffn[i], w_ff1[i], w_ff2[i],
                         norm_ple[i], w_ple_gate[i], w_ple_proj[i])
    return rmsnorm(h, norm_final)
```

```cpp
#include <hip/hip_runtime.h>
#include <hip/hip_cooperative_groups.h>
#include <cstdio>
#include <cstdint>
#include <cstddef>
namespace cg = cooperative_groups;

#ifndef MK_COOP
#define MK_COOP 0
#endif

#define LAS __attribute__((address_space(3)))
typedef unsigned short bf16_t;
typedef short bf16x8 __attribute__((ext_vector_type(8)));
typedef float f32x4 __attribute__((ext_vector_type(4)));
typedef float f32x2 __attribute__((ext_vector_type(2)));
typedef unsigned u32x4 __attribute__((ext_vector_type(4)));
typedef unsigned u32x2 __attribute__((ext_vector_type(2)));

namespace pg8 {
constexpr int BM = 256, BK = 64, HALF = 128, HTB = HALF * BK * 2, STAGE_BYTES = 8 * HTB, NXCD = 8, WGM = 8;
__host__ __device__ __forceinline__ int lds_byte(int r, int c) { const int st = (r >> 4) * 2 + (c >> 5), rr = r & 15, cc = c & 31, ob = rr * 64 + cc * 2; return st * 1024 + (ob ^ (((ob >> 9) & 1) << 5)); }
__host__ __device__ __forceinline__ void stage_rc(int b, int& R, int& C) { const int st = b / 1024, sb = b % 1024, swz = sb ^ (((sb >> 9) & 1) << 5); R = (st >> 1) * 16 + swz / 64; C = (st & 1) * 32 + (swz % 64) / 2; }
__host__ __device__ __forceinline__ int perm32(int rho) { const int n = rho >> 4, i = rho & 15; return 8 * (i >> 2) + 4 * n + (i & 3); }

struct Unit { int pm, pn; };
struct Gemm { const bf16_t* A; const bf16_t* Bt; int M, N, K; };

struct StaticOrder {
    int nM, nN, nwg, G, c;
    __host__ __device__ void init(int M, int N, int G_, int c_) { nM = M / BM; nN = N / BM; nwg = nM * nN; G = G_; c = c_; }
    __host__ __device__ bool next(int i, Unit& u) const {
        const long L = (long)i * G + c; if (L >= nwg) return false;
        int wgid = (int)L; { const int q = nwg / NXCD, r = nwg % NXCD, xcd = wgid % NXCD, off = wgid / NXCD; wgid = (xcd < r ? xcd * (q + 1) : r * (q + 1) + (xcd - r) * q) + off; }
        const int nig = WGM * nN, gid = wgid / nig, fm = gid * WGM, gsz = (nM - fm) < WGM ? (nM - fm) : WGM;
        u.pm = fm + ((wgid % nig) % gsz); u.pn = (wgid % nig) / gsz; return true;
    }
};

__device__ __forceinline__ unsigned cvt_pk_bf16(float lo, float hi) { unsigned r; asm volatile("v_cvt_pk_bf16_f32 %0, %1, %2" : "=v"(r) : "v"(lo), "v"(hi)); return r; }

template <class Epi>
__device__ __forceinline__ void gemm_phase(LAS unsigned char* lds, const Gemm g, const StaticOrder& S, const Epi& E, const int tid) {
    const int wid = __builtin_amdgcn_readfirstlane(tid >> 6), lane = tid & 63, wr = wid >> 2, wc = wid & 3, fr = lane & 15, fq = lane >> 4;
    int K_ = g.K; asm volatile("" : "+s"(K_)); const int K = K_, nt = K / BK;
    unsigned voffA[2], voffB[2];
#pragma unroll
    for (int i = 0; i < 2; ++i) { int R, C; stage_rc(tid * 16 + i * 8192, R, C); const int Rb = (R & ~31) + perm32(R & 31);
        voffA[i] = (unsigned)(R * K + C) * 2u; voffB[i] = (unsigned)(Rb * K + C) * 2u; }
    const size_t kstep = (size_t)(BK * 2);
    const size_t hstep = (size_t)HALF * K * 2;
    const size_t tstep = 2 * hstep;
    const unsigned ldsw = (unsigned)wid * 1024u;
    const int aoff = lds_byte(wr * 64 + fr, fq * 8), boff = lds_byte(wc * 32 + fr, fq * 8);
#define PG8_SA(b, h) (((b) * 2 + (h)) * HTB)
#define PG8_SB(b, h) ((4 + (b) * 2 + (h)) * HTB)
#define PG8_STAGE(bufoff, gbase, voff) do { _Pragma("unroll") for (int _i = 0; _i < 2; ++_i) \
        __builtin_amdgcn_global_load_lds((const unsigned*)((const char*)(gbase) + (voff)[_i]), (LAS unsigned*)(lds + (bufoff) + ldsw + _i * 8192), 16, 0, 0); } while (0)
#define PG8_LDA(dst, b, h) do { _Pragma("unroll") for (int m = 0; m < 4; ++m) _Pragma("unroll") for (int k = 0; k < 2; ++k) dst[m][k] = *(const LAS bf16x8*)(lds + PG8_SA(b, h) + aoff + m * 2048 + k * 1024); } while (0)
#define PG8_LDB(dst, b, h) do { _Pragma("unroll") for (int n = 0; n < 2; ++n) _Pragma("unroll") for (int k = 0; k < 2; ++k) dst[n][k] = *(const LAS bf16x8*)(lds + PG8_SB(b, h) + boff + n * 2048 + k * 1024); } while (0)
#define PG8_MMA(ai, bj, At, Bt) do { __builtin_amdgcn_s_setprio(1); _Pragma("unroll") for (int m = 0; m < 4; ++m) _Pragma("unroll") for (int n = 0; n < 2; ++n) _Pragma("unroll") for (int k = 0; k < 2; ++k) \
        acc[ai][bj][m][n] = __builtin_amdgcn_mfma_f32_16x16x32_bf16(Bt[n][k], At[m][k], acc[ai][bj][m][n], 0, 0, 0); __builtin_amdgcn_s_setprio(0); } while (0)
#define PG8_WAIT_V(n) asm volatile("s_waitcnt vmcnt(" #n ")" ::: "memory")
#define PG8_WAIT_L(n) asm volatile("s_waitcnt lgkmcnt(" #n ")" ::: "memory")
#define PG8_BAR __builtin_amdgcn_s_barrier()
#define PG8_SCHED __builtin_amdgcn_sched_barrier(0)
    Unit cur, nxt; int ui = 0;
    if (!S.next(0, cur)) return;
    f32x4 acc[2][2][4][2];
#pragma unroll
    for (int a = 0; a < 2; ++a)
#pragma unroll
        for (int b = 0; b < 2; ++b)
#pragma unroll
            for (int m = 0; m < 4; ++m)
#pragma unroll
                for (int n = 0; n < 2; ++n) acc[a][b][m][n] = (f32x4){0.f, 0.f, 0.f, 0.f};
    bf16x8 At[4][2], B0[2][2], B1[2][2];
    const char* cA = (const char*)g.A + (size_t)cur.pm * tstep; const char* cB = (const char*)g.Bt + (size_t)cur.pn * tstep;
    PG8_STAGE(PG8_SB(0, 0), cB, voffB); PG8_STAGE(PG8_SB(0, 1), cB + hstep, voffB); PG8_STAGE(PG8_SA(0, 0), cA, voffA); PG8_STAGE(PG8_SA(0, 1), cA + hstep, voffA);
    if (wr == 1) PG8_BAR;
    PG8_WAIT_V(2); PG8_BAR;
    PG8_STAGE(PG8_SB(1, 0), cB + kstep, voffB); PG8_STAGE(PG8_SA(1, 0), cA + kstep, voffA); PG8_STAGE(PG8_SB(1, 1), cB + hstep + kstep, voffB);
    PG8_WAIT_V(6); PG8_BAR;
    for (;;) {
        const bool has_next = S.next(ui + 1, nxt);
        const char* nA = has_next ? (const char*)g.A + (size_t)nxt.pm * tstep : cA; const char* nB = has_next ? (const char*)g.Bt + (size_t)nxt.pn * tstep : cB;
        for (int t = 0; t < nt; t += 2) {
            const bool last = (t == nt - 2);
            const char* a1 = cA + (size_t)(t + 1) * kstep;
            const char* a2 = last ? nA : cA + (size_t)(t + 2) * kstep; const char* b2 = last ? nB : cB + (size_t)(t + 2) * kstep;
            const char* a3 = a2 + kstep; const char* b3 = b2 + kstep;
            PG8_LDB(B0, 0, 0); PG8_LDB(B1, 0, 1); PG8_SCHED; PG8_LDA(At, 0, 0); PG8_STAGE(PG8_SA(1, 1), a1 + hstep, voffA);
            PG8_WAIT_V(8); PG8_WAIT_L(0); PG8_BAR; PG8_MMA(0, 0, At, B0); PG8_MMA(0, 1, At, B1); PG8_BAR; PG8_SCHED;
            PG8_LDA(At, 0, 1); PG8_STAGE(PG8_SB(0, 0), b2, voffB); PG8_STAGE(PG8_SB(0, 1), b2 + hstep, voffB); PG8_STAGE(PG8_SA(0, 0), a2, voffA);
            PG8_WAIT_V(8); PG8_WAIT_L(0); PG8_BAR; PG8_MMA(1, 0, At, B0); PG8_MMA(1, 1, At, B1); PG8_BAR; PG8_SCHED;
            PG8_LDB(B0, 1, 0); PG8_LDB(B1, 1, 1); PG8_SCHED; PG8_LDA(At, 1, 0); PG8_STAGE(PG8_SA(0, 1), a2 + hstep, voffA);
            PG8_WAIT_V(8); PG8_WAIT_L(0); PG8_BAR; PG8_MMA(0, 0, At, B0); PG8_MMA(0, 1, At, B1); PG8_BAR; PG8_SCHED;
            PG8_LDA(At, 1, 1); PG8_STAGE(PG8_SB(1, 0), b3, voffB); PG8_STAGE(PG8_SB(1, 1), b3 + hstep, voffB); PG8_STAGE(PG8_SA(1, 0), a3, voffA);
            PG8_WAIT_V(8); PG8_WAIT_L(0); PG8_BAR; PG8_MMA(1, 0, At, B0); PG8_MMA(1, 1, At, B1); PG8_BAR; PG8_SCHED;
        }
        if (wr == 0) PG8_BAR;
        E(acc, cur, wr, wc, fr, fq);
        if (!has_next) break;
#pragma unroll
        for (int a = 0; a < 2; ++a)
#pragma unroll
            for (int b = 0; b < 2; ++b)
#pragma unroll
                for (int m = 0; m < 4; ++m)
#pragma unroll
                    for (int n = 0; n < 2; ++n) acc[a][b][m][n] = (f32x4){0.f, 0.f, 0.f, 0.f};
        cur = nxt; cA = nA; cB = nB; ++ui;
        if (wr == 1) PG8_BAR;
    }
    PG8_WAIT_V(0);
    PG8_BAR;
#undef PG8_SA
#undef PG8_SB
#undef PG8_STAGE
#undef PG8_LDA
#undef PG8_LDB
#undef PG8_MMA
#undef PG8_WAIT_V
#undef PG8_WAIT_L
#undef PG8_BAR
#undef PG8_SCHED
}
}

constexpr int TOK = 16384, DM = 2048, SEQL = 4096, FFD = 8192, PLE = 256;
constexpr int INC = 6672, INP = 6912, PJ = 6656;
constexpr int C_U = 0, C_V = 512, C_GB = 1024, C_GC = 1536, C_XI = 2048, C_Q = 2560, C_Z = 5632;
constexpr float EPSF = 1e-6f;
constexpr int NTHREADS = 512, NWAVES = 8;
constexpr int LDS_BYTES = 147456;

constexpr size_t WS_AB = 0;
constexpr size_t WS_GL = 1048576;
constexpr size_t WS_WIN = 2097152;
constexpr size_t WS_WO = WS_WIN + (size_t)INP * DM * 2;
constexpr size_t WS_W1 = WS_WO + (size_t)DM * DM * 2;
constexpr size_t WS_W2 = WS_W1 + (size_t)FFD * DM * 2;
constexpr size_t WS_WG = WS_W2 + (size_t)FFD * DM * 2;
constexpr size_t WS_WP = WS_WG + (size_t)DM * DM * 2;
constexpr size_t WS_P16 = WS_WP + (size_t)DM * PLE * 2;
constexpr size_t WS_XN = WS_P16 + (size_t)TOK * PLE * 2;
constexpr size_t WS_BIG = WS_XN + (size_t)TOK * DM * 2;
constexpr size_t WS_GDN = WS_BIG + (size_t)TOK * FFD * 2;
constexpr size_t GDN_ITEM = 73728;
constexpr size_t WS_END = WS_GDN + 2048 * GDN_ITEM;

struct Args {
    const float *x, *p, *norm_mix, *w_in, *sg_ln_g, *sg_ln_b, *sg_w, *sg_b, *sc_conv, *gdn_conv, *gdn_a_log, *gdn_dt_bias, *gdn_norm,
        *out_norm_a, *out_norm_b, *w_o, *norm_ffn, *w_ff1, *w_ff2, *norm_ple, *w_ple_gate, *w_ple_proj, *norm_final;
    float* out; unsigned char* ws; int ph_lo, ph_hi, coop, pad;
};

__device__ __forceinline__ unsigned pk2(float lo, float hi) { return pg8::cvt_pk_bf16(lo, hi); }
__device__ __forceinline__ float bf2f(unsigned short v) { return __uint_as_float((unsigned)v << 16); }
__device__ __forceinline__ float bflo(unsigned w) { return __uint_as_float(w << 16); }
__device__ __forceinline__ float bfhi(unsigned w) { return __uint_as_float(w & 0xffff0000u); }
__device__ __forceinline__ float wave_sum(float v) {
#pragma unroll
    for (int o = 1; o < 64; o <<= 1) v += __shfl_xor(v, o);
    return v;
}
__device__ __forceinline__ float sigmoidf_(float x) { return 1.0f / (1.0f + __expf(-x)); }
__device__ __forceinline__ float gelu_tanh(float x) { const float y = 1.5957691216057308f * x * (1.0f + 0.044715f * x * x); return x / (1.0f + __expf(-y)); }
__device__ __forceinline__ bf16x8 pack8(const f32x4 a, const f32x4 b) {
    u32x4 w; w.x = pk2(a[0], a[1]); w.y = pk2(a[2], a[3]); w.z = pk2(b[0], b[1]); w.w = pk2(b[2], b[3]);
    return __builtin_bit_cast(bf16x8, w);
}
__host__ __device__ __forceinline__ int kperm(int d) { return (d & ~31) + 8 * ((d >> 2) & 3) + 4 * ((d >> 4) & 1) + (d & 3); }
#define LDS_WAIT() asm volatile("s_waitcnt lgkmcnt(0)" ::: "memory")

#define EPI_LOOP_BEGIN  _Pragma("unroll") for (int ai = 0; ai < 2; ++ai) _Pragma("unroll") for (int m = 0; m < 4; ++m) { const int row = u.pm * 256 + ai * 128 + wr * 64 + m * 16 + fr; \
                        _Pragma("unroll") for (int bj = 0; bj < 2; ++bj) { const int col = u.pn * 256 + bj * 128 + wc * 32 + 8 * fq; f32x4 v0 = acc[ai][bj][m][0], v1 = acc[ai][bj][m][1];
#define EPI_LOOP_END    } }
#define EPI_ARGS const f32x4 (&acc)[2][2][4][2], const pg8::Unit& u, int wr, int wc, int fr, int fq

struct EpiProj {
    bf16_t* P; float* AB;
    __device__ __forceinline__ void operator()(EPI_ARGS) const {
        if (u.pn < 26) {
            const bool act = u.pn < 4;
            EPI_LOOP_BEGIN
                if (act) {
#pragma unroll
                    for (int e = 0; e < 4; ++e) { v0[e] = gelu_tanh(v0[e]); v1[e] = gelu_tanh(v1[e]); }
                }
                u32x4 w; w.x = pk2(v0[0], v0[1]); w.y = pk2(v0[2], v0[3]); w.z = pk2(v1[0], v1[1]); w.w = pk2(v1[2], v1[3]);
                *(u32x4*)(P + (size_t)row * PJ + col) = w;
            EPI_LOOP_END
        } else {
            if (wc == 0 && fq < 2) {
#pragma unroll
                for (int ai = 0; ai < 2; ++ai)
#pragma unroll
                    for (int m = 0; m < 4; ++m) { const int row = u.pm * 256 + ai * 128 + wr * 64 + m * 16 + fr;
                        *(f32x4*)(AB + (size_t)row * 16 + 8 * fq) = acc[ai][0][m][0]; *(f32x4*)(AB + (size_t)row * 16 + 8 * fq + 4) = acc[ai][0][m][1]; }
            }
        }
    }
};
struct EpiRes {
    const float* base; float* out;
    __device__ __forceinline__ void operator()(EPI_ARGS) const {
        EPI_LOOP_BEGIN
            const size_t off = (size_t)row * DM + col;
            const f32x4 b0 = *(const f32x4*)(base + off), b1 = *(const f32x4*)(base + off + 4);
            *(f32x4*)(out + off) = b0 + v0; *(f32x4*)(out + off + 4) = b1 + v1;
        EPI_LOOP_END
    }
};
struct EpiRelu2 {
    bf16_t* O;
    __device__ __forceinline__ void operator()(EPI_ARGS) const {
        EPI_LOOP_BEGIN
#pragma unroll
            for (int e = 0; e < 4; ++e) { const float a = fmaxf(v0[e], 0.f), b = fmaxf(v1[e], 0.f); v0[e] = a * a; v1[e] = b * b; }
            u32x4 w; w.x = pk2(v0[0], v0[1]); w.y = pk2(v0[2], v0[3]); w.z = pk2(v1[0], v1[1]); w.w = pk2(v1[2], v1[3]);
            *(u32x4*)(O + (size_t)row * FFD + col) = w;
        EPI_LOOP_END
    }
};
struct EpiPlain {
    bf16_t* O;
    __device__ __forceinline__ void operator()(EPI_ARGS) const {
        EPI_LOOP_BEGIN
            u32x4 w; w.x = pk2(v0[0], v0[1]); w.y = pk2(v0[2], v0[3]); w.z = pk2(v1[0], v1[1]); w.w = pk2(v1[2], v1[3]);
            *(u32x4*)(O + (size_t)row * DM + col) = w;
        EPI_LOOP_END
    }
};
struct EpiGate {
    const bf16_t* PP; float* out;
    __device__ __forceinline__ void operator()(EPI_ARGS) const {
        EPI_LOOP_BEGIN
            const size_t off = (size_t)row * DM + col;
            const u32x4 pw = *(const u32x4*)(PP + off);
            const f32x4 b0 = *(const f32x4*)(out + off), b1 = *(const f32x4*)(out + off + 4);
            f32x4 o0, o1;
            o0[0] = b0[0] + bflo(pw.x) * sigmoidf_(v0[0]); o0[1] = b0[1] + bfhi(pw.x) * sigmoidf_(v0[1]);
            o0[2] = b0[2] + bflo(pw.y) * sigmoidf_(v0[2]); o0[3] = b0[3] + bfhi(pw.y) * sigmoidf_(v0[3]);
            o1[0] = b1[0] + bflo(pw.z) * sigmoidf_(v1[0]); o1[1] = b1[1] + bfhi(pw.z) * sigmoidf_(v1[1]);
            o1[2] = b1[2] + bflo(pw.w) * sigmoidf_(v1[2]); o1[3] = b1[3] + bfhi(pw.w) * sigmoidf_(v1[3]);
            *(f32x4*)(out + off) = o0; *(f32x4*)(out + off + 4) = o1;
        EPI_LOOP_END
    }
};

__device__ __forceinline__ void transpose_item(const float* W, int K, int N, int Npad, bf16_t* WT, LAS float* scr, int item, int lane) {
    const int nblk = Npad / 32, kb = item / nblk, nb = item % nblk, k0 = 64 * kb, n0 = 32 * nb;
    const int nn = n0 + (lane & 31); const bool ok = nn < N;
#pragma unroll 8
    for (int i = 0; i < 32; ++i) { const int kk = 2 * i + (lane >> 5); scr[kk * 33 + (lane & 31)] = ok ? W[(size_t)(k0 + kk) * N + nn] : 0.f; }
    LDS_WAIT(); asm volatile("" ::: "memory");
    const int c = lane & 7;
#pragma unroll
    for (int j = 0; j < 4; ++j) { const int n = (lane >> 3) + 8 * j; const LAS float* s = scr + (8 * c) * 33 + n;
        u32x4 o; o.x = pk2(s[0 * 33], s[1 * 33]); o.y = pk2(s[2 * 33], s[3 * 33]); o.z = pk2(s[4 * 33], s[5 * 33]); o.w = pk2(s[6 * 33], s[7 * 33]);
        *(u32x4*)(WT + (size_t)(n0 + n) * K + k0 + 8 * c) = o; }
    LDS_WAIT(); asm volatile("" ::: "memory");
}
__device__ __forceinline__ void rms_row_bf16(const float* xrow, const float* g, bf16_t* orow, int lane) {
    const f32x4* xr = (const f32x4*)xrow + lane; const f32x4* gr = (const f32x4*)g + lane;
    f32x4 v[8]; float s = 0.f;
#pragma unroll
    for (int j = 0; j < 8; ++j) { v[j] = xr[64 * j]; s += (v[j][0] * v[j][0] + v[j][1] * v[j][1]) + (v[j][2] * v[j][2] + v[j][3] * v[j][3]); }
    const float rstd = 1.0f / sqrtf(wave_sum(s) * (1.0f / DM) + EPSF);
    u32x2* o8 = (u32x2*)orow + lane;
#pragma unroll
    for (int j = 0; j < 8; ++j) { const f32x4 gg = gr[64 * j]; u32x2 w; w.x = pk2(v[j][0] * rstd * gg[0], v[j][1] * rstd * gg[1]); w.y = pk2(v[j][2] * rstd * gg[2], v[j][3] * rstd * gg[3]); o8[64 * j] = w; }
}
__device__ __forceinline__ void rms_row_f32(const float* xrow, const float* g, float* orow, int lane) {
    const f32x4* xr = (const f32x4*)xrow + lane; const f32x4* gr = (const f32x4*)g + lane;
    f32x4 v[8]; float s = 0.f;
#pragma unroll
    for (int j = 0; j < 8; ++j) { v[j] = xr[64 * j]; s += (v[j][0] * v[j][0] + v[j][1] * v[j][1]) + (v[j][2] * v[j][2] + v[j][3] * v[j][3]); }
    const float rstd = 1.0f / sqrtf(wave_sum(s) * (1.0f / DM) + EPSF);
    f32x4* o = (f32x4*)orow + lane;
#pragma unroll
    for (int j = 0; j < 8; ++j) { const f32x4 gg = gr[64 * j]; o[64 * j] = v[j] * rstd * gg; }
}

__device__ __forceinline__ void gdn_chunk_item(LAS unsigned char* L, int item, const bf16_t* P, const float* AB, const float* convw, const float* a_log, const float* dt_bias,
                                               unsigned char* GDN, float* GL, int tid) {
    const int n = item & 63, bh = item >> 6, h = bh & 7, b = bh >> 3;
    const int tok0 = b * SEQL + n * 64;
    const int wave = tid >> 6, lane = tid & 63, q4 = lane >> 4, c15 = lane & 15;
    LAS bf16_t* Kb = (LAS bf16_t*)(L);
    LAS bf16_t* Qb = (LAS bf16_t*)(L + 17408);
    LAS float* Af = (LAS float*)(L + 34816);
    LAS float* X = (LAS float*)(L + 51200);
    LAS float* gcs = (LAS float*)(L + 116736);
    LAS float* bts = gcs + 64;
    LAS float* egc = gcs + 128;
    unsigned char* gbase = GDN + (size_t)item * GDN_ITEM;
    bf16_t* g_qexp = (bf16_t*)gbase; bf16_t* g_kcd = (bf16_t*)(gbase + 16384); bf16_t* g_ktT = (bf16_t*)(gbase + 32768);
    bf16_t* g_valT = (bf16_t*)(gbase + 49152); bf16_t* g_intra = (bf16_t*)(gbase + 65536);

    if (wave == 0) {
        const float a = AB[(size_t)(tok0 + lane) * 16 + h], bb = AB[(size_t)(tok0 + lane) * 16 + 8 + h];
        const float xs = a + dt_bias[h];
        const float sp = xs > 20.f ? xs : log1pf(__expf(xs));
        float c = -__expf(a_log[h]) * sp;
#pragma unroll
        for (int o = 1; o < 64; o <<= 1) { const float t = __shfl_up(c, o); if (lane >= o) c += t; }
        gcs[lane] = c; bts[lane] = sigmoidf_(bb); egc[lane] = __expf(c);
    }
    __syncthreads();
    if (wave < 6) {
        const int cgi = tid % 48, seg = tid / 48, which = cgi >> 4, cc = (cgi & 15) * 8;
        const int col = C_Q + which * 1024 + h * 128 + cc;
        float w[4][8];
#pragma unroll
        for (int j = 0; j < 4; ++j) { const f32x4 a = *(const f32x4*)(convw + j * 3072 + which * 1024 + h * 128 + cc), bq = *(const f32x4*)(convw + j * 3072 + which * 1024 + h * 128 + cc + 4);
            w[j][0] = a[0]; w[j][1] = a[1]; w[j][2] = a[2]; w[j][3] = a[3]; w[j][4] = bq[0]; w[j][5] = bq[1]; w[j][6] = bq[2]; w[j][7] = bq[3]; }
        float x0[8], x1[8], x2[8], x3[8];
        auto ldrow = [&](int r, float (&dst)[8]) {
            if (n * 64 + r >= 0) { const u32x4 v = *(const u32x4*)(P + (size_t)(tok0 + r) * PJ + col);
                dst[0] = bflo(v.x); dst[1] = bfhi(v.x); dst[2] = bflo(v.y); dst[3] = bfhi(v.y); dst[4] = bflo(v.z); dst[5] = bfhi(v.z); dst[6] = bflo(v.w); dst[7] = bfhi(v.w); }
            else {
#pragma unroll
                for (int e = 0; e < 8; ++e) dst[e] = 0.f; }
        };
        ldrow(seg * 8 - 3, x0); ldrow(seg * 8 - 2, x1); ldrow(seg * 8 - 1, x2);
#pragma unroll
        for (int i = 0; i < 8; ++i) {
            const int t = seg * 8 + i;
            ldrow(t, x3);
            float y[8]; float ss = 0.f;
#pragma unroll
            for (int e = 0; e < 8; ++e) { const float c = w[0][e] * x0[e] + w[1][e] * x1[e] + w[2][e] * x2[e] + w[3][e] * x3[e]; y[e] = c * sigmoidf_(c); ss += y[e] * y[e]; }
            ss += __shfl_xor(ss, 1); ss += __shfl_xor(ss, 2); ss += __shfl_xor(ss, 4); ss += __shfl_xor(ss, 8);
            const float rn = 1.0f / sqrtf(ss + EPSF);
            const float bt = bts[t], eg = egc[t];
            if (which == 0) {
                const float s = rn * 0.08838834764831845f;
                u32x4 o; o.x = pk2(y[0] * s, y[1] * s); o.y = pk2(y[2] * s, y[3] * s); o.z = pk2(y[4] * s, y[5] * s); o.w = pk2(y[6] * s, y[7] * s);
                *(LAS u32x4*)(Qb + t * 136 + cc) = o;
            } else if (which == 1) {
                u32x4 o; o.x = pk2(y[0] * rn, y[1] * rn); o.y = pk2(y[2] * rn, y[3] * rn); o.z = pk2(y[4] * rn, y[5] * rn); o.w = pk2(y[6] * rn, y[7] * rn);
                *(LAS u32x4*)(Kb + t * 136 + cc) = o;
                const float s = rn * bt * eg;
                *(LAS f32x4*)(X + t * 256 + 128 + cc) = (f32x4){y[0] * s, y[1] * s, y[2] * s, y[3] * s};
                *(LAS f32x4*)(X + t * 256 + 128 + cc + 4) = (f32x4){y[4] * s, y[5] * s, y[6] * s, y[7] * s};
            } else {
                *(LAS f32x4*)(X + t * 256 + cc) = (f32x4){y[0] * bt, y[1] * bt, y[2] * bt, y[3] * bt};
                *(LAS f32x4*)(X + t * 256 + cc + 4) = (f32x4){y[4] * bt, y[5] * bt, y[6] * bt, y[7] * bt};
            }
#pragma unroll
            for (int e = 0; e < 8; ++e) { x0[e] = x1[e]; x1[e] = x2[e]; x2[e] = x3[e]; }
        }
    }
    __syncthreads();
    {
        const int ti = wave >> 1;
        bf16x8 ak[4], aq[4];
#pragma unroll
        for (int kb = 0; kb < 4; ++kb) { ak[kb] = *(const LAS bf16x8*)(Kb + (16 * ti + c15) * 136 + 32 * kb + 8 * q4); aq[kb] = *(const LAS bf16x8*)(Qb + (16 * ti + c15) * 136 + 32 * kb + 8 * q4); }
#pragma unroll
        for (int jj = 0; jj < 2; ++jj) {
            const int tj = 2 * (wave & 1) + jj;
            f32x4 dk = (f32x4){0.f, 0.f, 0.f, 0.f}, dq = (f32x4){0.f, 0.f, 0.f, 0.f};
#pragma unroll
            for (int kb = 0; kb < 4; ++kb) { const bf16x8 bk = *(const LAS bf16x8*)(Kb + (16 * tj + c15) * 136 + 32 * kb + 8 * q4);
                dk = __builtin_amdgcn_mfma_f32_16x16x32_bf16(ak[kb], bk, dk, 0, 0, 0); dq = __builtin_amdgcn_mfma_f32_16x16x32_bf16(aq[kb], bk, dq, 0, 0, 0); }
            const int j = 16 * tj + c15; const float gj = gcs[j];
#pragma unroll
            for (int r = 0; r < 4; ++r) { const int i = 16 * ti + 4 * q4 + r;
                const float dec = (j <= i) ? __expf(fminf(gcs[i] - gj, 0.f)) : 0.f;
                Af[i * 64 + j] = (j < i) ? bts[i] * dk[r] * dec : 0.f;
                g_intra[i * 64 + kperm(j)] = (bf16_t)(pk2(dq[r] * dec, 0.f) & 0xffffu); }
        }
    }
    __syncthreads();
    if (tid < 256) {
        const int c = tid;
        float x[64];
#pragma unroll
        for (int i = 0; i < 64; ++i) {
            float a = X[i * 256 + c];
#pragma unroll
            for (int j = 0; j < i; ++j) a -= Af[i * 64 + j] * x[j];
            x[i] = a;
        }
        if (c < 128) {
#pragma unroll
            for (int k = 0; k < 8; ++k) { u32x4 o; o.x = pk2(x[8 * k], x[8 * k + 1]); o.y = pk2(x[8 * k + 2], x[8 * k + 3]); o.z = pk2(x[8 * k + 4], x[8 * k + 5]); o.w = pk2(x[8 * k + 6], x[8 * k + 7]);
                *(u32x4*)(g_valT + c * 64 + 8 * k) = o; }
        } else {
            const int pd = kperm(c - 128);
#pragma unroll
            for (int i = 0; i < 64; ++i) g_kcd[i * 128 + pd] = (bf16_t)(pk2(x[i], 0.f) & 0xffffu);
        }
    } else {
        const int t2 = tid - 256;
        {
            const int l = t2 >> 2, kb = t2 & 3; const float eg = egc[l];
#pragma unroll
            for (int k4 = 0; k4 < 4; ++k4) { float v[8];
#pragma unroll
                for (int e = 0; e < 8; ++e) { const int pos = 8 * k4 + e, qq = pos >> 3, jh = (pos >> 2) & 1, r = pos & 3; v[e] = bf2f(Qb[l * 136 + 32 * kb + 16 * jh + 4 * qq + r]) * eg; }
                u32x4 o; o.x = pk2(v[0], v[1]); o.y = pk2(v[2], v[3]); o.z = pk2(v[4], v[5]); o.w = pk2(v[6], v[7]);
                *(u32x4*)(g_qexp + l * 128 + 32 * kb + 8 * k4) = o; }
        }
        {
            const int d = t2 >> 1, kb2 = t2 & 1; const float glast = gcs[63];
#pragma unroll
            for (int k4 = 0; k4 < 4; ++k4) { float v[8];
#pragma unroll
                for (int e = 0; e < 8; ++e) { const int pos = 8 * k4 + e, qq = pos >> 3, jh = (pos >> 2) & 1, r = pos & 3; const int l = 32 * kb2 + 16 * jh + 4 * qq + r; v[e] = bf2f(Kb[l * 136 + d]) * __expf(glast - gcs[l]); }
                u32x4 o; o.x = pk2(v[0], v[1]); o.y = pk2(v[2], v[3]); o.z = pk2(v[4], v[5]); o.w = pk2(v[6], v[7]);
                *(u32x4*)(g_ktT + d * 64 + 32 * kb2 + 8 * k4) = o; }
        }
        if (t2 == 0) GL[item] = egc[63];
    }
    __syncthreads();
}

__device__ __forceinline__ void gdn_scan(LAS unsigned char* L, int bh, const unsigned char* GDN, const float* GL, const bf16_t* P, const float* gnorm, bf16_t* MIX, int tid) {
    const int h = bh & 7, b = bh >> 3;
    const int wave = tid >> 6, lane = tid & 63, q4 = lane >> 4, c15 = lane & 15;
    LAS unsigned char* Lq = L;
    LAS unsigned char* Lk = L + 17408;
    LAS unsigned char* Lt = L + 34816;
    LAS unsigned char* Li = L + 53248;
    LAS float* Lo = (LAS float*)(L + 62464);
    f32x4 S[8];
#pragma unroll
    for (int T = 0; T < 8; ++T) S[T] = (f32x4){0.f, 0.f, 0.f, 0.f};
    u32x4 pf[7];
    const int c0 = tid, c1 = tid + 512;
#define SCAN_LOAD(nn) do { const unsigned char* gb_ = GDN + (size_t)(bh * 64 + (nn)) * GDN_ITEM; \
        pf[0] = *(const u32x4*)(gb_ + c0 * 16); pf[1] = *(const u32x4*)(gb_ + c1 * 16); \
        pf[2] = *(const u32x4*)(gb_ + 16384 + c0 * 16); pf[3] = *(const u32x4*)(gb_ + 16384 + c1 * 16); \
        pf[4] = *(const u32x4*)(gb_ + 32768 + c0 * 16); pf[5] = *(const u32x4*)(gb_ + 32768 + c1 * 16); \
        pf[6] = *(const u32x4*)(gb_ + 65536 + c0 * 16); } while (0)
#define SCAN_STORE() do { \
        *(LAS u32x4*)(Lq + (c0 >> 4) * 272 + (c0 & 15) * 16) = pf[0]; *(LAS u32x4*)(Lq + (c1 >> 4) * 272 + (c1 & 15) * 16) = pf[1]; \
        *(LAS u32x4*)(Lk + (c0 >> 4) * 272 + (c0 & 15) * 16) = pf[2]; *(LAS u32x4*)(Lk + (c1 >> 4) * 272 + (c1 & 15) * 16) = pf[3]; \
        *(LAS u32x4*)(Lt + (c0 >> 3) * 144 + (c0 & 7) * 16) = pf[4]; *(LAS u32x4*)(Lt + (c1 >> 3) * 144 + (c1 & 7) * 16) = pf[5]; \
        *(LAS u32x4*)(Li + (c0 >> 3) * 144 + (c0 & 7) * 16) = pf[6]; } while (0)
    SCAN_LOAD(0); SCAN_STORE();
    __syncthreads();
    for (int n = 0; n < 64; ++n) {
        if (n + 1 < 64) SCAN_LOAD(n + 1);
        const unsigned char* gb = GDN + (size_t)(bh * 64 + n) * GDN_ITEM;
        const float gl = GL[bh * 64 + n];
        u32x2 vraw[4];
#pragma unroll
        for (int t = 0; t < 4; ++t) vraw[t] = *(const u32x2*)(gb + 49152 + ((16 * wave + c15) * 64 + 16 * t + 4 * q4) * 2);
        bf16x8 Sp[4];
#pragma unroll
        for (int kb = 0; kb < 4; ++kb) Sp[kb] = pack8(S[2 * kb], S[2 * kb + 1]);
        f32x4 Vn[4];
#pragma unroll
        for (int t = 0; t < 4; ++t) {
            f32x4 pa = (f32x4){0.f, 0.f, 0.f, 0.f};
#pragma unroll
            for (int kb = 0; kb < 4; ++kb) { const bf16x8 a = *(const LAS bf16x8*)(Lk + (16 * t + c15) * 272 + (32 * kb + 8 * q4) * 2); pa = __builtin_amdgcn_mfma_f32_16x16x32_bf16(a, Sp[kb], pa, 0, 0, 0); }
            Vn[t] = (f32x4){bflo(vraw[t].x), bfhi(vraw[t].x), bflo(vraw[t].y), bfhi(vraw[t].y)} - pa;
        }
        bf16x8 Vp[2];
        Vp[0] = pack8(Vn[0], Vn[1]); Vp[1] = pack8(Vn[2], Vn[3]);
#pragma unroll
        for (int t = 0; t < 4; ++t) {
            f32x4 o = (f32x4){0.f, 0.f, 0.f, 0.f};
#pragma unroll
            for (int kb = 0; kb < 4; ++kb) { const bf16x8 a = *(const LAS bf16x8*)(Lq + (16 * t + c15) * 272 + (32 * kb + 8 * q4) * 2); o = __builtin_amdgcn_mfma_f32_16x16x32_bf16(a, Sp[kb], o, 0, 0, 0); }
#pragma unroll
            for (int kb = 0; kb < 2; ++kb) { const bf16x8 a = *(const LAS bf16x8*)(Li + (16 * t + c15) * 144 + (32 * kb + 8 * q4) * 2); o = __builtin_amdgcn_mfma_f32_16x16x32_bf16(a, Vp[kb], o, 0, 0, 0); }
#pragma unroll
            for (int r = 0; r < 4; ++r) Lo[(16 * t + 4 * q4 + r) * 132 + 16 * wave + c15] = o[r];
        }
#pragma unroll
        for (int T = 0; T < 8; ++T) {
            f32x4 s = S[T] * gl;
#pragma unroll
            for (int kb = 0; kb < 2; ++kb) { const bf16x8 a = *(const LAS bf16x8*)(Lt + (16 * T + c15) * 144 + (32 * kb + 8 * q4) * 2); s = __builtin_amdgcn_mfma_f32_16x16x32_bf16(a, Vp[kb], s, 0, 0, 0); }
            S[T] = s;
        }
        __syncthreads();
        {
            const int l = tid >> 3, part = tid & 7; const size_t tok = (size_t)b * SEQL + n * 64 + l;
            f32x4 ov[4]; float ss = 0.f;
#pragma unroll
            for (int k = 0; k < 4; ++k) { ov[k] = *(const LAS f32x4*)(Lo + l * 132 + part * 16 + 4 * k); ss += (ov[k][0] * ov[k][0] + ov[k][1] * ov[k][1]) + (ov[k][2] * ov[k][2] + ov[k][3] * ov[k][3]); }
            ss += __shfl_xor(ss, 1); ss += __shfl_xor(ss, 2); ss += __shfl_xor(ss, 4);
            const float rstd = 1.0f / sqrtf(ss * (1.0f / 128.f) + EPSF);
            const u32x4 z0 = *(const u32x4*)(P + tok * PJ + C_Z + h * 128 + part * 16), z1 = *(const u32x4*)(P + tok * PJ + C_Z + h * 128 + part * 16 + 8);
            float zz[16] = {bflo(z0.x), bfhi(z0.x), bflo(z0.y), bfhi(z0.y), bflo(z0.z), bfhi(z0.z), bflo(z0.w), bfhi(z0.w), bflo(z1.x), bfhi(z1.x), bflo(z1.y), bfhi(z1.y), bflo(z1.z), bfhi(z1.z), bflo(z1.w), bfhi(z1.w)};
            float res[16];
#pragma unroll
            for (int k = 0; k < 4; ++k) { const f32x4 gg = *(const f32x4*)(gnorm + part * 16 + 4 * k);
#pragma unroll
                for (int e = 0; e < 4; ++e) { const float z = zz[4 * k + e]; res[4 * k + e] = ov[k][e] * rstd * gg[e] * (z * sigmoidf_(z)); } }
            u32x4 w0, w1; w0.x = pk2(res[0], res[1]); w0.y = pk2(res[2], res[3]); w0.z = pk2(res[4], res[5]); w0.w = pk2(res[6], res[7]);
            w1.x = pk2(res[8], res[9]); w1.y = pk2(res[10], res[11]); w1.z = pk2(res[12], res[13]); w1.w = pk2(res[14], res[15]);
            *(u32x4*)(MIX + tok * DM + 1024 + h * 128 + part * 16) = w0; *(u32x4*)(MIX + tok * DM + 1024 + h * 128 + part * 16 + 8) = w1;
        }
        if (n + 1 < 64) SCAN_STORE();
        __syncthreads();
    }
#undef SCAN_LOAD
#undef SCAN_STORE
}

__device__ __forceinline__ void sgu_item(LAS unsigned char* L, int item, const bf16_t* P, const float* sgw, const float* sgb, const float* lng, const float* lnb, const float* ona, bf16_t* MIX, int tid) {
    const int h = item & 3, n = (item >> 2) & 31, b = item >> 7;
    const size_t tok0 = (size_t)b * SEQL + n * 128;
    const int wave = tid >> 6, lane = tid & 63, q4 = lane >> 4, c15 = lane & 15;
    LAS bf16_t* Wl = (LAS bf16_t*)L;
    LAS bf16_t* Vt = (LAS bf16_t*)(L + 34816);
    {
        const int t = tid >> 2, s0 = (tid & 3) * 32; const float* wr = sgw + (size_t)h * 16384 + t * 128 + s0;
#pragma unroll
        for (int k = 0; k < 4; ++k) { const f32x4 a = *(const f32x4*)(wr + 8 * k), c = *(const f32x4*)(wr + 8 * k + 4); float v[8] = {a[0], a[1], a[2], a[3], c[0], c[1], c[2], c[3]};
#pragma unroll
            for (int e = 0; e < 8; ++e) v[e] = (s0 + 8 * k + e <= t) ? v[e] : 0.f;
            u32x4 o; o.x = pk2(v[0], v[1]); o.y = pk2(v[2], v[3]); o.z = pk2(v[4], v[5]); o.w = pk2(v[6], v[7]);
            *(LAS u32x4*)(Wl + t * 136 + s0 + 8 * k) = o; }
    }
    {
        const int s = tid >> 2, d0 = (tid & 3) * 32; const bf16_t* vr = P + (tok0 + s) * PJ + C_V + h * 128 + d0;
        float v[32]; float sm = 0.f;
#pragma unroll
        for (int k = 0; k < 4; ++k) { const u32x4 w = *(const u32x4*)(vr + 8 * k); v[8 * k] = bflo(w.x); v[8 * k + 1] = bfhi(w.x); v[8 * k + 2] = bflo(w.y); v[8 * k + 3] = bfhi(w.y); v[8 * k + 4] = bflo(w.z); v[8 * k + 5] = bfhi(w.z); v[8 * k + 6] = bflo(w.w); v[8 * k + 7] = bfhi(w.w); }
#pragma unroll
        for (int e = 0; e < 32; ++e) sm += v[e];
        sm += __shfl_xor(sm, 1); sm += __shfl_xor(sm, 2);
        const float mu = sm * (1.0f / 128.f); float sq = 0.f;
#pragma unroll
        for (int e = 0; e < 32; ++e) { v[e] -= mu; sq += v[e] * v[e]; }
        sq += __shfl_xor(sq, 1); sq += __shfl_xor(sq, 2);
        const float rstd = 1.0f / sqrtf(sq * (1.0f / 128.f) + EPSF);
#pragma unroll
        for (int e = 0; e < 32; ++e) { const float y = v[e] * rstd * lng[h * 128 + d0 + e] + lnb[h * 128 + d0 + e]; Vt[(d0 + e) * 136 + s] = (bf16_t)(pk2(y, 0.f) & 0xffffu); }
    }
    __syncthreads();
    {
        f32x4 D[8];
#pragma unroll
        for (int tj = 0; tj < 8; ++tj) D[tj] = (f32x4){0.f, 0.f, 0.f, 0.f};
        const int nkb = (wave >> 1) + 1;
        for (int kb = 0; kb < nkb; ++kb) {
            const bf16x8 a = *(const LAS bf16x8*)(Wl + (16 * wave + c15) * 136 + 32 * kb + 8 * q4);
#pragma unroll
            for (int tj = 0; tj < 8; ++tj) { const bf16x8 bv = *(const LAS bf16x8*)(Vt + (16 * tj + c15) * 136 + 32 * kb + 8 * q4); D[tj] = __builtin_amdgcn_mfma_f32_16x16x32_bf16(a, bv, D[tj], 0, 0, 0); }
        }
        float ss[4] = {0.f, 0.f, 0.f, 0.f};
#pragma unroll
        for (int r = 0; r < 4; ++r) { const int t = 16 * wave + 4 * q4 + r; const float bias = sgb[h * 128 + t]; const bf16_t* ur = P + (tok0 + t) * PJ + C_U + h * 128 + c15;
#pragma unroll
            for (int tj = 0; tj < 8; ++tj) { const float uu = bf2f(ur[16 * tj]); const float y = uu * (D[tj][r] + bias); D[tj][r] = y; ss[r] += y * y; } }
#pragma unroll
        for (int r = 0; r < 4; ++r) { float s = ss[r]; s += __shfl_xor(s, 1); s += __shfl_xor(s, 2); s += __shfl_xor(s, 4); s += __shfl_xor(s, 8); ss[r] = 1.0f / sqrtf(s * (1.0f / 128.f) + EPSF); }
#pragma unroll
        for (int r = 0; r < 4; ++r) { const int t = 16 * wave + 4 * q4 + r; bf16_t* orow = MIX + (tok0 + t) * DM + h * 128 + c15;
#pragma unroll
            for (int tj = 0; tj < 8; ++tj) orow[16 * tj] = (bf16_t)(pk2(D[tj][r] * ss[r] * ona[h * 128 + 16 * tj + c15], 0.f) & 0xffffu); }
    }
    __syncthreads();
}

__device__ __forceinline__ void unpack8(const u32x4 w, float (&v)[8]) { v[0] = bflo(w.x); v[1] = bfhi(w.x); v[2] = bflo(w.y); v[3] = bfhi(w.y); v[4] = bflo(w.z); v[5] = bfhi(w.z); v[6] = bflo(w.w); v[7] = bfhi(w.w); }
__device__ __forceinline__ void shortconv_token(int tok, const bf16_t* P, const float* scw, const float* onb, bf16_t* MIX, int lane) {
    const int c = lane * 8, pos = tok & (SEQL - 1);
    const bf16_t* row = P + (size_t)tok * PJ;
    float gb[8], acc[8];
    unpack8(*(const u32x4*)(row + C_GB + c), gb);
#pragma unroll
    for (int e = 0; e < 8; ++e) acc[e] = 0.f;
#pragma unroll
    for (int j = 0; j < 3; ++j) {
        const int back = 2 - j;
        if (pos - back >= 0) { float g[8], xi[8]; const bf16_t* r2 = row - (size_t)back * PJ;
            unpack8(*(const u32x4*)(r2 + C_GC + c), g); unpack8(*(const u32x4*)(r2 + C_XI + c), xi);
            const f32x4 w0 = *(const f32x4*)(scw + j * 512 + c), w1 = *(const f32x4*)(scw + j * 512 + c + 4);
#pragma unroll
            for (int e = 0; e < 4; ++e) { acc[e] += w0[e] * (g[e] * xi[e]); acc[4 + e] += w1[e] * (g[4 + e] * xi[4 + e]); } }
    }
    float ss = 0.f;
#pragma unroll
    for (int e = 0; e < 8; ++e) { acc[e] *= gb[e]; ss += acc[e] * acc[e]; }
    ss += __shfl_xor(ss, 1); ss += __shfl_xor(ss, 2); ss += __shfl_xor(ss, 4); ss += __shfl_xor(ss, 8);
    const float rstd = 1.0f / sqrtf(ss * (1.0f / 128.f) + EPSF);
    const f32x4 g0 = *(const f32x4*)(onb + c), g1 = *(const f32x4*)(onb + c + 4);
    u32x4 o; o.x = pk2(acc[0] * rstd * g0[0], acc[1] * rstd * g0[1]); o.y = pk2(acc[2] * rstd * g0[2], acc[3] * rstd * g0[3]);
    o.z = pk2(acc[4] * rstd * g1[0], acc[5] * rstd * g1[1]); o.w = pk2(acc[6] * rstd * g1[2], acc[7] * rstd * g1[3]);
    *(u32x4*)(MIX + (size_t)tok * DM + 512 + c) = o;
}

typedef const char __attribute__((address_space(4))) kchar_t;
#define KARG(field) (*(decltype(Args::field) const __attribute__((address_space(4)))*)(kp + offsetof(Args, field)))
#define PHASE_BEGIN int tid = threadIdx.x; asm volatile("" : "+v"(tid)); const int lane = tid & 63, wave = __builtin_amdgcn_readfirstlane(tid >> 6); \
    const int G = gridDim.x, bx = blockIdx.x, gw = bx * NWAVES + wave, NGW = G * NWAVES; (void)lane; (void)gw; (void)NGW; \
    kchar_t* kp = (kchar_t*)__builtin_amdgcn_kernarg_segment_ptr(); asm volatile("" : "+s"(kp)); \
    unsigned char* ws = KARG(ws); (void)ws; int l = lsel; asm volatile("" : "+s"(l));
#define WSP(T, off) ((T*)(ws + (off)))
__global__ void __launch_bounds__(NTHREADS, 2) hybrid_fwd(Args a) {
    extern __shared__ __attribute__((aligned(16))) unsigned char lds_raw[];
    LAS unsigned char* L = (LAS unsigned char*)lds_raw;
    const int lo = a.ph_lo, hi = a.ph_hi, coop = a.coop;
#ifndef PH_MASK
#define PH_MASK 0xFFFFu
#endif
#define IN(k) (((PH_MASK >> ((k) >= 20 ? 10 : (k) % 10)) & 1u) && lo <= (k) && (k) < hi)
#define SEAM() do { if (coop) cg::this_grid().sync(); else __syncthreads(); } while (0)

#pragma unroll 1
    for (int lsel = 0; lsel < 2; ++lsel) {
        const int pb = lsel * 10;
        if (IN(pb + 0)) {
            PHASE_BEGIN
            LAS float* scr = (LAS float*)(L + wave * 16384);
            constexpr int I_IN = 32 * (INP / 32), I_O = 32 * 64, I_1 = 32 * 256, I_2 = 128 * 64, I_G = 32 * 64, I_P = 4 * 64;
            constexpr int NITEMS = I_IN + I_O + I_1 + I_2 + I_G + I_P;
            for (int it = gw; it < NITEMS; it += NGW) {
                int r = it;
                if (r < I_IN) { transpose_item(KARG(w_in) + (size_t)l * DM * INC, DM, INC, INP, WSP(bf16_t, WS_WIN), scr, r, lane); continue; } r -= I_IN;
                if (r < I_O) { transpose_item(KARG(w_o) + (size_t)l * DM * DM, DM, DM, DM, WSP(bf16_t, WS_WO), scr, r, lane); continue; } r -= I_O;
                if (r < I_1) { transpose_item(KARG(w_ff1) + (size_t)l * DM * FFD, DM, FFD, FFD, WSP(bf16_t, WS_W1), scr, r, lane); continue; } r -= I_1;
                if (r < I_2) { transpose_item(KARG(w_ff2) + (size_t)l * DM * FFD, FFD, DM, DM, WSP(bf16_t, WS_W2), scr, r, lane); continue; } r -= I_2;
                if (r < I_G) { transpose_item(KARG(w_ple_gate) + (size_t)l * DM * DM, DM, DM, DM, WSP(bf16_t, WS_WG), scr, r, lane); continue; } r -= I_G;
                transpose_item(KARG(w_ple_proj) + (size_t)l * PLE * DM, PLE, DM, DM, WSP(bf16_t, WS_WP), scr, r, lane);
            }
            {
                const f32x4* src = (const f32x4*)(KARG(p) + (size_t)l * TOK * PLE); u32x2* dst = WSP(u32x2, WS_P16);
                for (int i = bx * NTHREADS + tid; i < TOK * PLE / 4; i += G * NTHREADS) { const f32x4 v = src[i]; u32x2 w; w.x = pk2(v[0], v[1]); w.y = pk2(v[2], v[3]); dst[i] = w; }
            }
            const float* hsrc = (l == 0) ? KARG(x) : (const float*)KARG(out);
            for (int m = gw; m < TOK; m += NGW) rms_row_bf16(hsrc + (size_t)m * DM, KARG(norm_mix) + l * DM, WSP(bf16_t, WS_XN) + (size_t)m * DM, lane);
        }
        if (IN(pb + 0) && IN(pb + 1)) SEAM();
        if (IN(pb + 1)) {
            PHASE_BEGIN
            pg8::Gemm g{WSP(bf16_t, WS_XN), WSP(bf16_t, WS_WIN), TOK, INP, DM}; pg8::StaticOrder S; S.init(TOK, INP, G, bx);
            EpiProj E{WSP(bf16_t, WS_BIG), WSP(float, WS_AB)};
            pg8::gemm_phase<EpiProj>(L, g, S, E, tid);
        }
        if (IN(pb + 1) && IN(pb + 2)) SEAM();
        if (IN(pb + 2)) {
            PHASE_BEGIN
            for (int it = bx; it < 2048; it += G)
                gdn_chunk_item(L, it, WSP(bf16_t, WS_BIG), WSP(float, WS_AB), KARG(gdn_conv) + (size_t)l * 4 * 3072, KARG(gdn_a_log) + l * 8, KARG(gdn_dt_bias) + l * 8, ws + WS_GDN, WSP(float, WS_GL), tid);
        }
        if (IN(pb + 2) && IN(pb + 3)) SEAM();
        if (IN(pb + 3)) {
            PHASE_BEGIN
            const int nscan = (G > 32) ? 32 : 0;
            if (bx < nscan) {
                gdn_scan(L, bx, ws + WS_GDN, WSP(float, WS_GL), WSP(bf16_t, WS_BIG), KARG(gdn_norm) + l * 128, WSP(bf16_t, WS_XN), tid);
            } else {
                if (nscan == 0) { for (int bh = bx; bh < 32; bh += G) gdn_scan(L, bh, ws + WS_GDN, WSP(float, WS_GL), WSP(bf16_t, WS_BIG), KARG(gdn_norm) + l * 128, WSP(bf16_t, WS_XN), tid); }
                const int rb = bx - nscan, RG = G - nscan;
                for (int it = rb; it < 512; it += RG)
                    sgu_item(L, it, WSP(bf16_t, WS_BIG), KARG(sg_w) + (size_t)l * 4 * 16384, KARG(sg_b) + l * 512, KARG(sg_ln_g) + l * 512, KARG(sg_ln_b) + l * 512, KARG(out_norm_a) + l * 512, WSP(bf16_t, WS_XN), tid);
                for (int tk = rb * NWAVES + wave; tk < TOK; tk += RG * NWAVES)
                    shortconv_token(tk, WSP(bf16_t, WS_BIG), KARG(sc_conv) + l * 3 * 512, KARG(out_norm_b) + l * 512, WSP(bf16_t, WS_XN), lane);
            }
        }
        if (IN(pb + 3) && IN(pb + 4)) SEAM();
        if (IN(pb + 4)) {
            PHASE_BEGIN
            pg8::Gemm g{WSP(bf16_t, WS_XN), WSP(bf16_t, WS_WO), TOK, DM, DM}; pg8::StaticOrder S; S.init(TOK, DM, G, bx);
            const float* hsrc = (l == 0) ? KARG(x) : (const float*)KARG(out);
            EpiRes E{hsrc, KARG(out)};
            pg8::gemm_phase<EpiRes>(L, g, S, E, tid);
        }
        if (IN(pb + 4) && IN(pb + 5)) SEAM();
        if (IN(pb + 5)) {
            PHASE_BEGIN
            for (int m = gw; m < TOK; m += NGW) rms_row_bf16(KARG(out) + (size_t)m * DM, KARG(norm_ffn) + l * DM, WSP(bf16_t, WS_XN) + (size_t)m * DM, lane);
        }
        if (IN(pb + 5) && IN(pb + 6)) SEAM();
        if (IN(pb + 6)) {
            PHASE_BEGIN
            pg8::Gemm g{WSP(bf16_t, WS_XN), WSP(bf16_t, WS_W1), TOK, FFD, DM}; pg8::StaticOrder S; S.init(TOK, FFD, G, bx);
            EpiRelu2 E{WSP(bf16_t, WS_BIG)};
            pg8::gemm_phase<EpiRelu2>(L, g, S, E, tid);
        }
        if (IN(pb + 6) && IN(pb + 7)) SEAM();
        if (IN(pb + 7)) {
            PHASE_BEGIN
            pg8::Gemm g{WSP(bf16_t, WS_BIG), WSP(bf16_t, WS_W2), TOK, DM, FFD}; pg8::StaticOrder S; S.init(TOK, DM, G, bx);
            EpiRes E{KARG(out), KARG(out)};
            pg8::gemm_phase<EpiRes>(L, g, S, E, tid);
        }
        if (IN(pb + 7) && IN(pb + 8)) SEAM();
        if (IN(pb + 8)) {
            PHASE_BEGIN
            for (int m = gw; m < TOK; m += NGW) rms_row_bf16(KARG(out) + (size_t)m * DM, KARG(norm_ple) + l * DM, WSP(bf16_t, WS_XN) + (size_t)m * DM, lane);
        }
        if (IN(pb + 8)) {
            __syncthreads();
            PHASE_BEGIN
            pg8::Gemm g{WSP(bf16_t, WS_P16), WSP(bf16_t, WS_WP), TOK, DM, PLE}; pg8::StaticOrder S; S.init(TOK, DM, G, bx);
            EpiPlain E{WSP(bf16_t, WS_BIG)};
            pg8::gemm_phase<EpiPlain>(L, g, S, E, tid);
        }
        if (IN(pb + 8) && IN(pb + 9)) SEAM();
        if (IN(pb + 9)) {
            PHASE_BEGIN
            pg8::Gemm g{WSP(bf16_t, WS_XN), WSP(bf16_t, WS_WG), TOK, DM, DM}; pg8::StaticOrder S; S.init(TOK, DM, G, bx);
            EpiGate E{WSP(bf16_t, WS_BIG), KARG(out)};
            pg8::gemm_phase<EpiGate>(L, g, S, E, tid);
        }
        if (IN(pb + 9) && IN(pb + 10)) SEAM();
    }
    if (IN(20)) {
        const int lsel = 0;
        PHASE_BEGIN
        for (int m = gw; m < TOK; m += NGW) rms_row_f32(KARG(out) + (size_t)m * DM, KARG(norm_final), KARG(out) + (size_t)m * DM, lane);
    }
#undef IN
#undef SEAM
}

extern "C" void kernel_launch(void* const* d_in, const int* in_sizes, int n_in, void* d_out, int out_size, void* d_ws, size_t ws_size, hipStream_t stream) {
    static int grid = 0;
    if (grid == 0) {
        if (n_in != 23 || out_size != TOK * DM || ws_size < WS_END) { fprintf(stderr, "kernel_launch: unexpected shapes (n_in %d out %d ws %zu need %zu)\n", n_in, out_size, ws_size, (size_t)WS_END); grid = -1; return; }
        int dev = 0, cus = 0, per_cu = 0;
        hipGetDevice(&dev);
        hipDeviceGetAttribute(&cus, hipDeviceAttributeMultiprocessorCount, dev);
        if (hipFuncSetAttribute((const void*)hybrid_fwd, hipFuncAttributeMaxDynamicSharedMemorySize, LDS_BYTES) != hipSuccess) { fprintf(stderr, "kernel_launch: hipFuncSetAttribute failed\n"); grid = -1; return; }
        if (hipOccupancyMaxActiveBlocksPerMultiprocessor(&per_cu, (const void*)hybrid_fwd, NTHREADS, LDS_BYTES) != hipSuccess || per_cu < 1) { fprintf(stderr, "kernel_launch: occupancy query gave %d\n", per_cu); per_cu = 1; }
        (void)hipGetLastError();
        grid = cus * per_cu;
    }
    if (grid < 0) return;
    Args a{};
    const float** f = (const float**)&a;
    for (int i = 0; i < 23; ++i) f[i] = (const float*)d_in[i];
    a.out = (float*)d_out; a.ws = (unsigned char*)d_ws;
#if MK_COOP
    a.ph_lo = 0; a.ph_hi = 21; a.coop = 1;
    void* args[] = {&a};
    hipError_t e = hipLaunchCooperativeKernel((const void*)hybrid_fwd, dim3(grid), dim3(NTHREADS), args, LDS_BYTES, stream);
    if (e != hipSuccess) fprintf(stderr, "cooperative launch failed: %s (grid %d)\n", hipGetErrorString(e), grid);
#else
    for (int ph = 0; ph < 21; ++ph) {
        a.ph_lo = ph; a.ph_hi = ph + 1; a.coop = 0;
        hipLaunchKernelGGL(hybrid_fwd, dim3(grid), dim3(NTHREADS), LDS_BYTES, stream, a);
    }
#endif
}
```

```cpp
#include <hip/hip_runtime.h>
#include <hip/hip_cooperative_groups.h>
#include <cstdio>
#include <cstdint>
#include <cstddef>
namespace cg = cooperative_groups;

#ifndef MK_COOP
#define MK_COOP 1
#endif

#define LAS __attribute__((address_space(3)))
typedef unsigned short bf16_t;
typedef short bf16x8 __attribute__((ext_vector_type(8)));
typedef float f32x4 __attribute__((ext_vector_type(4)));
typedef float f32x2 __attribute__((ext_vector_type(2)));
typedef unsigned u32x4 __attribute__((ext_vector_type(4)));
typedef unsigned u32x2 __attribute__((ext_vector_type(2)));

namespace pg8 {
constexpr int BM = 256, BK = 64, HALF = 128, HTB = HALF * BK * 2, STAGE_BYTES = 8 * HTB, NXCD = 8, WGM = 8;
__host__ __device__ __forceinline__ int lds_byte(int r, int c) { const int st = (r >> 4) * 2 + (c >> 5), rr = r & 15, cc = c & 31, ob = rr * 64 + cc * 2; return st * 1024 + (ob ^ (((ob >> 9) & 1) << 5)); }
__host__ __device__ __forceinline__ void stage_rc(int b, int& R, int& C) { const int st = b / 1024, sb = b % 1024, swz = sb ^ (((sb >> 9) & 1) << 5); R = (st >> 1) * 16 + swz / 64; C = (st & 1) * 32 + (swz % 64) / 2; }
__host__ __device__ __forceinline__ int perm32(int rho) { const int n = rho >> 4, i = rho & 15; return 8 * (i >> 2) + 4 * n + (i & 3); }

struct Unit { int pm, pn; };
struct Gemm { const bf16_t* A; const bf16_t* Bt; int M, N, K; };

struct StaticOrder {
    int nM, nN, nwg, G, c;
    __host__ __device__ void init(int M, int N, int G_, int c_) { nM = M / BM; nN = N / BM; nwg = nM * nN; G = G_; c = c_; }
    __host__ __device__ bool next(int i, Unit& u) const {
        const long L = (long)i * G + c; if (L >= nwg) return false;
        int wgid = (int)L; { const int q = nwg / NXCD, r = nwg % NXCD, xcd = wgid % NXCD, off = wgid / NXCD; wgid = (xcd < r ? xcd * (q + 1) : r * (q + 1) + (xcd - r) * q) + off; }
        const int nig = WGM * nN, gid = wgid / nig, fm = gid * WGM, gsz = (nM - fm) < WGM ? (nM - fm) : WGM;
        u.pm = fm + ((wgid % nig) % gsz); u.pn = (wgid % nig) / gsz; return true;
    }
};

__device__ __forceinline__ unsigned cvt_pk_bf16(float lo, float hi) { unsigned r; asm volatile("v_cvt_pk_bf16_f32 %0, %1, %2" : "=v"(r) : "v"(lo), "v"(hi)); return r; }

template <class Epi>
__device__ __forceinline__ void gemm_phase(LAS unsigned char* lds, const Gemm g, const StaticOrder& S, const Epi& E, const int tid) {
    const int wid = __builtin_amdgcn_readfirstlane(tid >> 6), lane = tid & 63, wr = wid >> 2, wc = wid & 3, fr = lane & 15, fq = lane >> 4;
    int K_ = g.K; asm volatile("" : "+s"(K_)); const int K = K_, nt = K / BK;
    unsigned voffA[2], voffB[2];
#pragma unroll
    for (int i = 0; i < 2; ++i) { int R, C; stage_rc(tid * 16 + i * 8192, R, C); const int Rb = (R & ~31) + perm32(R & 31);
        voffA[i] = (unsigned)(R * K + C) * 2u; voffB[i] = (unsigned)(Rb * K + C) * 2u; }
    const size_t kstep = (size_t)(BK * 2);
    const size_t hstep = (size_t)HALF * K * 2;
    const size_t tstep = 2 * hstep;
    const unsigned ldsw = (unsigned)wid * 1024u;
    const int aoff = lds_byte(wr * 64 + fr, fq * 8), boff = lds_byte(wc * 32 + fr, fq * 8);
#define PG8_SA(b, h) (((b) * 2 + (h)) * HTB)
#define PG8_SB(b, h) ((4 + (b) * 2 + (h)) * HTB)
#define PG8_STAGE(bufoff, gbase, voff) do { _Pragma("unroll") for (int _i = 0; _i < 2; ++_i) \
        __builtin_amdgcn_global_load_lds((const unsigned*)((const char*)(gbase) + (voff)[_i]), (LAS unsigned*)(lds + (bufoff) + ldsw + _i * 8192), 16, 0, 0); } while (0)
#define PG8_LDA(dst, b, h) do { _Pragma("unroll") for (int m = 0; m < 4; ++m) _Pragma("unroll") for (int k = 0; k < 2; ++k) dst[m][k] = *(const LAS bf16x8*)(lds + PG8_SA(b, h) + aoff + m * 2048 + k * 1024); } while (0)
#define PG8_LDB(dst, b, h) do { _Pragma("unroll") for (int n = 0; n < 2; ++n) _Pragma("unroll") for (int k = 0; k < 2; ++k) dst[n][k] = *(const LAS bf16x8*)(lds + PG8_SB(b, h) + boff + n * 2048 + k * 1024); } while (0)
#define PG8_MMA(ai, bj, At, Bt) do { __builtin_amdgcn_s_setprio(1); _Pragma("unroll") for (int m = 0; m < 4; ++m) _Pragma("unroll") for (int n = 0; n < 2; ++n) _Pragma("unroll") for (int k = 0; k < 2; ++k) \
        acc[ai][bj][m][n] = __builtin_amdgcn_mfma_f32_16x16x32_bf16(Bt[n][k], At[m][k], acc[ai][bj][m][n], 0, 0, 0); __builtin_amdgcn_s_setprio(0); } while (0)
#define PG8_WAIT_V(n) asm volatile("s_waitcnt vmcnt(" #n ")" ::: "memory")
#define PG8_WAIT_L(n) asm volatile("s_waitcnt lgkmcnt(" #n ")" ::: "memory")
#define PG8_BAR __builtin_amdgcn_s_barrier()
#define PG8_SCHED __builtin_amdgcn_sched_barrier(0)
    Unit cur, nxt; int ui = 0;
    if (!S.next(0, cur)) return;
    f32x4 acc[2][2][4][2];
#pragma unroll
    for (int a = 0; a < 2; ++a)
#pragma unroll
        for (int b = 0; b < 2; ++b)
#pragma unroll
            for (int m = 0; m < 4; ++m)
#pragma unroll
                for (int n = 0; n < 2; ++n) acc[a][b][m][n] = (f32x4){0.f, 0.f, 0.f, 0.f};
    bf16x8 At[4][2], B0[2][2], B1[2][2];
    const char* cA = (const char*)g.A + (size_t)cur.pm * tstep; const char* cB = (const char*)g.Bt + (size_t)cur.pn * tstep;
    PG8_STAGE(PG8_SB(0, 0), cB, voffB); PG8_STAGE(PG8_SB(0, 1), cB + hstep, voffB); PG8_STAGE(PG8_SA(0, 0), cA, voffA); PG8_STAGE(PG8_SA(0, 1), cA + hstep, voffA);
    if (wr == 1) PG8_BAR;
    PG8_WAIT_V(2); PG8_BAR;
    PG8_STAGE(PG8_SB(1, 0), cB + kstep, voffB); PG8_STAGE(PG8_SA(1, 0), cA + kstep, voffA); PG8_STAGE(PG8_SB(1, 1), cB + hstep + kstep, voffB);
    PG8_WAIT_V(6); PG8_BAR;
    for (;;) {
        const bool has_next = S.next(ui + 1, nxt);
        const char* nA = has_next ? (const char*)g.A + (size_t)nxt.pm * tstep : cA; const char* nB = has_next ? (const char*)g.Bt + (size_t)nxt.pn * tstep : cB;
        for (int t = 0; t < nt; t += 2) {
            const bool last = (t == nt - 2);
            const char* a1 = cA + (size_t)(t + 1) * kstep;
            const char* a2 = last ? nA : cA + (size_t)(t + 2) * kstep; const char* b2 = last ? nB : cB + (size_t)(t + 2) * kstep;
            const char* a3 = a2 + kstep; const char* b3 = b2 + kstep;
            PG8_LDB(B0, 0, 0); PG8_LDB(B1, 0, 1); PG8_SCHED; PG8_LDA(At, 0, 0); PG8_STAGE(PG8_SA(1, 1), a1 + hstep, voffA);
            PG8_WAIT_V(8); PG8_WAIT_L(0); PG8_BAR; PG8_MMA(0, 0, At, B0); PG8_MMA(0, 1, At, B1); PG8_BAR; PG8_SCHED;
            PG8_LDA(At, 0, 1); PG8_STAGE(PG8_SB(0, 0), b2, voffB); PG8_STAGE(PG8_SB(0, 1), b2 + hstep, voffB); PG8_STAGE(PG8_SA(0, 0), a2, voffA);
            PG8_WAIT_V(8); PG8_WAIT_L(0); PG8_BAR; PG8_MMA(1, 0, At, B0); PG8_MMA(1, 1, At, B1); PG8_BAR; PG8_SCHED;
            PG8_LDB(B0, 1, 0); PG8_LDB(B1, 1, 1); PG8_SCHED; PG8_LDA(At, 1, 0); PG8_STAGE(PG8_SA(0, 1), a2 + hstep, voffA);
            PG8_WAIT_V(8); PG8_WAIT_L(0); PG8_BAR; PG8_MMA(0, 0, At, B0); PG8_MMA(0, 1, At, B1); PG8_BAR; PG8_SCHED;
            PG8_LDA(At, 1, 1); PG8_STAGE(PG8_SB(1, 0), b3, voffB); PG8_STAGE(PG8_SB(1, 1), b3 + hstep, voffB); PG8_STAGE(PG8_SA(1, 0), a3, voffA);
            PG8_WAIT_V(8); PG8_WAIT_L(0); PG8_BAR; PG8_MMA(1, 0, At, B0); PG8_MMA(1, 1, At, B1); PG8_BAR; PG8_SCHED;
        }
        if (wr == 0) PG8_BAR;
        E(acc, cur, wr, wc, fr, fq);
        if (!has_next) break;
#pragma unroll
        for (int a = 0; a < 2; ++a)
#pragma unroll
            for (int b = 0; b < 2; ++b)
#pragma unroll
                for (int m = 0; m < 4; ++m)
#pragma unroll
                    for (int n = 0; n < 2; ++n) acc[a][b][m][n] = (f32x4){0.f, 0.f, 0.f, 0.f};
        cur = nxt; cA = nA; cB = nB; ++ui;
        if (wr == 1) PG8_BAR;
    }
    PG8_WAIT_V(0);
    PG8_BAR;
#undef PG8_SA
#undef PG8_SB
#undef PG8_STAGE
#undef PG8_LDA
#undef PG8_LDB
#undef PG8_MMA
#undef PG8_WAIT_V
#undef PG8_WAIT_L
#undef PG8_BAR
#undef PG8_SCHED
}
}

constexpr int TOK = 16384, DM = 2048, SEQL = 4096, FFD = 8192, PLE = 256;
constexpr int INC = 6672, INP = 6912, PJ = 6656;
constexpr int C_U = 0, C_V = 512, C_GB = 1024, C_GC = 1536, C_XI = 2048, C_Q = 2560, C_Z = 5632;
constexpr float EPSF = 1e-6f;
constexpr int NTHREADS = 512, NWAVES = 8;
constexpr int LDS_BYTES = 147456;

constexpr size_t WS_AB = 0;
constexpr size_t WS_GL = 1048576;
constexpr size_t WS_WIN = 2097152;
constexpr size_t WS_WO = WS_WIN + (size_t)INP * DM * 2;
constexpr size_t WS_W1 = WS_WO + (size_t)DM * DM * 2;
constexpr size_t WS_W2 = WS_W1 + (size_t)FFD * DM * 2;
constexpr size_t WS_WG = WS_W2 + (size_t)FFD * DM * 2;
constexpr size_t WS_WP = WS_WG + (size_t)DM * DM * 2;
constexpr size_t WS_P16 = WS_WP + (size_t)DM * PLE * 2;
constexpr size_t WS_XN = WS_P16 + (size_t)TOK * PLE * 2;
constexpr size_t WS_BIG = WS_XN + (size_t)TOK * DM * 2;
constexpr size_t WS_GDN = WS_BIG + (size_t)TOK * FFD * 2;
constexpr size_t GDN_ITEM = 73728;
constexpr size_t WS_END = WS_GDN + 2048 * GDN_ITEM;

struct Args {
    const float *x, *p, *norm_mix, *w_in, *sg_ln_g, *sg_ln_b, *sg_w, *sg_b, *sc_conv, *gdn_conv, *gdn_a_log, *gdn_dt_bias, *gdn_norm,
        *out_norm_a, *out_norm_b, *w_o, *norm_ffn, *w_ff1, *w_ff2, *norm_ple, *w_ple_gate, *w_ple_proj, *norm_final;
    float* out; unsigned char* ws; int ph_lo, ph_hi, coop, pad;
};

__device__ __forceinline__ unsigned pk2(float lo, float hi) { return pg8::cvt_pk_bf16(lo, hi); }
__device__ __forceinline__ float bf2f(unsigned short v) { return __uint_as_float((unsigned)v << 16); }
__device__ __forceinline__ float bflo(unsigned w) { return __uint_as_float(w << 16); }
__device__ __forceinline__ float bfhi(unsigned w) { return __uint_as_float(w & 0xffff0000u); }
__device__ __forceinline__ float wave_sum(float v) {
#pragma unroll
    for (int o = 1; o < 64; o <<= 1) v += __shfl_xor(v, o);
    return v;
}
__device__ __forceinline__ float sigmoidf_(float x) { return 1.0f / (1.0f + __expf(-x)); }
__device__ __forceinline__ float gelu_tanh(float x) { const float y = 1.5957691216057308f * x * (1.0f + 0.044715f * x * x); return x / (1.0f + __expf(-y)); }
__device__ __forceinline__ bf16x8 pack8(const f32x4 a, const f32x4 b) {
    u32x4 w; w.x = pk2(a[0], a[1]); w.y = pk2(a[2], a[3]); w.z = pk2(b[0], b[1]); w.w = pk2(b[2], b[3]);
    return __builtin_bit_cast(bf16x8, w);
}
__host__ __device__ __forceinline__ int kperm(int d) { return (d & ~31) + 8 * ((d >> 2) & 3) + 4 * ((d >> 4) & 1) + (d & 3); }
#define LDS_WAIT() asm volatile("s_waitcnt lgkmcnt(0)" ::: "memory")

#define EPI_LOOP_BEGIN  _Pragma("unroll") for (int ai = 0; ai < 2; ++ai) _Pragma("unroll") for (int m = 0; m < 4; ++m) { const int row = u.pm * 256 + ai * 128 + wr * 64 + m * 16 + fr; \
                        _Pragma("unroll") for (int bj = 0; bj < 2; ++bj) { const int col = u.pn * 256 + bj * 128 + wc * 32 + 8 * fq; f32x4 v0 = acc[ai][bj][m][0], v1 = acc[ai][bj][m][1];
#define EPI_LOOP_END    } }
#define EPI_ARGS const f32x4 (&acc)[2][2][4][2], const pg8::Unit& u, int wr, int wc, int fr, int fq

struct EpiProj {
    bf16_t* P; float* AB;
    __device__ __forceinline__ void operator()(EPI_ARGS) const {
        if (u.pn < 26) {
            const bool act = u.pn < 4;
            EPI_LOOP_BEGIN
                if (act) {
#pragma unroll
                    for (int e = 0; e < 4; ++e) { v0[e] = gelu_tanh(v0[e]); v1[e] = gelu_tanh(v1[e]); }
                }
                u32x4 w; w.x = pk2(v0[0], v0[1]); w.y = pk2(v0[2], v0[3]); w.z = pk2(v1[0], v1[1]); w.w = pk2(v1[2], v1[3]);
                *(u32x4*)(P + (size_t)row * PJ + col) = w;
            EPI_LOOP_END
        } else {
            if (wc == 0 && fq < 2) {
#pragma unroll
                for (int ai = 0; ai < 2; ++ai)
#pragma unroll
                    for (int m = 0; m < 4; ++m) { const int row = u.pm * 256 + ai * 128 + wr * 64 + m * 16 + fr;
                        *(f32x4*)(AB + (size_t)row * 16 + 8 * fq) = acc[ai][0][m][0]; *(f32x4*)(AB + (size_t)row * 16 + 8 * fq + 4) = acc[ai][0][m][1]; }
            }
        }
    }
};
struct EpiRes {
    const float* base; float* out;
    __device__ __forceinline__ void operator()(EPI_ARGS) const {
        EPI_LOOP_BEGIN
            const size_t off = (size_t)row * DM + col;
            const f32x4 b0 = *(const f32x4*)(base + off), b1 = *(const f32x4*)(base + off + 4);
            *(f32x4*)(out + off) = b0 + v0; *(f32x4*)(out + off + 4) = b1 + v1;
        EPI_LOOP_END
    }
};
struct EpiRelu2 {
    bf16_t* O;
    __device__ __forceinline__ void operator()(EPI_ARGS) const {
        EPI_LOOP_BEGIN
#pragma unroll
            for (int e = 0; e < 4; ++e) { const float a = fmaxf(v0[e], 0.f), b = fmaxf(v1[e], 0.f); v0[e] = a * a; v1[e] = b * b; }
            u32x4 w; w.x = pk2(v0[0], v0[1]); w.y = pk2(v0[2], v0[3]); w.z = pk2(v1[0], v1[1]); w.w = pk2(v1[2], v1[3]);
            *(u32x4*)(O + (size_t)row * FFD + col) = w;
        EPI_LOOP_END
    }
};
struct EpiPlain {
    bf16_t* O;
    __device__ __forceinline__ void operator()(EPI_ARGS) const {
        EPI_LOOP_BEGIN
            u32x4 w; w.x = pk2(v0[0], v0[1]); w.y = pk2(v0[2], v0[3]); w.z = pk2(v1[0], v1[1]); w.w = pk2(v1[2], v1[3]);
            *(u32x4*)(O + (size_t)row * DM + col) = w;
        EPI_LOOP_END
    }
};
struct EpiGate {
    const bf16_t* PP; float* out;
    __device__ __forceinline__ void operator()(EPI_ARGS) const {
        EPI_LOOP_BEGIN
            const size_t off = (size_t)row * DM + col;
            const u32x4 pw = *(const u32x4*)(PP + off);
            const f32x4 b0 = *(const f32x4*)(out + off), b1 = *(const f32x4*)(out + off + 4);
            f32x4 o0, o1;
            o0[0] = b0[0] + bflo(pw.x) * sigmoidf_(v0[0]); o0[1] = b0[1] + bfhi(pw.x) * sigmoidf_(v0[1]);
            o0[2] = b0[2] + bflo(pw.y) * sigmoidf_(v0[2]); o0[3] = b0[3] + bfhi(pw.y) * sigmoidf_(v0[3]);
            o1[0] = b1[0] + bflo(pw.z) * sigmoidf_(v1[0]); o1[1] = b1[1] + bfhi(pw.z) * sigmoidf_(v1[1]);
            o1[2] = b1[2] + bflo(pw.w) * sigmoidf_(v1[2]); o1[3] = b1[3] + bfhi(pw.w) * sigmoidf_(v1[3]);
            *(f32x4*)(out + off) = o0; *(f32x4*)(out + off + 4) = o1;
        EPI_LOOP_END
    }
};

__device__ __forceinline__ void transpose_item(const float* W, int K, int N, int Npad, bf16_t* WT, LAS float* scr, int item, int lane) {
    const int nblk = Npad / 32, kb = item / nblk, nb = item % nblk, k0 = 64 * kb, n0 = 32 * nb;
    const int nn = n0 + (lane & 31); const bool ok = nn < N;
#pragma unroll 8
    for (int i = 0; i < 32; ++i) { const int kk = 2 * i + (lane >> 5); scr[kk * 33 + (lane & 31)] = ok ? W[(size_t)(k0 + kk) * N + nn] : 0.f; }
    LDS_WAIT(); asm volatile("" ::: "memory");
    const int c = lane & 7;
#pragma unroll
    for (int j = 0; j < 4; ++j) { const int n = (lane >> 3) + 8 * j; const LAS float* s = scr + (8 * c) * 33 + n;
        u32x4 o; o.x = pk2(s[0 * 33], s[1 * 33]); o.y = pk2(s[2 * 33], s[3 * 33]); o.z = pk2(s[4 * 33], s[5 * 33]); o.w = pk2(s[6 * 33], s[7 * 33]);
        *(u32x4*)(WT + (size_t)(n0 + n) * K + k0 + 8 * c) = o; }
    LDS_WAIT(); asm volatile("" ::: "memory");
}
__device__ __forceinline__ void rms_row_bf16(const float* xrow, const float* g, bf16_t* orow, int lane) {
    const f32x4* xr = (const f32x4*)xrow + lane; const f32x4* gr = (const f32x4*)g + lane;
    f32x4 v[8]; float s = 0.f;
#pragma unroll
    for (int j = 0; j < 8; ++j) { v[j] = xr[64 * j]; s += (v[j][0] * v[j][0] + v[j][1] * v[j][1]) + (v[j][2] * v[j][2] + v[j][3] * v[j][3]); }
    const float rstd = 1.0f / sqrtf(wave_sum(s) * (1.0f / DM) + EPSF);
    u32x2* o8 = (u32x2*)orow + lane;
#pragma unroll
    for (int j = 0; j < 8; ++j) { const f32x4 gg = gr[64 * j]; u32x2 w; w.x = pk2(v[j][0] * rstd * gg[0], v[j][1] * rstd * gg[1]); w.y = pk2(v[j][2] * rstd * gg[2], v[j][3] * rstd * gg[3]); o8[64 * j] = w; }
}
__device__ __forceinline__ void rms_row_f32(const float* xrow, const float* g, float* orow, int lane) {
    const f32x4* xr = (const f32x4*)xrow + lane; const f32x4* gr = (const f32x4*)g + lane;
    f32x4 v[8]; float s = 0.f;
#pragma unroll
    for (int j = 0; j < 8; ++j) { v[j] = xr[64 * j]; s += (v[j][0] * v[j][0] + v[j][1] * v[j][1]) + (v[j][2] * v[j][2] + v[j][3] * v[j][3]); }
    const float rstd = 1.0f / sqrtf(wave_sum(s) * (1.0f / DM) + EPSF);
    f32x4* o = (f32x4*)orow + lane;
#pragma unroll
    for (int j = 0; j < 8; ++j) { const f32x4 gg = gr[64 * j]; o[64 * j] = v[j] * rstd * gg; }
}

__device__ __forceinline__ void gdn_chunk_item(LAS unsigned char* L, int item, const bf16_t* P, const float* AB, const float* convw, const float* a_log, const float* dt_bias,
                                               unsigned char* GDN, float* GL, int tid) {
    const int n = item & 63, bh = item >> 6, h = bh & 7, b = bh >> 3;
    const int tok0 = b * SEQL + n * 64;
    const int wave = tid >> 6, lane = tid & 63, q4 = lane >> 4, c15 = lane & 15;
    LAS bf16_t* Kb = (LAS bf16_t*)(L);
    LAS bf16_t* Qb = (LAS bf16_t*)(L + 17408);
    LAS float* Af = (LAS float*)(L + 34816);
    LAS float* X = (LAS float*)(L + 51200);
    LAS float* gcs = (LAS float*)(L + 116736);
    LAS float* bts = gcs + 64;
    LAS float* egc = gcs + 128;
    unsigned char* gbase = GDN + (size_t)item * GDN_ITEM;
    bf16_t* g_qexp = (bf16_t*)gbase; bf16_t* g_kcd = (bf16_t*)(gbase + 16384); bf16_t* g_ktT = (bf16_t*)(gbase + 32768);
    bf16_t* g_valT = (bf16_t*)(gbase + 49152); bf16_t* g_intra = (bf16_t*)(gbase + 65536);

    if (wave == 0) {
        const float a = AB[(size_t)(tok0 + lane) * 16 + h], bb = AB[(size_t)(tok0 + lane) * 16 + 8 + h];
        const float xs = a + dt_bias[h];
        const float sp = xs > 20.f ? xs : log1pf(__expf(xs));
        float c = -__expf(a_log[h]) * sp;
#pragma unroll
        for (int o = 1; o < 64; o <<= 1) { const float t = __shfl_up(c, o); if (lane >= o) c += t; }
        gcs[lane] = c; bts[lane] = sigmoidf_(bb); egc[lane] = __expf(c);
    }
    __syncthreads();
    if (wave < 6) {
        const int cgi = tid % 48, seg = tid / 48, which = cgi >> 4, cc = (cgi & 15) * 8;
        const int col = C_Q + which * 1024 + h * 128 + cc;
        float w[4][8];
#pragma unroll
        for (int j = 0; j < 4; ++j) { const f32x4 a = *(const f32x4*)(convw + j * 3072 + which * 1024 + h * 128 + cc), bq = *(const f32x4*)(convw + j * 3072 + which * 1024 + h * 128 + cc + 4);
            w[j][0] = a[0]; w[j][1] = a[1]; w[j][2] = a[2]; w[j][3] = a[3]; w[j][4] = bq[0]; w[j][5] = bq[1]; w[j][6] = bq[2]; w[j][7] = bq[3]; }
        float x0[8], x1[8], x2[8], x3[8];
        auto ldrow = [&](int r, float (&dst)[8]) {
            if (n * 64 + r >= 0) { const u32x4 v = *(const u32x4*)(P + (size_t)(tok0 + r) * PJ + col);
                dst[0] = bflo(v.x); dst[1] = bfhi(v.x); dst[2] = bflo(v.y); dst[3] = bfhi(v.y); dst[4] = bflo(v.z); dst[5] = bfhi(v.z); dst[6] = bflo(v.w); dst[7] = bfhi(v.w); }
            else {
#pragma unroll
                for (int e = 0; e < 8; ++e) dst[e] = 0.f; }
        };
        ldrow(seg * 8 - 3, x0); ldrow(seg * 8 - 2, x1); ldrow(seg * 8 - 1, x2);
#pragma unroll
        for (int i = 0; i < 8; ++i) {
            const int t = seg * 8 + i;
            ldrow(t, x3);
            float y[8]; float ss = 0.f;
#pragma unroll
            for (int e = 0; e < 8; ++e) { const float c = w[0][e] * x0[e] + w[1][e] * x1[e] + w[2][e] * x2[e] + w[3][e] * x3[e]; y[e] = c * sigmoidf_(c); ss += y[e] * y[e]; }
            ss += __shfl_xor(ss, 1); ss += __shfl_xor(ss, 2); ss += __shfl_xor(ss, 4); ss += __shfl_xor(ss, 8);
            const float rn = 1.0f / sqrtf(ss + EPSF);
            const float bt = bts[t], eg = egc[t];
            if (which == 0) {
                const float s = rn * 0.08838834764831845f;
                u32x4 o; o.x = pk2(y[0] * s, y[1] * s); o.y = pk2(y[2] * s, y[3] * s); o.z = pk2(y[4] * s, y[5] * s); o.w = pk2(y[6] * s, y[7] * s);
                *(LAS u32x4*)(Qb + t * 136 + cc) = o;
            } else if (which == 1) {
                u32x4 o; o.x = pk2(y[0] * rn, y[1] * rn); o.y = pk2(y[2] * rn, y[3] * rn); o.z = pk2(y[4] * rn, y[5] * rn); o.w = pk2(y[6] * rn, y[7] * rn);
                *(LAS u32x4*)(Kb + t * 136 + cc) = o;
                const float s = rn * bt * eg;
                *(LAS f32x4*)(X + t * 256 + 128 + cc) = (f32x4){y[0] * s, y[1] * s, y[2] * s, y[3] * s};
                *(LAS f32x4*)(X + t * 256 + 128 + cc + 4) = (f32x4){y[4] * s, y[5] * s, y[6] * s, y[7] * s};
            } else {
                *(LAS f32x4*)(X + t * 256 + cc) = (f32x4){y[0] * bt, y[1] * bt, y[2] * bt, y[3] * bt};
                *(LAS f32x4*)(X + t * 256 + cc + 4) = (f32x4){y[4] * bt, y[5] * bt, y[6] * bt, y[7] * bt};
            }
#pragma unroll
            for (int e = 0; e < 8; ++e) { x0[e] = x1[e]; x1[e] = x2[e]; x2[e] = x3[e]; }
        }
    }
    __syncthreads();
    {
        const int ti = wave >> 1;
        bf16x8 ak[4], aq[4];
#pragma unroll
        for (int kb = 0; kb < 4; ++kb) { ak[kb] = *(const LAS bf16x8*)(Kb + (16 * ti + c15) * 136 + 32 * kb + 8 * q4); aq[kb] = *(const LAS bf16x8*)(Qb + (16 * ti + c15) * 136 + 32 * kb + 8 * q4); }
#pragma unroll
        for (int jj = 0; jj < 2; ++jj) {
            const int tj = 2 * (wave & 1) + jj;
            f32x4 dk = (f32x4){0.f, 0.f, 0.f, 0.f}, dq = (f32x4){0.f, 0.f, 0.f, 0.f};
#pragma unroll
            for (int kb = 0; kb < 4; ++kb) { const bf16x8 bk = *(const LAS bf16x8*)(Kb + (16 * tj + c15) * 136 + 32 * kb + 8 * q4);
                dk = __builtin_amdgcn_mfma_f32_16x16x32_bf16(ak[kb], bk, dk, 0, 0, 0); dq = __builtin_amdgcn_mfma_f32_16x16x32_bf16(aq[kb], bk, dq, 0, 0, 0); }
            const int j = 16 * tj + c15; const float gj = gcs[j];
#pragma unroll
            for (int r = 0; r < 4; ++r) { const int i = 16 * ti + 4 * q4 + r;
                const float dec = (j <= i) ? __expf(fminf(gcs[i] - gj, 0.f)) : 0.f;
                Af[i * 64 + j] = (j < i) ? bts[i] * dk[r] * dec : 0.f;
                g_intra[i * 64 + kperm(j)] = (bf16_t)(pk2(dq[r] * dec, 0.f) & 0xffffu); }
        }
    }
    __syncthreads();
    if (tid < 256) {
        const int c = tid;
        float x[64];
#pragma unroll
        for (int i = 0; i < 64; ++i) {
            float a = X[i * 256 + c];
#pragma unroll
            for (int j = 0; j < i; ++j) a -= Af[i * 64 + j] * x[j];
            x[i] = a;
        }
        if (c < 128) {
#pragma unroll
            for (int k = 0; k < 8; ++k) { u32x4 o; o.x = pk2(x[8 * k], x[8 * k + 1]); o.y = pk2(x[8 * k + 2], x[8 * k + 3]); o.z = pk2(x[8 * k + 4], x[8 * k + 5]); o.w = pk2(x[8 * k + 6], x[8 * k + 7]);
                *(u32x4*)(g_valT + c * 64 + 8 * k) = o; }
        } else {
            const int pd = kperm(c - 128);
#pragma unroll
            for (int i = 0; i < 64; ++i) g_kcd[i * 128 + pd] = (bf16_t)(pk2(x[i], 0.f) & 0xffffu);
        }
    } else {
        const int t2 = tid - 256;
        {
            const int l = t2 >> 2, kb = t2 & 3; const float eg = egc[l];
#pragma unroll
            for (int k4 = 0; k4 < 4; ++k4) { float v[8];
#pragma unroll
                for (int e = 0; e < 8; ++e) { const int pos = 8 * k4 + e, qq = pos >> 3, jh = (pos >> 2) & 1, r = pos & 3; v[e] = bf2f(Qb[l * 136 + 32 * kb + 16 * jh + 4 * qq + r]) * eg; }
                u32x4 o; o.x = pk2(v[0], v[1]); o.y = pk2(v[2], v[3]); o.z = pk2(v[4], v[5]); o.w = pk2(v[6], v[7]);
                *(u32x4*)(g_qexp + l * 128 + 32 * kb + 8 * k4) = o; }
        }
        {
            const int d = t2 >> 1, kb2 = t2 & 1; const float glast = gcs[63];
#pragma unroll
            for (int k4 = 0; k4 < 4; ++k4) { float v[8];
#pragma unroll
                for (int e = 0; e < 8; ++e) { const int pos = 8 * k4 + e, qq = pos >> 3, jh = (pos >> 2) & 1, r = pos & 3; const int l = 32 * kb2 + 16 * jh + 4 * qq + r; v[e] = bf2f(Kb[l * 136 + d]) * __expf(glast - gcs[l]); }
                u32x4 o; o.x = pk2(v[0], v[1]); o.y = pk2(v[2], v[3]); o.z = pk2(v[4], v[5]); o.w = pk2(v[6], v[7]);
                *(u32x4*)(g_ktT + d * 64 + 32 * kb2 + 8 * k4) = o; }
        }
        if (t2 == 0) GL[item] = egc[63];
    }
    __syncthreads();
}

__device__ __forceinline__ void gdn_scan(LAS unsigned char* L, int bh, const unsigned char* GDN, const float* GL, const bf16_t* P, const float* gnorm, bf16_t* MIX, int tid) {
    const int h = bh & 7, b = bh >> 3;
    const int wave = tid >> 6, lane = tid & 63, q4 = lane >> 4, c15 = lane & 15;
    LAS unsigned char* Lq = L;
    LAS unsigned char* Lk = L + 17408;
    LAS unsigned char* Lt = L + 34816;
    LAS unsigned char* Li = L + 53248;
    LAS float* Lo = (LAS float*)(L + 62464);
    f32x4 S[8];
#pragma unroll
    for (int T = 0; T < 8; ++T) S[T] = (f32x4){0.f, 0.f, 0.f, 0.f};
    u32x4 pf[7];
    const int c0 = tid, c1 = tid + 512;
#define SCAN_LOAD(nn) do { const unsigned char* gb_ = GDN + (size_t)(bh * 64 + (nn)) * GDN_ITEM; \
        pf[0] = *(const u32x4*)(gb_ + c0 * 16); pf[1] = *(const u32x4*)(gb_ + c1 * 16); \
        pf[2] = *(const u32x4*)(gb_ + 16384 + c0 * 16); pf[3] = *(const u32x4*)(gb_ + 16384 + c1 * 16); \
        pf[4] = *(const u32x4*)(gb_ + 32768 + c0 * 16); pf[5] = *(const u32x4*)(gb_ + 32768 + c1 * 16); \
        pf[6] = *(const u32x4*)(gb_ + 65536 + c0 * 16); } while (0)
#define SCAN_STORE() do { \
        *(LAS u32x4*)(Lq + (c0 >> 4) * 272 + (c0 & 15) * 16) = pf[0]; *(LAS u32x4*)(Lq + (c1 >> 4) * 272 + (c1 & 15) * 16) = pf[1]; \
        *(LAS u32x4*)(Lk + (c0 >> 4) * 272 + (c0 & 15) * 16) = pf[2]; *(LAS u32x4*)(Lk + (c1 >> 4) * 272 + (c1 & 15) * 16) = pf[3]; \
        *(LAS u32x4*)(Lt + (c0 >> 3) * 144 + (c0 & 7) * 16) = pf[4]; *(LAS u32x4*)(Lt + (c1 >> 3) * 144 + (c1 & 7) * 16) = pf[5]; \
        *(LAS u32x4*)(Li + (c0 >> 3) * 144 + (c0 & 7) * 16) = pf[6]; } while (0)
    SCAN_LOAD(0); SCAN_STORE();
    __syncthreads();
    for (int n = 0; n < 64; ++n) {
        if (n + 1 < 64) SCAN_LOAD(n + 1);
        const unsigned char* gb = GDN + (size_t)(bh * 64 + n) * GDN_ITEM;
        const float gl = GL[bh * 64 + n];
        u32x2 vraw[4];
#pragma unroll
        for (int t = 0; t < 4; ++t) vraw[t] = *(const u32x2*)(gb + 49152 + ((16 * wave + c15) * 64 + 16 * t + 4 * q4) * 2);
        bf16x8 Sp[4];
#pragma unroll
        for (int kb = 0; kb < 4; ++kb) Sp[kb] = pack8(S[2 * kb], S[2 * kb + 1]);
        f32x4 Vn[4];
#pragma unroll
        for (int t = 0; t < 4; ++t) {
            f32x4 pa = (f32x4){0.f, 0.f, 0.f, 0.f};
#pragma unroll
            for (int kb = 0; kb < 4; ++kb) { const bf16x8 a = *(const LAS bf16x8*)(Lk + (16 * t + c15) * 272 + (32 * kb + 8 * q4) * 2); pa = __builtin_amdgcn_mfma_f32_16x16x32_bf16(a, Sp[kb], pa, 0, 0, 0); }
            Vn[t] = (f32x4){bflo(vraw[t].x), bfhi(vraw[t].x), bflo(vraw[t].y), bfhi(vraw[t].y)} - pa;
        }
        bf16x8 Vp[2];
        Vp[0] = pack8(Vn[0], Vn[1]); Vp[1] = pack8(Vn[2], Vn[3]);
#pragma unroll
        for (int t = 0; t < 4; ++t) {
            f32x4 o = (f32x4){0.f, 0.f, 0.f, 0.f};
#pragma unroll
            for (int kb = 0; kb < 4; ++kb) { const bf16x8 a = *(const LAS bf16x8*)(Lq + (16 * t + c15) * 272 + (32 * kb + 8 * q4) * 2); o = __builtin_amdgcn_mfma_f32_16x16x32_bf16(a, Sp[kb], o, 0, 0, 0); }
#pragma unroll
            for (int kb = 0; kb < 2; ++kb) { const bf16x8 a = *(const LAS bf16x8*)(Li + (16 * t + c15) * 144 + (32 * kb + 8 * q4) * 2); o = __builtin_amdgcn_mfma_f32_16x16x32_bf16(a, Vp[kb], o, 0, 0, 0); }
#pragma unroll
            for (int r = 0; r < 4; ++r) Lo[(16 * t + 4 * q4 + r) * 132 + 16 * wave + c15] = o[r];
        }
#pragma unroll
        for (int T = 0; T < 8; ++T) {
            f32x4 s = S[T] * gl;
#pragma unroll
            for (int kb = 0; kb < 2; ++kb) { const bf16x8 a = *(const LAS bf16x8*)(Lt + (16 * T + c15) * 144 + (32 * kb + 8 * q4) * 2); s = __builtin_amdgcn_mfma_f32_16x16x32_bf16(a, Vp[kb], s, 0, 0, 0); }
            S[T] = s;
        }
        __syncthreads();
        {
            const int l = tid >> 3, part = tid & 7; const size_t tok = (size_t)b * SEQL + n * 64 + l;
            f32x4 ov[4]; float ss = 0.f;
#pragma unroll
            for (int k = 0; k < 4; ++k) { ov[k] = *(const LAS f32x4*)(Lo + l * 132 + part * 16 + 4 * k); ss += (ov[k][0] * ov[k][0] + ov[k][1] * ov[k][1]) + (ov[k][2] * ov[k][2] + ov[k][3] * ov[k][3]); }
            ss += __shfl_xor(ss, 1); ss += __shfl_xor(ss, 2); ss += __shfl_xor(ss, 4);
            const float rstd = 1.0f / sqrtf(ss * (1.0f / 128.f) + EPSF);
            const u32x4 z0 = *(const u32x4*)(P + tok * PJ + C_Z + h * 128 + part * 16), z1 = *(const u32x4*)(P + tok * PJ + C_Z + h * 128 + part * 16 + 8);
            float zz[16] = {bflo(z0.x), bfhi(z0.x), bflo(z0.y), bfhi(z0.y), bflo(z0.z), bfhi(z0.z), bflo(z0.w), bfhi(z0.w), bflo(z1.x), bfhi(z1.x), bflo(z1.y), bfhi(z1.y), bflo(z1.z), bfhi(z1.z), bflo(z1.w), bfhi(z1.w)};
            float res[16];
#pragma unroll
            for (int k = 0; k < 4; ++k) { const f32x4 gg = *(const f32x4*)(gnorm + part * 16 + 4 * k);
#pragma unroll
                for (int e = 0; e < 4; ++e) { const float z = zz[4 * k + e]; res[4 * k + e] = ov[k][e] * rstd * gg[e] * (z * sigmoidf_(z)); } }
            u32x4 w0, w1; w0.x = pk2(res[0], res[1]); w0.y = pk2(res[2], res[3]); w0.z = pk2(res[4], res[5]); w0.w = pk2(res[6], res[7]);
            w1.x = pk2(res[8], res[9]); w1.y = pk2(res[10], res[11]); w1.z = pk2(res[12], res[13]); w1.w = pk2(res[14], res[15]);
            *(u32x4*)(MIX + tok * DM + 1024 + h * 128 + part * 16) = w0; *(u32x4*)(MIX + tok * DM + 1024 + h * 128 + part * 16 + 8) = w1;
        }
        if (n + 1 < 64) SCAN_STORE();
        __syncthreads();
    }
#undef SCAN_LOAD
#undef SCAN_STORE
}

__device__ __forceinline__ void sgu_item(LAS unsigned char* L, int item, const bf16_t* P, const float* sgw, const float* sgb, const float* lng, const float* lnb, const float* ona, bf16_t* MIX, int tid) {
    const int h = item & 3, n = (item >> 2) & 31, b = item >> 7;
    const size_t tok0 = (size_t)b * SEQL + n * 128;
    const int wave = tid >> 6, lane = tid & 63, q4 = lane >> 4, c15 = lane & 15;
    LAS bf16_t* Wl = (LAS bf16_t*)L;
    LAS bf16_t* Vt = (LAS bf16_t*)(L + 34816);
    {
        const int t = tid >> 2, s0 = (tid & 3) * 32; const float* wr = sgw + (size_t)h * 16384 + t * 128 + s0;
#pragma unroll
        for (int k = 0; k < 4; ++k) { const f32x4 a = *(const f32x4*)(wr + 8 * k), c = *(const f32x4*)(wr + 8 * k + 4); float v[8] = {a[0], a[1], a[2], a[3], c[0], c[1], c[2], c[3]};
#pragma unroll
            for (int e = 0; e < 8; ++e) v[e] = (s0 + 8 * k + e <= t) ? v[e] : 0.f;
            u32x4 o; o.x = pk2(v[0], v[1]); o.y = pk2(v[2], v[3]); o.z = pk2(v[4], v[5]); o.w = pk2(v[6], v[7]);
            *(LAS u32x4*)(Wl + t * 136 + s0 + 8 * k) = o; }
    }
    {
        const int s = tid >> 2, d0 = (tid & 3) * 32; const bf16_t* vr = P + (tok0 + s) * PJ + C_V + h * 128 + d0;
        float v[32]; float sm = 0.f;
#pragma unroll
        for (int k = 0; k < 4; ++k) { const u32x4 w = *(const u32x4*)(vr + 8 * k); v[8 * k] = bflo(w.x); v[8 * k + 1] = bfhi(w.x); v[8 * k + 2] = bflo(w.y); v[8 * k + 3] = bfhi(w.y); v[8 * k + 4] = bflo(w.z); v[8 * k + 5] = bfhi(w.z); v[8 * k + 6] = bflo(w.w); v[8 * k + 7] = bfhi(w.w); }
#pragma unroll
        for (int e = 0; e < 32; ++e) sm += v[e];
        sm += __shfl_xor(sm, 1); sm += __shfl_xor(sm, 2);
        const float mu = sm * (1.0f / 128.f); float sq = 0.f;
#pragma unroll
        for (int e = 0; e < 32; ++e) { v[e] -= mu; sq += v[e] * v[e]; }
        sq += __shfl_xor(sq, 1); sq += __shfl_xor(sq, 2);
        const float rstd = 1.0f / sqrtf(sq * (1.0f / 128.f) + EPSF);
#pragma unroll
        for (int e = 0; e < 32; ++e) { const float y = v[e] * rstd * lng[h * 128 + d0 + e] + lnb[h * 128 + d0 + e]; Vt[(d0 + e) * 136 + s] = (bf16_t)(pk2(y, 0.f) & 0xffffu); }
    }
    __syncthreads();
    {
        f32x4 D[8];
#pragma unroll
        for (int tj = 0; tj < 8; ++tj) D[tj] = (f32x4){0.f, 0.f, 0.f, 0.f};
        const int nkb = (wave >> 1) + 1;
        for (int kb = 0; kb < nkb; ++kb) {
            const bf16x8 a = *(const LAS bf16x8*)(Wl + (16 * wave + c15) * 136 + 32 * kb + 8 * q4);
#pragma unroll
            for (int tj = 0; tj < 8; ++tj) { const bf16x8 bv = *(const LAS bf16x8*)(Vt + (16 * tj + c15) * 136 + 32 * kb + 8 * q4); D[tj] = __builtin_amdgcn_mfma_f32_16x16x32_bf16(a, bv, D[tj], 0, 0, 0); }
        }
        float ss[4] = {0.f, 0.f, 0.f, 0.f};
#pragma unroll
        for (int r = 0; r < 4; ++r) { const int t = 16 * wave + 4 * q4 + r; const float bias = sgb[h * 128 + t]; const bf16_t* ur = P + (tok0 + t) * PJ + C_U + h * 128 + c15;
#pragma unroll
            for (int tj = 0; tj < 8; ++tj) { const float uu = bf2f(ur[16 * tj]); const float y = uu * (D[tj][r] + bias); D[tj][r] = y; ss[r] += y * y; } }
#pragma unroll
        for (int r = 0; r < 4; ++r) { float s = ss[r]; s += __shfl_xor(s, 1); s += __shfl_xor(s, 2); s += __shfl_xor(s, 4); s += __shfl_xor(s, 8); ss[r] = 1.0f / sqrtf(s * (1.0f / 128.f) + EPSF); }
#pragma unroll
        for (int r = 0; r < 4; ++r) { const int t = 16 * wave + 4 * q4 + r; bf16_t* orow = MIX + (tok0 + t) * DM + h * 128 + c15;
#pragma unroll
            for (int tj = 0; tj < 8; ++tj) orow[16 * tj] = (bf16_t)(pk2(D[tj][r] * ss[r] * ona[h * 128 + 16 * tj + c15], 0.f) & 0xffffu); }
    }
    __syncthreads();
}

__device__ __forceinline__ void unpack8(const u32x4 w, float (&v)[8]) { v[0] = bflo(w.x); v[1] = bfhi(w.x); v[2] = bflo(w.y); v[3] = bfhi(w.y); v[4] = bflo(w.z); v[5] = bfhi(w.z); v[6] = bflo(w.w); v[7] = bfhi(w.w); }
__device__ __forceinline__ void shortconv_token(int tok, const bf16_t* P, const float* scw, const float* onb, bf16_t* MIX, int lane) {
    const int c = lane * 8, pos = tok & (SEQL - 1);
    const bf16_t* row = P + (size_t)tok * PJ;
    float gb[8], acc[8];
    unpack8(*(const u32x4*)(row + C_GB + c), gb);
#pragma unroll
    for (int e = 0; e < 8; ++e) acc[e] = 0.f;
#pragma unroll
    for (int j = 0; j < 3; ++j) {
        const int back = 2 - j;
        if (pos - back >= 0) { float g[8], xi[8]; const bf16_t* r2 = row - (size_t)back * PJ;
            unpack8(*(const u32x4*)(r2 + C_GC + c), g); unpack8(*(const u32x4*)(r2 + C_XI + c), xi);
            const f32x4 w0 = *(const f32x4*)(scw + j * 512 + c), w1 = *(const f32x4*)(scw + j * 512 + c + 4);
#pragma unroll
            for (int e = 0; e < 4; ++e) { acc[e] += w0[e] * (g[e] * xi[e]); acc[4 + e] += w1[e] * (g[4 + e] * xi[4 + e]); } }
    }
    float ss = 0.f;
#pragma unroll
    for (int e = 0; e < 8; ++e) { acc[e] *= gb[e]; ss += acc[e] * acc[e]; }
    ss += __shfl_xor(ss, 1); ss += __shfl_xor(ss, 2); ss += __shfl_xor(ss, 4); ss += __shfl_xor(ss, 8);
    const float rstd = 1.0f / sqrtf(ss * (1.0f / 128.f) + EPSF);
    const f32x4 g0 = *(const f32x4*)(onb + c), g1 = *(const f32x4*)(onb + c + 4);
    u32x4 o; o.x = pk2(acc[0] * rstd * g0[0], acc[1] * rstd * g0[1]); o.y = pk2(acc[2] * rstd * g0[2], acc[3] * rstd * g0[3]);
    o.z = pk2(acc[4] * rstd * g1[0], acc[5] * rstd * g1[1]); o.w = pk2(acc[6] * rstd * g1[2], acc[7] * rstd * g1[3]);
    *(u32x4*)(MIX + (size_t)tok * DM + 512 + c) = o;
}

typedef const char __attribute__((address_space(4))) kchar_t;
#define KARG(field) (*(decltype(Args::field) const __attribute__((address_space(4)))*)(kp + offsetof(Args, field)))
#define PHASE_BEGIN int tid = threadIdx.x; asm volatile("" : "+v"(tid)); const int lane = tid & 63, wave = __builtin_amdgcn_readfirstlane(tid >> 6); \
    const int G = gridDim.x, bx = blockIdx.x, gw = bx * NWAVES + wave, NGW = G * NWAVES; (void)lane; (void)gw; (void)NGW; \
    kchar_t* kp = (kchar_t*)__builtin_amdgcn_kernarg_segment_ptr(); asm volatile("" : "+s"(kp)); \
    unsigned char* ws = KARG(ws); (void)ws; int l = lsel; asm volatile("" : "+s"(l));
#define WSP(T, off) ((T*)(ws + (off)))
__global__ void __launch_bounds__(NTHREADS, 2) hybrid_fwd(Args a) {
    extern __shared__ __attribute__((aligned(16))) unsigned char lds_raw[];
    LAS unsigned char* L = (LAS unsigned char*)lds_raw;
    const int lo = a.ph_lo, hi = a.ph_hi, coop = a.coop;
#ifndef PH_MASK
#define PH_MASK 0xFFFFu
#endif
#define IN(k) (((PH_MASK >> ((k) >= 20 ? 10 : (k) % 10)) & 1u) && lo <= (k) && (k) < hi)
#define SEAM() do { if (coop) cg::this_grid().sync(); else __syncthreads(); } while (0)

#pragma unroll 1
    for (int lsel = 0; lsel < 2; ++lsel) {
        const int pb = lsel * 10;
        if (IN(pb + 0)) {
            PHASE_BEGIN
            LAS float* scr = (LAS float*)(L + wave * 16384);
            constexpr int I_IN = 32 * (INP / 32), I_O = 32 * 64, I_1 = 32 * 256, I_2 = 128 * 64, I_G = 32 * 64, I_P = 4 * 64;
            constexpr int NITEMS = I_IN + I_O + I_1 + I_2 + I_G + I_P;
            for (int it = gw; it < NITEMS; it += NGW) {
                int r = it;
                if (r < I_IN) { transpose_item(KARG(w_in) + (size_t)l * DM * INC, DM, INC, INP, WSP(bf16_t, WS_WIN), scr, r, lane); continue; } r -= I_IN;
                if (r < I_O) { transpose_item(KARG(w_o) + (size_t)l * DM * DM, DM, DM, DM, WSP(bf16_t, WS_WO), scr, r, lane); continue; } r -= I_O;
                if (r < I_1) { transpose_item(KARG(w_ff1) + (size_t)l * DM * FFD, DM, FFD, FFD, WSP(bf16_t, WS_W1), scr, r, lane); continue; } r -= I_1;
                if (r < I_2) { transpose_item(KARG(w_ff2) + (size_t)l * DM * FFD, FFD, DM, DM, WSP(bf16_t, WS_W2), scr, r, lane); continue; } r -= I_2;
                if (r < I_G) { transpose_item(KARG(w_ple_gate) + (size_t)l * DM * DM, DM, DM, DM, WSP(bf16_t, WS_WG), scr, r, lane); continue; } r -= I_G;
                transpose_item(KARG(w_ple_proj) + (size_t)l * PLE * DM, PLE, DM, DM, WSP(bf16_t, WS_WP), scr, r, lane);
            }
            {
                const f32x4* src = (const f32x4*)(KARG(p) + (size_t)l * TOK * PLE); u32x2* dst = WSP(u32x2, WS_P16);
                for (int i = bx * NTHREADS + tid; i < TOK * PLE / 4; i += G * NTHREADS) { const f32x4 v = src[i]; u32x2 w; w.x = pk2(v[0], v[1]); w.y = pk2(v[2], v[3]); dst[i] = w; }
            }
            const float* hsrc = (l == 0) ? KARG(x) : (const float*)KARG(out);
            for (int m = gw; m < TOK; m += NGW) rms_row_bf16(hsrc + (size_t)m * DM, KARG(norm_mix) + l * DM, WSP(bf16_t, WS_XN) + (size_t)m * DM, lane);
        }
        if (IN(pb + 0) && IN(pb + 1)) SEAM();
        if (IN(pb + 1)) {
            PHASE_BEGIN
            pg8::Gemm g{WSP(bf16_t, WS_XN), WSP(bf16_t, WS_WIN), TOK, INP, DM}; pg8::StaticOrder S; S.init(TOK, INP, G, bx);
            EpiProj E{WSP(bf16_t, WS_BIG), WSP(float, WS_AB)};
            pg8::gemm_phase<EpiProj>(L, g, S, E, tid);
        }
        if (IN(pb + 1) && IN(pb + 2)) SEAM();
        if (IN(pb + 2)) {
            PHASE_BEGIN
            for (int it = bx; it < 2048; it += G)
                gdn_chunk_item(L, it, WSP(bf16_t, WS_BIG), WSP(float, WS_AB), KARG(gdn_conv) + (size_t)l * 4 * 3072, KARG(gdn_a_log) + l * 8, KARG(gdn_dt_bias) + l * 8, ws + WS_GDN, WSP(float, WS_GL), tid);
        }
        if (IN(pb + 2) && IN(pb + 3)) SEAM();
        if (IN(pb + 3)) {
            PHASE_BEGIN
            const int nscan = (G > 32) ? 32 : 0;
            if (bx < nscan) {
                gdn_scan(L, bx, ws + WS_GDN, WSP(float, WS_GL), WSP(bf16_t, WS_BIG), KARG(gdn_norm) + l * 128, WSP(bf16_t, WS_XN), tid);
            } else {
                if (nscan == 0) { for (int bh = bx; bh < 32; bh += G) gdn_scan(L, bh, ws + WS_GDN, WSP(float, WS_GL), WSP(bf16_t, WS_BIG), KARG(gdn_norm) + l * 128, WSP(bf16_t, WS_XN), tid); }
                const int rb = bx - nscan, RG = G - nscan;
                for (int it = rb; it < 512; it += RG)
                    sgu_item(L, it, WSP(bf16_t, WS_BIG), KARG(sg_w) + (size_t)l * 4 * 16384, KARG(sg_b) + l * 512, KARG(sg_ln_g) + l * 512, KARG(sg_ln_b) + l * 512, KARG(out_norm_a) + l * 512, WSP(bf16_t, WS_XN), tid);
                for (int tk = rb * NWAVES + wave; tk < TOK; tk += RG * NWAVES)
                    shortconv_token(tk, WSP(bf16_t, WS_BIG), KARG(sc_conv) + l * 3 * 512, KARG(out_norm_b) + l * 512, WSP(bf16_t, WS_XN), lane);
            }
        }
        if (IN(pb + 3) && IN(pb + 4)) SEAM();
        if (IN(pb + 4)) {
            PHASE_BEGIN
            pg8::Gemm g{WSP(bf16_t, WS_XN), WSP(bf16_t, WS_WO), TOK, DM, DM}; pg8::StaticOrder S; S.init(TOK, DM, G, bx);
            const float* hsrc = (l == 0) ? KARG(x) : (const float*)KARG(out);
            EpiRes E{hsrc, KARG(out)};
            pg8::gemm_phase<EpiRes>(L, g, S, E, tid);
        }
        if (IN(pb + 4) && IN(pb + 5)) SEAM();
        if (IN(pb + 5)) {
            PHASE_BEGIN
            for (int m = gw; m < TOK; m += NGW) rms_row_bf16(KARG(out) + (size_t)m * DM, KARG(norm_ffn) + l * DM, WSP(bf16_t, WS_XN) + (size_t)m * DM, lane);
        }
        if (IN(pb + 5) && IN(pb + 6)) SEAM();
        if (IN(pb + 6)) {
            PHASE_BEGIN
            pg8::Gemm g{WSP(bf16_t, WS_XN), WSP(bf16_t, WS_W1), TOK, FFD, DM}; pg8::StaticOrder S; S.init(TOK, FFD, G, bx);
            EpiRelu2 E{WSP(bf16_t, WS_BIG)};
            pg8::gemm_phase<EpiRelu2>(L, g, S, E, tid);
        }
        if (IN(pb + 6) && IN(pb + 7)) SEAM();
        if (IN(pb + 7)) {
            PHASE_BEGIN
            pg8::Gemm g{WSP(bf16_t, WS_BIG), WSP(bf16_t, WS_W2), TOK, DM, FFD}; pg8::StaticOrder S; S.init(TOK, DM, G, bx);
            EpiRes E{KARG(out), KARG(out)};
            pg8::gemm_phase<EpiRes>(L, g, S, E, tid);
        }
        if (IN(pb + 7) && IN(pb + 8)) SEAM();
        if (IN(pb + 8)) {
            PHASE_BEGIN
            for (int m = gw; m < TOK; m += NGW) rms_row_bf16(KARG(out) + (size_t)m * DM, KARG(norm_ple) + l * DM, WSP(bf16_t, WS_XN) + (size_t)m * DM, lane);
        }
        if (IN(pb + 8)) {
            __syncthreads();
            PHASE_BEGIN
            pg8::Gemm g{WSP(bf16_t, WS_P16), WSP(bf16_t, WS_WP), TOK, DM, PLE}; pg8::StaticOrder S; S.init(TOK, DM, G, bx);
            EpiPlain E{WSP(bf16_t, WS_BIG)};
            pg8::gemm_phase<EpiPlain>(L, g, S, E, tid);
        }
        if (IN(pb + 8) && IN(pb + 9)) SEAM();
        if (IN(pb + 9)) {
            PHASE_BEGIN
            pg8::Gemm g{WSP(bf16_t, WS_XN), WSP(bf16_t, WS_WG), TOK, DM, DM}; pg8::StaticOrder S; S.init(TOK, DM, G, bx);
            EpiGate E{WSP(bf16_t, WS_BIG), KARG(out)};
            pg8::gemm_phase<EpiGate>(L, g, S, E, tid);
        }
        if (IN(pb + 9) && IN(pb + 10)) SEAM();
    }
    if (IN(20)) {
        const int lsel = 0;
        PHASE_BEGIN
        for (int m = gw; m < TOK; m += NGW) rms_row_f32(KARG(out) + (size_t)m * DM, KARG(norm_final), KARG(out) + (size_t)m * DM, lane);
    }
#undef IN
#undef SEAM
}

extern "C" void kernel_launch(void* const* d_in, const int* in_sizes, int n_in, void* d_out, int out_size, void* d_ws, size_t ws_size, hipStream_t stream) {
    static int grid = 0;
    if (grid == 0) {
        if (n_in != 23 || out_size != TOK * DM || ws_size < WS_END) { fprintf(stderr, "kernel_launch: unexpected shapes (n_in %d out %d ws %zu need %zu)\n", n_in, out_size, ws_size, (size_t)WS_END); grid = -1; return; }
        int dev = 0, cus = 0, per_cu = 0;
        hipGetDevice(&dev);
        hipDeviceGetAttribute(&cus, hipDeviceAttributeMultiprocessorCount, dev);
        if (hipFuncSetAttribute((const void*)hybrid_fwd, hipFuncAttributeMaxDynamicSharedMemorySize, LDS_BYTES) != hipSuccess) { fprintf(stderr, "kernel_launch: hipFuncSetAttribute failed\n"); grid = -1; return; }
        if (hipOccupancyMaxActiveBlocksPerMultiprocessor(&per_cu, (const void*)hybrid_fwd, NTHREADS, LDS_BYTES) != hipSuccess || per_cu < 1) { fprintf(stderr, "kernel_launch: occupancy query gave %d\n", per_cu); per_cu = 1; }
        (void)hipGetLastError();
        grid = cus * per_cu;
    }
    if (grid < 0) return;
    Args a{};
    const float** f = (const float**)&a;
    for (int i = 0; i < 23; ++i) f[i] = (const float*)d_in[i];
    a.out = (float*)d_out; a.ws = (unsigned char*)d_ws;
#if MK_COOP
    a.ph_lo = 0; a.ph_hi = 21; a.coop = 1;
    void* args[] = {&a};
    hipError_t e = hipLaunchCooperativeKernel((const void*)hybrid_fwd, dim3(grid), dim3(NTHREADS), args, LDS_BYTES, stream);
    if (e != hipSuccess) fprintf(stderr, "cooperative launch failed: %s (grid %d)\n", hipGetErrorString(e), grid);
#else
    for (int ph = 0; ph < 21; ++ph) {
        a.ph_lo = ph; a.ph_hi = ph + 1; a.coop = 0;
        hipLaunchKernelGGL(hybrid_fwd, dim3(grid), dim3(NTHREADS), LDS_BYTES, stream, a);
    }
#endif
}
```

```cpp
#include <hip/hip_runtime.h>
#include <hip/hip_cooperative_groups.h>
#include <cstdio>
#include <cstdint>
#include <cstddef>
namespace cg = cooperative_groups;

#ifndef MK_COOP
#define MK_COOP 1
#endif

#define LAS __attribute__((address_space(3)))
typedef unsigned short bf16_t;
typedef short bf16x8 __attribute__((ext_vector_type(8)));
typedef float f32x4 __attribute__((ext_vector_type(4)));
typedef float f32x2 __attribute__((ext_vector_type(2)));
typedef unsigned u32x4 __attribute__((ext_vector_type(4)));
typedef unsigned u32x2 __attribute__((ext_vector_type(2)));

namespace pg8 {
constexpr int BM = 256, BK = 64, HALF = 128, HTB = HALF * BK * 2, STAGE_BYTES = 8 * HTB, NXCD = 8, WGM = 8;
__host__ __device__ __forceinline__ int lds_byte(int r, int c) { const int st = (r >> 4) * 2 + (c >> 5), rr = r & 15, cc = c & 31, ob = rr * 64 + cc * 2; return st * 1024 + (ob ^ (((ob >> 9) & 1) << 5)); }
__host__ __device__ __forceinline__ void stage_rc(int b, int& R, int& C) { const int st = b / 1024, sb = b % 1024, swz = sb ^ (((sb >> 9) & 1) << 5); R = (st >> 1) * 16 + swz / 64; C = (st & 1) * 32 + (swz % 64) / 2; }
__host__ __device__ __forceinline__ int perm32(int rho) { const int n = rho >> 4, i = rho & 15; return 8 * (i >> 2) + 4 * n + (i & 3); }

struct Unit { int pm, pn; };
struct Gemm { const bf16_t* A; const bf16_t* Bt; int M, N, K; };

struct StaticOrder {
    int nM, nN, nwg, G, c;
    __host__ __device__ void init(int M, int N, int G_, int c_) { nM = M / BM; nN = N / BM; nwg = nM * nN; G = G_; c = c_; }
    __host__ __device__ bool next(int i, Unit& u) const {
        const long L = (long)i * G + c; if (L >= nwg) return false;
        int wgid = (int)L; { const int q = nwg / NXCD, r = nwg % NXCD, xcd = wgid % NXCD, off = wgid / NXCD; wgid = (xcd < r ? xcd * (q + 1) : r * (q + 1) + (xcd - r) * q) + off; }
        const int nig = WGM * nN, gid = wgid / nig, fm = gid * WGM, gsz = (nM - fm) < WGM ? (nM - fm) : WGM;
        u.pm = fm + ((wgid % nig) % gsz); u.pn = (wgid % nig) / gsz; return true;
    }
};

__device__ __forceinline__ unsigned cvt_pk_bf16(float lo, float hi) { unsigned r; asm volatile("v_cvt_pk_bf16_f32 %0, %1, %2" : "=v"(r) : "v"(lo), "v"(hi)); return r; }

template <class Epi>
__device__ __forceinline__ void gemm_phase(LAS unsigned char* lds, const Gemm g, const StaticOrder& S, const Epi& E, const int tid) {
    const int wid = __builtin_amdgcn_readfirstlane(tid >> 6), lane = tid & 63, wr = wid >> 2, wc = wid & 3, fr = lane & 15, fq = lane >> 4;
    int K_ = g.K; asm volatile("" : "+s"(K_)); const int K = K_, nt = K / BK;
    unsigned voffA[2], voffB[2];
#pragma unroll
    for (int i = 0; i < 2; ++i) { int R, C; stage_rc(tid * 16 + i * 8192, R, C); const int Rb = (R & ~31) + perm32(R & 31);
        voffA[i] = (unsigned)(R * K + C) * 2u; voffB[i] = (unsigned)(Rb * K + C) * 2u; }
    const size_t kstep = (size_t)(BK * 2);
    const size_t hstep = (size_t)HALF * K * 2;
    const size_t tstep = 2 * hstep;
    const unsigned ldsw = (unsigned)wid * 1024u;
    const int aoff = lds_byte(wr * 64 + fr, fq * 8), boff = lds_byte(wc * 32 + fr, fq * 8);
#define PG8_SA(b, h) (((b) * 2 + (h)) * HTB)
#define PG8_SB(b, h) ((4 + (b) * 2 + (h)) * HTB)
#define PG8_STAGE(bufoff, gbase, voff) do { _Pragma("unroll") for (int _i = 0; _i < 2; ++_i) \
        __builtin_amdgcn_global_load_lds((const unsigned*)((const char*)(gbase) + (voff)[_i]), (LAS unsigned*)(lds + (bufoff) + ldsw + _i * 8192), 16, 0, 0); } while (0)
#define PG8_LDA(dst, b, h) do { _Pragma("unroll") for (int m = 0; m < 4; ++m) _Pragma("unroll") for (int k = 0; k < 2; ++k) dst[m][k] = *(const LAS bf16x8*)(lds + PG8_SA(b, h) + aoff + m * 2048 + k * 1024); } while (0)
#define PG8_LDB(dst, b, h) do { _Pragma("unroll") for (int n = 0; n < 2; ++n) _Pragma("unroll") for (int k = 0; k < 2; ++k) dst[n][k] = *(const LAS bf16x8*)(lds + PG8_SB(b, h) + boff + n * 2048 + k * 1024); } while (0)
#define PG8_MMA(ai, bj, At, Bt) do { __builtin_amdgcn_s_setprio(1); _Pragma("unroll") for (int m = 0; m < 4; ++m) _Pragma("unroll") for (int n = 0; n < 2; ++n) _Pragma("unroll") for (int k = 0; k < 2; ++k) \
        acc[ai][bj][m][n] = __builtin_amdgcn_mfma_f32_16x16x32_bf16(Bt[n][k], At[m][k], acc[ai][bj][m][n], 0, 0, 0); __builtin_amdgcn_s_setprio(0); } while (0)
#define PG8_WAIT_V(n) asm volatile("s_waitcnt vmcnt(" #n ")" ::: "memory")
#define PG8_WAIT_L(n) asm volatile("s_waitcnt lgkmcnt(" #n ")" ::: "memory")
#define PG8_BAR __builtin_amdgcn_s_barrier()
#define PG8_SCHED __builtin_amdgcn_sched_barrier(0)
    Unit cur, nxt; int ui = 0;
    if (!S.next(0, cur)) return;
    f32x4 acc[2][2][4][2];
#pragma unroll
    for (int a = 0; a < 2; ++a)
#pragma unroll
        for (int b = 0; b < 2; ++b)
#pragma unroll
            for (int m = 0; m < 4; ++m)
#pragma unroll
                for (int n = 0; n < 2; ++n) acc[a][b][m][n] = (f32x4){0.f, 0.f, 0.f, 0.f};
    bf16x8 At[4][2], B0[2][2], B1[2][2];
    const char* cA = (const char*)g.A + (size_t)cur.pm * tstep; const char* cB = (const char*)g.Bt + (size_t)cur.pn * tstep;
    PG8_STAGE(PG8_SB(0, 0), cB, voffB); PG8_STAGE(PG8_SB(0, 1), cB + hstep, voffB); PG8_STAGE(PG8_SA(0, 0), cA, voffA); PG8_STAGE(PG8_SA(0, 1), cA + hstep, voffA);
    if (wr == 1) PG8_BAR;
    PG8_WAIT_V(2); PG8_BAR;
    PG8_STAGE(PG8_SB(1, 0), cB + kstep, voffB); PG8_STAGE(PG8_SA(1, 0), cA + kstep, voffA); PG8_STAGE(PG8_SB(1, 1), cB + hstep + kstep, voffB);
    PG8_WAIT_V(6); PG8_BAR;
    for (;;) {
        const bool has_next = S.next(ui + 1, nxt);
        const char* nA = has_next ? (const char*)g.A + (size_t)nxt.pm * tstep : cA; const char* nB = has_next ? (const char*)g.Bt + (size_t)nxt.pn * tstep : cB;
        for (int t = 0; t < nt; t += 2) {
            const bool last = (t == nt - 2);
            const char* a1 = cA + (size_t)(t + 1) * kstep;
            const char* a2 = last ? nA : cA + (size_t)(t + 2) * kstep; const char* b2 = last ? nB : cB + (size_t)(t + 2) * kstep;
            const char* a3 = a2 + kstep; const char* b3 = b2 + kstep;
            PG8_LDB(B0, 0, 0); PG8_LDB(B1, 0, 1); PG8_SCHED; PG8_LDA(At, 0, 0); PG8_STAGE(PG8_SA(1, 1), a1 + hstep, voffA);
            PG8_WAIT_V(8); PG8_WAIT_L(0); PG8_BAR; PG8_MMA(0, 0, At, B0); PG8_MMA(0, 1, At, B1); PG8_BAR; PG8_SCHED;
            PG8_LDA(At, 0, 1); PG8_STAGE(PG8_SB(0, 0), b2, voffB); PG8_STAGE(PG8_SB(0, 1), b2 + hstep, voffB); PG8_STAGE(PG8_SA(0, 0), a2, voffA);
            PG8_WAIT_V(8); PG8_WAIT_L(0); PG8_BAR; PG8_MMA(1, 0, At, B0); PG8_MMA(1, 1, At, B1); PG8_BAR; PG8_SCHED;
            PG8_LDB(B0, 1, 0); PG8_LDB(B1, 1, 1); PG8_SCHED; PG8_LDA(At, 1, 0); PG8_STAGE(PG8_SA(0, 1), a2 + hstep, voffA);
            PG8_WAIT_V(8); PG8_WAIT_L(0); PG8_BAR; PG8_MMA(0, 0, At, B0); PG8_MMA(0, 1, At, B1); PG8_BAR; PG8_SCHED;
            PG8_LDA(At, 1, 1); PG8_STAGE(PG8_SB(1, 0), b3, voffB); PG8_STAGE(PG8_SB(1, 1), b3 + hstep, voffB); PG8_STAGE(PG8_SA(1, 0), a3, voffA);
            PG8_WAIT_V(8); PG8_WAIT_L(0); PG8_BAR; PG8_MMA(1, 0, At, B0); PG8_MMA(1, 1, At, B1); PG8_BAR; PG8_SCHED;
        }
        if (wr == 0) PG8_BAR;
        E(acc, cur, wr, wc, fr, fq);
        if (!has_next) break;
#pragma unroll
        for (int a = 0; a < 2; ++a)
#pragma unroll
            for (int b = 0; b < 2; ++b)
#pragma unroll
                for (int m = 0; m < 4; ++m)
#pragma unroll
                    for (int n = 0; n < 2; ++n) acc[a][b][m][n] = (f32x4){0.f, 0.f, 0.f, 0.f};
        cur = nxt; cA = nA; cB = nB; ++ui;
        if (wr == 1) PG8_BAR;
    }
    PG8_WAIT_V(0);
    PG8_BAR;
#undef PG8_SA
#undef PG8_SB
#undef PG8_STAGE
#undef PG8_LDA
#undef PG8_LDB
#undef PG8_MMA
#undef PG8_WAIT_V
#undef PG8_WAIT_L
#undef PG8_BAR
#undef PG8_SCHED
}
}

constexpr int TOK = 16384, DM = 2048, SEQL = 4096, FFD = 8192, PLE = 256;
constexpr int INC = 6672, INP = 6912, PJ = 6656;
constexpr int C_U = 0, C_V = 512, C_GB = 1024, C_GC = 1536, C_XI = 2048, C_Q = 2560, C_Z = 5632;
constexpr float EPSF = 1e-6f;
constexpr int NTHREADS = 512, NWAVES = 8;
constexpr int LDS_BYTES = 147456;

constexpr size_t WS_AB = 0;
constexpr size_t WS_GL = 1048576;
constexpr size_t WS_WIN = 2097152;
constexpr size_t WS_WO = WS_WIN + (size_t)INP * DM * 2;
constexpr size_t WS_W1 = WS_WO + (size_t)DM * DM * 2;
constexpr size_t WS_W2 = WS_W1 + (size_t)FFD * DM * 2;
constexpr size_t WS_WG = WS_W2 + (size_t)FFD * DM * 2;
constexpr size_t WS_WP = WS_WG + (size_t)DM * DM * 2;
constexpr size_t WS_P16 = WS_WP + (size_t)DM * PLE * 2;
constexpr size_t WS_XN = WS_P16 + (size_t)TOK * PLE * 2;
constexpr size_t WS_BIG = WS_XN + (size_t)TOK * DM * 2;
constexpr size_t WS_GDN = WS_BIG + (size_t)TOK * FFD * 2;
constexpr size_t GDN_ITEM = 73728;
constexpr size_t WS_END = WS_GDN + 2048 * GDN_ITEM;

struct Args {
    const float *x, *p, *norm_mix, *w_in, *sg_ln_g, *sg_ln_b, *sg_w, *sg_b, *sc_conv, *gdn_conv, *gdn_a_log, *gdn_dt_bias, *gdn_norm,
        *out_norm_a, *out_norm_b, *w_o, *norm_ffn, *w_ff1, *w_ff2, *norm_ple, *w_ple_gate, *w_ple_proj, *norm_final;
    float* out; unsigned char* ws; int ph_lo, ph_hi, coop, pad;
};

__device__ __forceinline__ unsigned pk2(float lo, float hi) { return pg8::cvt_pk_bf16(lo, hi); }
__device__ __forceinline__ float bf2f(unsigned short v) { return __uint_as_float((unsigned)v << 16); }
__device__ __forceinline__ float bflo(unsigned w) { return __uint_as_float(w << 16); }
__device__ __forceinline__ float bfhi(unsigned w) { return __uint_as_float(w & 0xffff0000u); }
__device__ __forceinline__ float wave_sum(float v) {
#pragma unroll
    for (int o = 1; o < 64; o <<= 1) v += __shfl_xor(v, o);
    return v;
}
__device__ __forceinline__ float sigmoidf_(float x) { return 1.0f / (1.0f + __expf(-x)); }
__device__ __forceinline__ float gelu_tanh(float x) { const float y = 1.5957691216057308f * x * (1.0f + 0.044715f * x * x); return x / (1.0f + __expf(-y)); }
__device__ __forceinline__ bf16x8 pack8(const f32x4 a, const f32x4 b) {
    u32x4 w; w.x = pk2(a[0], a[1]); w.y = pk2(a[2], a[3]); w.z = pk2(b[0], b[1]); w.w = pk2(b[2], b[3]);
    return __builtin_bit_cast(bf16x8, w);
}
__host__ __device__ __forceinline__ int kperm(int d) { return (d & ~31) + 8 * ((d >> 2) & 3) + 4 * ((d >> 4) & 1) + (d & 3); }
#define LDS_WAIT() asm volatile("s_waitcnt lgkmcnt(0)" ::: "memory")

#define EPI_LOOP_BEGIN  _Pragma("unroll") for (int ai = 0; ai < 2; ++ai) _Pragma("unroll") for (int m = 0; m < 4; ++m) { const int row = u.pm * 256 + ai * 128 + wr * 64 + m * 16 + fr; \
                        _Pragma("unroll") for (int bj = 0; bj < 2; ++bj) { const int col = u.pn * 256 + bj * 128 + wc * 32 + 8 * fq; f32x4 v0 = acc[ai][bj][m][0], v1 = acc[ai][bj][m][1];
#define EPI_LOOP_END    } }
#define EPI_ARGS const f32x4 (&acc)[2][2][4][2], const pg8::Unit& u, int wr, int wc, int fr, int fq

struct EpiProj {
    bf16_t* P; float* AB;
    __device__ __forceinline__ void operator()(EPI_ARGS) const {
        if (u.pn < 26) {
            const bool act = u.pn < 4;
            EPI_LOOP_BEGIN
                if (act) {
#pragma unroll
                    for (int e = 0; e < 4; ++e) { v0[e] = gelu_tanh(v0[e]); v1[e] = gelu_tanh(v1[e]); }
                }
                u32x4 w; w.x = pk2(v0[0], v0[1]); w.y = pk2(v0[2], v0[3]); w.z = pk2(v1[0], v1[1]); w.w = pk2(v1[2], v1[3]);
                *(u32x4*)(P + (size_t)row * PJ + col) = w;
            EPI_LOOP_END
        } else {
            if (wc == 0 && fq < 2) {
#pragma unroll
                for (int ai = 0; ai < 2; ++ai)
#pragma unroll
                    for (int m = 0; m < 4; ++m) { const int row = u.pm * 256 + ai * 128 + wr * 64 + m * 16 + fr;
                        *(f32x4*)(AB + (size_t)row * 16 + 8 * fq) = acc[ai][0][m][0]; *(f32x4*)(AB + (size_t)row * 16 + 8 * fq + 4) = acc[ai][0][m][1]; }
            }
        }
    }
};
struct EpiRes {
    const float* base; float* out;
    __device__ __forceinline__ void operator()(EPI_ARGS) const {
        EPI_LOOP_BEGIN
            const size_t off = (size_t)row * DM + col;
            const f32x4 b0 = *(const f32x4*)(base + off), b1 = *(const f32x4*)(base + off + 4);
            *(f32x4*)(out + off) = b0 + v0; *(f32x4*)(out + off + 4) = b1 + v1;
        EPI_LOOP_END
    }
};
struct EpiRelu2 {
    bf16_t* O;
    __device__ __forceinline__ void operator()(EPI_ARGS) const {
        EPI_LOOP_BEGIN
#pragma unroll
            for (int e = 0; e < 4; ++e) { const float a = fmaxf(v0[e], 0.f), b = fmaxf(v1[e], 0.f); v0[e] = a * a; v1[e] = b * b; }
            u32x4 w; w.x = pk2(v0[0], v0[1]); w.y = pk2(v0[2], v0[3]); w.z = pk2(v1[0], v1[1]); w.w = pk2(v1[2], v1[3]);
            *(u32x4*)(O + (size_t)row * FFD + col) = w;
        EPI_LOOP_END
    }
};
struct EpiPlain {
    bf16_t* O;
    __device__ __forceinline__ void operator()(EPI_ARGS) const {
        EPI_LOOP_BEGIN
            u32x4 w; w.x = pk2(v0[0], v0[1]); w.y = pk2(v0[2], v0[3]); w.z = pk2(v1[0], v1[1]); w.w = pk2(v1[2], v1[3]);
            *(u32x4*)(O + (size_t)row * DM + col) = w;
        EPI_LOOP_END
    }
};
struct EpiGate {
    const bf16_t* PP; float* out;
    __device__ __forceinline__ void operator()(EPI_ARGS) const {
        EPI_LOOP_BEGIN
            const size_t off = (size_t)row * DM + col;
            const u32x4 pw = *(const u32x4*)(PP + off);
            const f32x4 b0 = *(const f32x4*)(out + off), b1 = *(const f32x4*)(out + off + 4);
            f32x4 o0, o1;
            o0[0] = b0[0] + bflo(pw.x) * sigmoidf_(v0[0]); o0[1] = b0[1] + bfhi(pw.x) * sigmoidf_(v0[1]);
            o0[2] = b0[2] + bflo(pw.y) * sigmoidf_(v0[2]); o0[3] = b0[3] + bfhi(pw.y) * sigmoidf_(v0[3]);
            o1[0] = b1[0] + bflo(pw.z) * sigmoidf_(v1[0]); o1[1] = b1[1] + bfhi(pw.z) * sigmoidf_(v1[1]);
            o1[2] = b1[2] + bflo(pw.w) * sigmoidf_(v1[2]); o1[3] = b1[3] + bfhi(pw.w) * sigmoidf_(v1[3]);
            *(f32x4*)(out + off) = o0; *(f32x4*)(out + off + 4) = o1;
        EPI_LOOP_END
    }
};

__device__ __forceinline__ void transpose_item(const float* W, int K, int N, int Npad, bf16_t* WT, LAS float* scr, int item, int lane) {
    const int nblk = Npad / 32, kb = item / nblk, nb = item % nblk, k0 = 64 * kb, n0 = 32 * nb;
    const int nn = n0 + (lane & 31); const bool ok = nn < N;
#pragma unroll 8
    for (int i = 0; i < 32; ++i) { const int kk = 2 * i + (lane >> 5); scr[kk * 33 + (lane & 31)] = ok ? W[(size_t)(k0 + kk) * N + nn] : 0.f; }
    LDS_WAIT(); asm volatile("" ::: "memory");
    const int c = lane & 7;
#pragma unroll
    for (int j = 0; j < 4; ++j) { const int n = (lane >> 3) + 8 * j; const LAS float* s = scr + (8 * c) * 33 + n;
        u32x4 o; o.x = pk2(s[0 * 33], s[1 * 33]); o.y = pk2(s[2 * 33], s[3 * 33]); o.z = pk2(s[4 * 33], s[5 * 33]); o.w = pk2(s[6 * 33], s[7 * 33]);
        *(u32x4*)(WT + (size_t)(n0 + n) * K + k0 + 8 * c) = o; }
    LDS_WAIT(); asm volatile("" ::: "memory");
}
__device__ __forceinline__ void rms_row_bf16(const float* xrow, const float* g, bf16_t* orow, int lane) {
    const f32x4* xr = (const f32x4*)xrow + lane; const f32x4* gr = (const f32x4*)g + lane;
    f32x4 v[8]; float s = 0.f;
#pragma unroll
    for (int j = 0; j < 8; ++j) { v[j] = xr[64 * j]; s += (v[j][0] * v[j][0] + v[j][1] * v[j][1]) + (v[j][2] * v[j][2] + v[j][3] * v[j][3]); }
    const float rstd = 1.0f / sqrtf(wave_sum(s) * (1.0f / DM) + EPSF);
    u32x2* o8 = (u32x2*)orow + lane;
#pragma unroll
    for (int j = 0; j < 8; ++j) { const f32x4 gg = gr[64 * j]; u32x2 w; w.x = pk2(v[j][0] * rstd * gg[0], v[j][1] * rstd * gg[1]); w.y = pk2(v[j][2] * rstd * gg[2], v[j][3] * rstd * gg[3]); o8[64 * j] = w; }
}
__device__ __forceinline__ void rms_row_f32(const float* xrow, const float* g, float* orow, int lane) {
    const f32x4* xr = (const f32x4*)xrow + lane; const f32x4* gr = (const f32x4*)g + lane;
    f32x4 v[8]; float s = 0.f;
#pragma unroll
    for (int j = 0; j < 8; ++j) { v[j] = xr[64 * j]; s += (v[j][0] * v[j][0] + v[j][1] * v[j][1]) + (v[j][2] * v[j][2] + v[j][3] * v[j][3]); }
    const float rstd = 1.0f / sqrtf(wave_sum(s) * (1.0f / DM) + EPSF);
    f32x4* o = (f32x4*)orow + lane;
#pragma unroll
    for (int j = 0; j < 8; ++j) { const f32x4 gg = gr[64 * j]; o[64 * j] = v[j] * rstd * gg; }
}

__device__ __forceinline__ void gdn_chunk_item(LAS unsigned char* L, int item, const bf16_t* P, const float* AB, const float* convw, const float* a_log, const float* dt_bias,
                                               unsigned char* GDN, float* GL, int tid) {
    const int n = item & 63, bh = item >> 6, h = bh & 7, b = bh >> 3;
    const int tok0 = b * SEQL + n * 64;
    const int wave = tid >> 6, lane = tid & 63, q4 = lane >> 4, c15 = lane & 15;
    LAS bf16_t* Kb = (LAS bf16_t*)(L);
    LAS bf16_t* Qb = (LAS bf16_t*)(L + 17408);
    LAS float* Af = (LAS float*)(L + 34816);
    LAS float* X = (LAS float*)(L + 51200);
    LAS float* gcs = (LAS float*)(L + 116736);
    LAS float* bts = gcs + 64;
    LAS float* egc = gcs + 128;
    unsigned char* gbase = GDN + (size_t)item * GDN_ITEM;
    bf16_t* g_qexp = (bf16_t*)gbase; bf16_t* g_kcd = (bf16_t*)(gbase + 16384); bf16_t* g_ktT = (bf16_t*)(gbase + 32768);
    bf16_t* g_valT = (bf16_t*)(gbase + 49152); bf16_t* g_intra = (bf16_t*)(gbase + 65536);

    if (wave == 0) {
        const float a = AB[(size_t)(tok0 + lane) * 16 + h], bb = AB[(size_t)(tok0 + lane) * 16 + 8 + h];
        const float xs = a + dt_bias[h];
        const float sp = xs > 20.f ? xs : log1pf(__expf(xs));
        float c = -__expf(a_log[h]) * sp;
#pragma unroll
        for (int o = 1; o < 64; o <<= 1) { const float t = __shfl_up(c, o); if (lane >= o) c += t; }
        gcs[lane] = c; bts[lane] = sigmoidf_(bb); egc[lane] = __expf(c);
    }
    __syncthreads();
    if (wave < 6) {
        const int cgi = tid % 48, seg = tid / 48, which = cgi >> 4, cc = (cgi & 15) * 8;
        const int col = C_Q + which * 1024 + h * 128 + cc;
        float w[4][8];
#pragma unroll
        for (int j = 0; j < 4; ++j) { const f32x4 a = *(const f32x4*)(convw + j * 3072 + which * 1024 + h * 128 + cc), bq = *(const f32x4*)(convw + j * 3072 + which * 1024 + h * 128 + cc + 4);
            w[j][0] = a[0]; w[j][1] = a[1]; w[j][2] = a[2]; w[j][3] = a[3]; w[j][4] = bq[0]; w[j][5] = bq[1]; w[j][6] = bq[2]; w[j][7] = bq[3]; }
        float x0[8], x1[8], x2[8], x3[8];
        auto ldrow = [&](int r, float (&dst)[8]) {
            if (n * 64 + r >= 0) { const u32x4 v = *(const u32x4*)(P + (size_t)(tok0 + r) * PJ + col);
                dst[0] = bflo(v.x); dst[1] = bfhi(v.x); dst[2] = bflo(v.y); dst[3] = bfhi(v.y); dst[4] = bflo(v.z); dst[5] = bfhi(v.z); dst[6] = bflo(v.w); dst[7] = bfhi(v.w); }
            else {
#pragma unroll
                for (int e = 0; e < 8; ++e) dst[e] = 0.f; }
        };
        ldrow(seg * 8 - 3, x0); ldrow(seg * 8 - 2, x1); ldrow(seg * 8 - 1, x2);
#pragma unroll
        for (int i = 0; i < 8; ++i) {
            const int t = seg * 8 + i;
            ldrow(t, x3);
            float y[8]; float ss = 0.f;
#pragma unroll
            for (int e = 0; e < 8; ++e) { const float c = w[0][e] * x0[e] + w[1][e] * x1[e] + w[2][e] * x2[e] + w[3][e] * x3[e]; y[e] = c * sigmoidf_(c); ss += y[e] * y[e]; }
            ss += __shfl_xor(ss, 1); ss += __shfl_xor(ss, 2); ss += __shfl_xor(ss, 4); ss += __shfl_xor(ss, 8);
            const float rn = 1.0f / sqrtf(ss + EPSF);
            const float bt = bts[t], eg = egc[t];
            if (which == 0) {
                const float s = rn * 0.08838834764831845f;
                u32x4 o; o.x = pk2(y[0] * s, y[1] * s); o.y = pk2(y[2] * s, y[3] * s); o.z = pk2(y[4] * s, y[5] * s); o.w = pk2(y[6] * s, y[7] * s);
                *(LAS u32x4*)(Qb + t * 136 + cc) = o;
            } else if (which == 1) {
                u32x4 o; o.x = pk2(y[0] * rn, y[1] * rn); o.y = pk2(y[2] * rn, y[3] * rn); o.z = pk2(y[4] * rn, y[5] * rn); o.w = pk2(y[6] * rn, y[7] * rn);
                *(LAS u32x4*)(Kb + t * 136 + cc) = o;
                const float s = rn * bt * eg;
                *(LAS f32x4*)(X + t * 256 + 128 + cc) = (f32x4){y[0] * s, y[1] * s, y[2] * s, y[3] * s};
                *(LAS f32x4*)(X + t * 256 + 128 + cc + 4) = (f32x4){y[4] * s, y[5] * s, y[6] * s, y[7] * s};
            } else {
                *(LAS f32x4*)(X + t * 256 + cc) = (f32x4){y[0] * bt, y[1] * bt, y[2] * bt, y[3] * bt};
                *(LAS f32x4*)(X + t * 256 + cc + 4) = (f32x4){y[4] * bt, y[5] * bt, y[6] * bt, y[7] * bt};
            }
#pragma unroll
            for (int e = 0; e < 8; ++e) { x0[e] = x1[e]; x1[e] = x2[e]; x2[e] = x3[e]; }
        }
    }
    __syncthreads();
    {
        const int ti = wave >> 1;
        bf16x8 ak[4], aq[4];
#pragma unroll
        for (int kb = 0; kb < 4; ++kb) { ak[kb] = *(const LAS bf16x8*)(Kb + (16 * ti + c15) * 136 + 32 * kb + 8 * q4); aq[kb] = *(const LAS bf16x8*)(Qb + (16 * ti + c15) * 136 + 32 * kb + 8 * q4); }
#pragma unroll
        for (int jj = 0; jj < 2; ++jj) {
            const int tj = 2 * (wave & 1) + jj;
            f32x4 dk = (f32x4){0.f, 0.f, 0.f, 0.f}, dq = (f32x4){0.f, 0.f, 0.f, 0.f};
#pragma unroll
            for (int kb = 0; kb < 4; ++kb) { const bf16x8 bk = *(const LAS bf16x8*)(Kb + (16 * tj + c15) * 136 + 32 * kb + 8 * q4);
                dk = __builtin_amdgcn_mfma_f32_16x16x32_bf16(ak[kb], bk, dk, 0, 0, 0); dq = __builtin_amdgcn_mfma_f32_16x16x32_bf16(aq[kb], bk, dq, 0, 0, 0); }
            const int j = 16 * tj + c15; const float gj = gcs[j];
#pragma unroll
            for (int r = 0; r < 4; ++r) { const int i = 16 * ti + 4 * q4 + r;
                const float dec = (j <= i) ? __expf(fminf(gcs[i] - gj, 0.f)) : 0.f;
                Af[i * 64 + j] = (j < i) ? bts[i] * dk[r] * dec : 0.f;
                g_intra[i * 64 + kperm(j)] = (bf16_t)(pk2(dq[r] * dec, 0.f) & 0xffffu); }
        }
    }
    __syncthreads();
    if (tid < 256) {
        const int c = tid;
        float x[64];
#pragma unroll
        for (int i = 0; i < 64; ++i) {
            float a = X[i * 256 + c];
#pragma unroll
            for (int j = 0; j < i; ++j) a -= Af[i * 64 + j] * x[j];
            x[i] = a;
        }
        if (c < 128) {
#pragma unroll
            for (int k = 0; k < 8; ++k) { u32x4 o; o.x = pk2(x[8 * k], x[8 * k + 1]); o.y = pk2(x[8 * k + 2], x[8 * k + 3]); o.z = pk2(x[8 * k + 4], x[8 * k + 5]); o.w = pk2(x[8 * k + 6], x[8 * k + 7]);
                *(u32x4*)(g_valT + c * 64 + 8 * k) = o; }
        } else {
            const int pd = kperm(c - 128);
#pragma unroll
            for (int i = 0; i < 64; ++i) g_kcd[i * 128 + pd] = (bf16_t)(pk2(x[i], 0.f) & 0xffffu);
        }
    } else {
        const int t2 = tid - 256;
        {
            const int l = t2 >> 2, kb = t2 & 3; const float eg = egc[l];
#pragma unroll
            for (int k4 = 0; k4 < 4; ++k4) { float v[8];
#pragma unroll
                for (int e = 0; e < 8; ++e) { const int pos = 8 * k4 + e, qq = pos >> 3, jh = (pos >> 2) & 1, r = pos & 3; v[e] = bf2f(Qb[l * 136 + 32 * kb + 16 * jh + 4 * qq + r]) * eg; }
                u32x4 o; o.x = pk2(v[0], v[1]); o.y = pk2(v[2], v[3]); o.z = pk2(v[4], v[5]); o.w = pk2(v[6], v[7]);
                *(u32x4*)(g_qexp + l * 128 + 32 * kb + 8 * k4) = o; }
        }
        {
            const int d = t2 >> 1, kb2 = t2 & 1; const float glast = gcs[63];
#pragma unroll
            for (int k4 = 0; k4 < 4; ++k4) { float v[8];
#pragma unroll
                for (int e = 0; e < 8; ++e) { const int pos = 8 * k4 + e, qq = pos >> 3, jh = (pos >> 2) & 1, r = pos & 3; const int l = 32 * kb2 + 16 * jh + 4 * qq + r; v[e] = bf2f(Kb[l * 136 + d]) * __expf(glast - gcs[l]); }
                u32x4 o; o.x = pk2(v[0], v[1]); o.y = pk2(v[2], v[3]); o.z = pk2(v[4], v[5]); o.w = pk2(v[6], v[7]);
                *(u32x4*)(g_ktT + d * 64 + 32 * kb2 + 8 * k4) = o; }
        }
        if (t2 == 0) GL[item] = egc[63];
    }
    __syncthreads();
}

__device__ __forceinline__ void gdn_scan(LAS unsigned char* L, int bh, const unsigned char* GDN, const float* GL, const bf16_t* P, const float* gnorm, bf16_t* MIX, int tid) {
    const int h = bh & 7, b = bh >> 3;
    const int wave = tid >> 6, lane = tid & 63, q4 = lane >> 4, c15 = lane & 15;
    LAS unsigned char* Lq = L;
    LAS unsigned char* Lk = L + 17408;
    LAS unsigned char* Lt = L + 34816;
    LAS unsigned char* Li = L + 53248;
    LAS float* Lo = (LAS float*)(L + 62464);
    f32x4 S[8];
#pragma unroll
    for (int T = 0; T < 8; ++T) S[T] = (f32x4){0.f, 0.f, 0.f, 0.f};
    u32x4 pf[7];
    const int c0 = tid, c1 = tid + 512;
#define SCAN_LOAD(nn) do { const unsigned char* gb_ = GDN + (size_t)(bh * 64 + (nn)) * GDN_ITEM; \
        pf[0] = *(const u32x4*)(gb_ + c0 * 16); pf[1] = *(const u32x4*)(gb_ + c1 * 16); \
        pf[2] = *(const u32x4*)(gb_ + 16384 + c0 * 16); pf[3] = *(const u32x4*)(gb_ + 16384 + c1 * 16); \
        pf[4] = *(const u32x4*)(gb_ + 32768 + c0 * 16); pf[5] = *(const u32x4*)(gb_ + 32768 + c1 * 16); \
        pf[6] = *(const u32x4*)(gb_ + 65536 + c0 * 16); } while (0)
#define SCAN_STORE() do { \
        *(LAS u32x4*)(Lq + (c0 >> 4) * 272 + (c0 & 15) * 16) = pf[0]; *(LAS u32x4*)(Lq + (c1 >> 4) * 272 + (c1 & 15) * 16) = pf[1]; \
        *(LAS u32x4*)(Lk + (c0 >> 4) * 272 + (c0 & 15) * 16) = pf[2]; *(LAS u32x4*)(Lk + (c1 >> 4) * 272 + (c1 & 15) * 16) = pf[3]; \
        *(LAS u32x4*)(Lt + (c0 >> 3) * 144 + (c0 & 7) * 16) = pf[4]; *(LAS u32x4*)(Lt + (c1 >> 3) * 144 + (c1 & 7) * 16) = pf[5]; \
        *(LAS u32x4*)(Li + (c0 >> 3) * 144 + (c0 & 7) * 16) = pf[6]; } while (0)
    SCAN_LOAD(0); SCAN_STORE();
    __syncthreads();
    for (int n = 0; n < 64; ++n) {
        if (n + 1 < 64) SCAN_LOAD(n + 1);
        const unsigned char* gb = GDN + (size_t)(bh * 64 + n) * GDN_ITEM;
        const float gl = GL[bh * 64 + n];
        u32x2 vraw[4];
#pragma unroll
        for (int t = 0; t < 4; ++t) vraw[t] = *(const u32x2*)(gb + 49152 + ((16 * wave + c15) * 64 + 16 * t + 4 * q4) * 2);
        bf16x8 Sp[4];
#pragma unroll
        for (int kb = 0; kb < 4; ++kb) Sp[kb] = pack8(S[2 * kb], S[2 * kb + 1]);
        f32x4 Vn[4];
#pragma unroll
        for (int t = 0; t < 4; ++t) {
            f32x4 pa = (f32x4){0.f, 0.f, 0.f, 0.f};
#pragma unroll
            for (int kb = 0; kb < 4; ++kb) { const bf16x8 a = *(const LAS bf16x8*)(Lk + (16 * t + c15) * 272 + (32 * kb + 8 * q4) * 2); pa = __builtin_amdgcn_mfma_f32_16x16x32_bf16(a, Sp[kb], pa, 0, 0, 0); }
            Vn[t] = (f32x4){bflo(vraw[t].x), bfhi(vraw[t].x), bflo(vraw[t].y), bfhi(vraw[t].y)} - pa;
        }
        bf16x8 Vp[2];
        Vp[0] = pack8(Vn[0], Vn[1]); Vp[1] = pack8(Vn[2], Vn[3]);
#pragma unroll
        for (int t = 0; t < 4; ++t) {
            f32x4 o = (f32x4){0.f, 0.f, 0.f, 0.f};
#pragma unroll
            for (int kb = 0; kb < 4; ++kb) { const bf16x8 a = *(const LAS bf16x8*)(Lq + (16 * t + c15) * 272 + (32 * kb + 8 * q4) * 2); o = __builtin_amdgcn_mfma_f32_16x16x32_bf16(a, Sp[kb], o, 0, 0, 0); }
#pragma unroll
            for (int kb = 0; kb < 2; ++kb) { const bf16x8 a = *(const LAS bf16x8*)(Li + (16 * t + c15) * 144 + (32 * kb + 8 * q4) * 2); o = __builtin_amdgcn_mfma_f32_16x16x32_bf16(a, Vp[kb], o, 0, 0, 0); }
#pragma unroll
            for (int r = 0; r < 4; ++r) Lo[(16 * t + 4 * q4 + r) * 132 + 16 * wave + c15] = o[r];
        }
#pragma unroll
        for (int T = 0; T < 8; ++T) {
            f32x4 s = S[T] * gl;
#pragma unroll
            for (int kb = 0; kb < 2; ++kb) { const bf16x8 a = *(const LAS bf16x8*)(Lt + (16 * T + c15) * 144 + (32 * kb + 8 * q4) * 2); s = __builtin_amdgcn_mfma_f32_16x16x32_bf16(a, Vp[kb], s, 0, 0, 0); }
            S[T] = s;
        }
        __syncthreads();
        {
            const int l = tid >> 3, part = tid & 7; const size_t tok = (size_t)b * SEQL + n * 64 + l;
            f32x4 ov[4]; float ss = 0.f;
#pragma unroll
            for (int k = 0; k < 4; ++k) { ov[k] = *(const LAS f32x4*)(Lo + l * 132 + part * 16 + 4 * k); ss += (ov[k][0] * ov[k][0] + ov[k][1] * ov[k][1]) + (ov[k][2] * ov[k][2] + ov[k][3] * ov[k][3]); }
            ss += __shfl_xor(ss, 1); ss += __shfl_xor(ss, 2); ss += __shfl_xor(ss, 4);
            const float rstd = 1.0f / sqrtf(ss * (1.0f / 128.f) + EPSF);
            const u32x4 z0 = *(const u32x4*)(P + tok * PJ + C_Z + h * 128 + part * 16), z1 = *(const u32x4*)(P + tok * PJ + C_Z + h * 128 + part * 16 + 8);
            float zz[16] = {bflo(z0.x), bfhi(z0.x), bflo(z0.y), bfhi(z0.y), bflo(z0.z), bfhi(z0.z), bflo(z0.w), bfhi(z0.w), bflo(z1.x), bfhi(z1.x), bflo(z1.y), bfhi(z1.y), bflo(z1.z), bfhi(z1.z), bflo(z1.w), bfhi(z1.w)};
            float res[16];
#pragma unroll
            for (int k = 0; k < 4; ++k) { const f32x4 gg = *(const f32x4*)(gnorm + part * 16 + 4 * k);
#pragma unroll
                for (int e = 0; e < 4; ++e) { const float z = zz[4 * k + e]; res[4 * k + e] = ov[k][e] * rstd * gg[e] * (z * sigmoidf_(z)); } }
            u32x4 w0, w1; w0.x = pk2(res[0], res[1]); w0.y = pk2(res[2], res[3]); w0.z = pk2(res[4], res[5]); w0.w = pk2(res[6], res[7]);
            w1.x = pk2(res[8], res[9]); w1.y = pk2(res[10], res[11]); w1.z = pk2(res[12], res[13]); w1.w = pk2(res[14], res[15]);
            *(u32x4*)(MIX + tok * DM + 1024 + h * 128 + part * 16) = w0; *(u32x4*)(MIX + tok * DM + 1024 + h * 128 + part * 16 + 8) = w1;
        }
        if (n + 1 < 64) SCAN_STORE();
        __syncthreads();
    }
#undef SCAN_LOAD
#undef SCAN_STORE
}

__device__ __forceinline__ void sgu_item(LAS unsigned char* L, int item, const bf16_t* P, const float* sgw, const float* sgb, const float* lng, const float* lnb, const float* ona, bf16_t* MIX, int tid) {
    const int h = item & 3, n = (item >> 2) & 31, b = item >> 7;
    const size_t tok0 = (size_t)b * SEQL + n * 128;
    const int wave = tid >> 6, lane = tid & 63, q4 = lane >> 4, c15 = lane & 15;
    LAS bf16_t* Wl = (LAS bf16_t*)L;
    LAS bf16_t* Vt = (LAS bf16_t*)(L + 34816);
    {
        const int t = tid >> 2, s0 = (tid & 3) * 32; const float* wr = sgw + (size_t)h * 16384 + t * 128 + s0;
#pragma unroll
        for (int k = 0; k < 4; ++k) { const f32x4 a = *(const f32x4*)(wr + 8 * k), c = *(const f32x4*)(wr + 8 * k + 4); float v[8] = {a[0], a[1], a[2], a[3], c[0], c[1], c[2], c[3]};
#pragma unroll
            for (int e = 0; e < 8; ++e) v[e] = (s0 + 8 * k + e <= t) ? v[e] : 0.f;
            u32x4 o; o.x = pk2(v[0], v[1]); o.y = pk2(v[2], v[3]); o.z = pk2(v[4], v[5]); o.w = pk2(v[6], v[7]);
            *(LAS u32x4*)(Wl + t * 136 + s0 + 8 * k) = o; }
    }
    {
        const int s = tid >> 2, d0 = (tid & 3) * 32; const bf16_t* vr = P + (tok0 + s) * PJ + C_V + h * 128 + d0;
        float v[32]; float sm = 0.f;
#pragma unroll
        for (int k = 0; k < 4; ++k) { const u32x4 w = *(const u32x4*)(vr + 8 * k); v[8 * k] = bflo(w.x); v[8 * k + 1] = bfhi(w.x); v[8 * k + 2] = bflo(w.y); v[8 * k + 3] = bfhi(w.y); v[8 * k + 4] = bflo(w.z); v[8 * k + 5] = bfhi(w.z); v[8 * k + 6] = bflo(w.w); v[8 * k + 7] = bfhi(w.w); }
#pragma unroll
        for (int e = 0; e < 32; ++e) sm += v[e];
        sm += __shfl_xor(sm, 1); sm += __shfl_xor(sm, 2);
        const float mu = sm * (1.0f / 128.f); float sq = 0.f;
#pragma unroll
        for (int e = 0; e < 32; ++e) { v[e] -= mu; sq += v[e] * v[e]; }
        sq += __shfl_xor(sq, 1); sq += __shfl_xor(sq, 2);
        const float rstd = 1.0f / sqrtf(sq * (1.0f / 128.f) + EPSF);
#pragma unroll
        for (int e = 0; e < 32; ++e) { const float y = v[e] * rstd * lng[h * 128 + d0 + e] + lnb[h * 128 + d0 + e]; Vt[(d0 + e) * 136 + s] = (bf16_t)(pk2(y, 0.f) & 0xffffu); }
    }
    __syncthreads();
    {
        f32x4 D[8];
#pragma unroll
        for (int tj = 0; tj < 8; ++tj) D[tj] = (f32x4){0.f, 0.f, 0.f, 0.f};
        const int nkb = (wave >> 1) + 1;
        for (int kb = 0; kb < nkb; ++kb) {
            const bf16x8 a = *(const LAS bf16x8*)(Wl + (16 * wave + c15) * 136 + 32 * kb + 8 * q4);
#pragma unroll
            for (int tj = 0; tj < 8; ++tj) { const bf16x8 bv = *(const LAS bf16x8*)(Vt + (16 * tj + c15) * 136 + 32 * kb + 8 * q4); D[tj] = __builtin_amdgcn_mfma_f32_16x16x32_bf16(a, bv, D[tj], 0, 0, 0); }
        }
        float ss[4] = {0.f, 0.f, 0.f, 0.f};
#pragma unroll
        for (int r = 0; r < 4; ++r) { const int t = 16 * wave + 4 * q4 + r; const float bias = sgb[h * 128 + t]; const bf16_t* ur = P + (tok0 + t) * PJ + C_U + h * 128 + c15;
#pragma unroll
            for (int tj = 0; tj < 8; ++tj) { const float uu = bf2f(ur[16 * tj]); const float y = uu * (D[tj][r] + bias); D[tj][r] = y; ss[r] += y * y; } }
#pragma unroll
        for (int r = 0; r < 4; ++r) { float s = ss[r]; s += __shfl_xor(s, 1); s += __shfl_xor(s, 2); s += __shfl_xor(s, 4); s += __shfl_xor(s, 8); ss[r] = 1.0f / sqrtf(s * (1.0f / 128.f) + EPSF); }
#pragma unroll
        for (int r = 0; r < 4; ++r) { const int t = 16 * wave + 4 * q4 + r; bf16_t* orow = MIX + (tok0 + t) * DM + h * 128 + c15;
#pragma unroll
            for (int tj = 0; tj < 8; ++tj) orow[16 * tj] = (bf16_t)(pk2(D[tj][r] * ss[r] * ona[h * 128 + 16 * tj + c15], 0.f) & 0xffffu); }
    }
    __syncthreads();
}

__device__ __forceinline__ void unpack8(const u32x4 w, float (&v)[8]) { v[0] = bflo(w.x); v[1] = bfhi(w.x); v[2] = bflo(w.y); v[3] = bfhi(w.y); v[4] = bflo(w.z); v[5] = bfhi(w.z); v[6] = bflo(w.w); v[7] = bfhi(w.w); }
__device__ __forceinline__ void shortconv_token(int tok, const bf16_t* P, const float* scw, const float* onb, bf16_t* MIX, int lane) {
    const int c = lane * 8, pos = tok & (SEQL - 1);
    const bf16_t* row = P + (size_t)tok * PJ;
    float gb[8], acc[8];
    unpack8(*(const u32x4*)(row + C_GB + c), gb);
#pragma unroll
    for (int e = 0; e < 8; ++e) acc[e] = 0.f;
#pragma unroll
    for (int j = 0; j < 3; ++j) {
        const int back = 2 - j;
        if (pos - back >= 0) { float g[8], xi[8]; const bf16_t* r2 = row - (size_t)back * PJ;
            unpack8(*(const u32x4*)(r2 + C_GC + c), g); unpack8(*(const u32x4*)(r2 + C_XI + c), xi);
            const f32x4 w0 = *(const f32x4*)(scw + j * 512 + c), w1 = *(const f32x4*)(scw + j * 512 + c + 4);
#pragma unroll
            for (int e = 0; e < 4; ++e) { acc[e] += w0[e] * (g[e] * xi[e]); acc[4 + e] += w1[e] * (g[4 + e] * xi[4 + e]); } }
    }
    float ss = 0.f;
#pragma unroll
    for (int e = 0; e < 8; ++e) { acc[e] *= gb[e]; ss += acc[e] * acc[e]; }
    ss += __shfl_xor(ss, 1); ss += __shfl_xor(ss, 2); ss += __shfl_xor(ss, 4); ss += __shfl_xor(ss, 8);
    const float rstd = 1.0f / sqrtf(ss * (1.0f / 128.f) + EPSF);
    const f32x4 g0 = *(const f32x4*)(onb + c), g1 = *(const f32x4*)(onb + c + 4);
    u32x4 o; o.x = pk2(acc[0] * rstd * g0[0], acc[1] * rstd * g0[1]); o.y = pk2(acc[2] * rstd * g0[2], acc[3] * rstd * g0[3]);
    o.z = pk2(acc[4] * rstd * g1[0], acc[5] * rstd * g1[1]); o.w = pk2(acc[6] * rstd * g1[2], acc[7] * rstd * g1[3]);
    *(u32x4*)(MIX + (size_t)tok * DM + 512 + c) = o;
}


#define XB_TMO      128
#define XB_XCNT(j)  (256  + 64 * (j))
#define XB_XSUB(j)  (1280 + 64 * (j))
#define XB_XGEN(j)  (2304 + 64 * (j))
#define XB_TOP      3328
#define XB_TOPGEN   3392
#define XCD_BAR_WORDS 3456
#define XB_SPIN_CAP (1u << 22)
__device__ __forceinline__ unsigned xb_ld(unsigned* p)              { return __hip_atomic_load(p, __ATOMIC_RELAXED, __HIP_MEMORY_SCOPE_AGENT); }
__device__ __forceinline__ unsigned xb_add(unsigned* p, unsigned v) { return __hip_atomic_fetch_add(p, v, __ATOMIC_RELAXED, __HIP_MEMORY_SCOPE_AGENT); }
__device__ __forceinline__ unsigned xb_xcc_id() { return (unsigned)__builtin_amdgcn_s_getreg((3 << 11) | 20) & 0xFu; }
#define XB_SPIN(cond, bar) do { unsigned _sp = 0; while (cond) { __builtin_amdgcn_s_sleep(1); \
    if ((++_sp & 255u) == 0u) { if (xb_ld(&(bar)[XB_TMO])) break; if (_sp > XB_SPIN_CAP) { atomicAdd(&(bar)[XB_TMO], 1u); break; } } } } while (0)
struct XcdBarrier { unsigned* bar; unsigned x; volatile LAS unsigned* st; };
__device__ __forceinline__ XcdBarrier xcd_barrier_post(unsigned* bar, volatile LAS unsigned* st) {
    XcdBarrier b; b.bar = bar; b.x = xb_xcc_id(); b.st = st;
    if (threadIdx.x == 0) (void)xb_add(&bar[XB_XCNT(b.x)], 1u);
    return b;
}
__device__ __forceinline__ void xcd_barrier_complete(unsigned* bar, unsigned x, unsigned& nloc, unsigned& nx) {
    const unsigned G = gridDim.x * gridDim.y * gridDim.z;
    unsigned sum, cnt, mine, sp = 0u;
    for (;;) {
        sum = 0u; cnt = 0u; mine = 0u;
#pragma unroll
        for (unsigned j = 0; j < 16; ++j) { const unsigned c = xb_ld(&bar[XB_XCNT(j)]); sum += c; cnt += (c > 0u) ? 1u : 0u; mine = (j == x) ? c : mine; }
        if (sum == G) break;
        __builtin_amdgcn_s_sleep(1);
        if ((++sp & 255u) == 0u) { if (xb_ld(&bar[XB_TMO])) break; if (sp > XB_SPIN_CAP) { atomicAdd(&bar[XB_TMO], 1u); break; } }
    }
    nloc = mine > 0u ? mine : 1u; nx = cnt > 0u ? cnt : 1u;
}
__device__ __forceinline__ void xcd_barrier(const XcdBarrier& b) {
    asm volatile("s_waitcnt vmcnt(0)" ::: "memory");
    __syncthreads();
    if (threadIdx.x == 0) {
        unsigned* bar = b.bar;
        __builtin_amdgcn_s_waitcnt(0);
        unsigned nloc = b.st[0], nx = b.st[1];
        if (nloc == 0u) { xcd_barrier_complete(bar, b.x, nloc, nx); b.st[0] = nloc; b.st[1] = nx; }
        const unsigned old = xb_add(&bar[XB_XSUB(b.x)], 1u);
        const unsigned gen = old / nloc;
        if (old + 1u == (gen + 1u) * nloc) {
            __builtin_amdgcn_fence(__ATOMIC_RELEASE, "agent");
            asm volatile("s_waitcnt vmcnt(0)" ::: "memory");
            const unsigned og = xb_add(&bar[XB_TOP], 1u);
            const unsigned tg = og / nx;
            if (og + 1u == (tg + 1u) * nx) xb_add(&bar[XB_TOPGEN], 1u);
            else XB_SPIN(xb_ld(&bar[XB_TOPGEN]) == tg, bar);
            __builtin_amdgcn_fence(__ATOMIC_ACQUIRE, "agent");
            xb_add(&bar[XB_XGEN(b.x)], 1u);
            asm volatile("s_waitcnt vmcnt(0)" ::: "memory");
        } else {
            XB_SPIN(xb_ld(&bar[XB_XGEN(b.x)]) == gen, bar);
            __builtin_amdgcn_fence(__ATOMIC_ACQUIRE, "agent");
            asm volatile("s_waitcnt vmcnt(0)" ::: "memory");
        }
    }
    __syncthreads();
}
constexpr size_t WS_BAR = 1048576 + 65536;
constexpr int LDS_MISC = 131072 + 320;

typedef const char __attribute__((address_space(4))) kchar_t;
#define KARG(field) (*(decltype(Args::field) const __attribute__((address_space(4)))*)(kp + offsetof(Args, field)))
#define PHASE_BEGIN int tid = threadIdx.x; asm volatile("" : "+v"(tid)); const int lane = tid & 63, wave = __builtin_amdgcn_readfirstlane(tid >> 6); \
    const int G = gridDim.x, bx = blockIdx.x, gw = bx * NWAVES + wave, NGW = G * NWAVES; (void)lane; (void)gw; (void)NGW; \
    kchar_t* kp = (kchar_t*)__builtin_amdgcn_kernarg_segment_ptr(); asm volatile("" : "+s"(kp)); \
    unsigned char* ws = KARG(ws); (void)ws; int l = lsel; asm volatile("" : "+s"(l));
#define WSP(T, off) ((T*)(ws + (off)))
__global__ void __launch_bounds__(NTHREADS, 2) hybrid_fwd(Args a) {
    extern __shared__ __attribute__((aligned(16))) unsigned char lds_raw[];
    LAS unsigned char* L = (LAS unsigned char*)lds_raw;
    const int lo = a.ph_lo, hi = a.ph_hi, coop = a.coop;
    if (threadIdx.x < 8) ((LAS unsigned*)(L + LDS_MISC))[threadIdx.x] = 0u;
    __syncthreads();
    XcdBarrier xbar; xbar.bar = (unsigned*)(a.ws + WS_BAR); xbar.x = 0; xbar.st = nullptr;
    if (coop) xbar = xcd_barrier_post((unsigned*)(a.ws + WS_BAR), (volatile LAS unsigned*)(L + LDS_MISC));
    bool first_seam = true;
#ifndef PH_MASK
#define PH_MASK 0xFFFFu
#endif
#define IN(k) (((PH_MASK >> ((k) >= 20 ? 10 : (k) % 10)) & 1u) && lo <= (k) && (k) < hi)
#ifndef PROBE_DUP
#define PROBE_DUP 0u
#endif
#define NREP(k) (1 + (int)((PROBE_DUP >> (k)) & 1u))
#ifndef PROBE_SYNC
#define PROBE_SYNC 1
#endif
#define SEAM() do { if (coop) { for (int s_ = 0; s_ < PROBE_SYNC; ++s_) { if (first_seam) { cg::this_grid().sync(); first_seam = false; } else xcd_barrier(xbar); } } else __syncthreads(); } while (0)

#pragma unroll 1
    for (int lsel = 0; lsel < 2; ++lsel) {
        const int pb = lsel * 10;
        if (IN(pb + 0)) for (int rep_ = 0; rep_ < NREP(0); ++rep_) { if (rep_) __syncthreads();
            PHASE_BEGIN
            LAS float* scr = (LAS float*)(L + wave * 16384);
            constexpr int I_IN = 32 * (INP / 32), I_O = 32 * 64, I_1 = 32 * 256, I_2 = 128 * 64, I_G = 32 * 64, I_P = 4 * 64;
            constexpr int NITEMS = I_IN + I_O + I_1 + I_2 + I_G + I_P;
            for (int it = gw; it < NITEMS; it += NGW) {
                int r = it;
                if (r < I_IN) { transpose_item(KARG(w_in) + (size_t)l * DM * INC, DM, INC, INP, WSP(bf16_t, WS_WIN), scr, r, lane); continue; } r -= I_IN;
                if (r < I_O) { transpose_item(KARG(w_o) + (size_t)l * DM * DM, DM, DM, DM, WSP(bf16_t, WS_WO), scr, r, lane); continue; } r -= I_O;
                if (r < I_1) { transpose_item(KARG(w_ff1) + (size_t)l * DM * FFD, DM, FFD, FFD, WSP(bf16_t, WS_W1), scr, r, lane); continue; } r -= I_1;
                if (r < I_2) { transpose_item(KARG(w_ff2) + (size_t)l * DM * FFD, FFD, DM, DM, WSP(bf16_t, WS_W2), scr, r, lane); continue; } r -= I_2;
                if (r < I_G) { transpose_item(KARG(w_ple_gate) + (size_t)l * DM * DM, DM, DM, DM, WSP(bf16_t, WS_WG), scr, r, lane); continue; } r -= I_G;
                transpose_item(KARG(w_ple_proj) + (size_t)l * PLE * DM, PLE, DM, DM, WSP(bf16_t, WS_WP), scr, r, lane);
            }
            {
                const f32x4* src = (const f32x4*)(KARG(p) + (size_t)l * TOK * PLE); u32x2* dst = WSP(u32x2, WS_P16);
                for (int i = bx * NTHREADS + tid; i < TOK * PLE / 4; i += G * NTHREADS) { const f32x4 v = src[i]; u32x2 w; w.x = pk2(v[0], v[1]); w.y = pk2(v[2], v[3]); dst[i] = w; }
            }
            const float* hsrc = (l == 0) ? KARG(x) : (const float*)KARG(out);
            for (int m = gw; m < TOK; m += NGW) rms_row_bf16(hsrc + (size_t)m * DM, KARG(norm_mix) + l * DM, WSP(bf16_t, WS_XN) + (size_t)m * DM, lane);
        }
        if (IN(pb + 0) && IN(pb + 1)) SEAM();
        if (IN(pb + 1)) for (int rep_ = 0; rep_ < NREP(1); ++rep_) { if (rep_) __syncthreads();
            PHASE_BEGIN
            pg8::Gemm g{WSP(bf16_t, WS_XN), WSP(bf16_t, WS_WIN), TOK, INP, DM}; pg8::StaticOrder S; S.init(TOK, INP, G, bx);
            EpiProj E{WSP(bf16_t, WS_BIG), WSP(float, WS_AB)};
            pg8::gemm_phase<EpiProj>(L, g, S, E, tid);
        }
        if (IN(pb + 1) && IN(pb + 2)) SEAM();
        if (IN(pb + 2)) for (int rep_ = 0; rep_ < NREP(2); ++rep_) { if (rep_) __syncthreads();
            PHASE_BEGIN
            for (int it = bx; it < 2048; it += G)
                gdn_chunk_item(L, it, WSP(bf16_t, WS_BIG), WSP(float, WS_AB), KARG(gdn_conv) + (size_t)l * 4 * 3072, KARG(gdn_a_log) + l * 8, KARG(gdn_dt_bias) + l * 8, ws + WS_GDN, WSP(float, WS_GL), tid);
        }
        if (IN(pb + 2) && IN(pb + 3)) SEAM();
        if (IN(pb + 3)) for (int rep_ = 0; rep_ < NREP(3); ++rep_) { if (rep_) __syncthreads();
            PHASE_BEGIN
            const int nscan = (G > 32) ? 32 : 0;
            if (bx < nscan) {
                gdn_scan(L, bx, ws + WS_GDN, WSP(float, WS_GL), WSP(bf16_t, WS_BIG), KARG(gdn_norm) + l * 128, WSP(bf16_t, WS_XN), tid);
            } else {
                if (nscan == 0) { for (int bh = bx; bh < 32; bh += G) gdn_scan(L, bh, ws + WS_GDN, WSP(float, WS_GL), WSP(bf16_t, WS_BIG), KARG(gdn_norm) + l * 128, WSP(bf16_t, WS_XN), tid); }
                const int rb = bx - nscan, RG = G - nscan;
                for (int it = rb; it < 512; it += RG)
                    sgu_item(L, it, WSP(bf16_t, WS_BIG), KARG(sg_w) + (size_t)l * 4 * 16384, KARG(sg_b) + l * 512, KARG(sg_ln_g) + l * 512, KARG(sg_ln_b) + l * 512, KARG(out_norm_a) + l * 512, WSP(bf16_t, WS_XN), tid);
                for (int tk = rb * NWAVES + wave; tk < TOK; tk += RG * NWAVES)
                    shortconv_token(tk, WSP(bf16_t, WS_BIG), KARG(sc_conv) + l * 3 * 512, KARG(out_norm_b) + l * 512, WSP(bf16_t, WS_XN), lane);
            }
        }
        if (IN(pb + 3) && IN(pb + 4)) SEAM();
        if (IN(pb + 4)) for (int rep_ = 0; rep_ < NREP(4); ++rep_) { if (rep_) __syncthreads();
            PHASE_BEGIN
            pg8::Gemm g{WSP(bf16_t, WS_XN), WSP(bf16_t, WS_WO), TOK, DM, DM}; pg8::StaticOrder S; S.init(TOK, DM, G, bx);
            const float* hsrc = (l == 0) ? KARG(x) : (const float*)KARG(out);
            EpiRes E{hsrc, KARG(out)};
            pg8::gemm_phase<EpiRes>(L, g, S, E, tid);
        }
        if (IN(pb + 4) && IN(pb + 5)) SEAM();
        if (IN(pb + 5)) for (int rep_ = 0; rep_ < NREP(5); ++rep_) { if (rep_) __syncthreads();
            PHASE_BEGIN
            for (int m = gw; m < TOK; m += NGW) rms_row_bf16(KARG(out) + (size_t)m * DM, KARG(norm_ffn) + l * DM, WSP(bf16_t, WS_XN) + (size_t)m * DM, lane);
        }
        if (IN(pb + 5) && IN(pb + 6)) SEAM();
        if (IN(pb + 6)) for (int rep_ = 0; rep_ < NREP(6); ++rep_) { if (rep_) __syncthreads();
            PHASE_BEGIN
            pg8::Gemm g{WSP(bf16_t, WS_XN), WSP(bf16_t, WS_W1), TOK, FFD, DM}; pg8::StaticOrder S; S.init(TOK, FFD, G, bx);
            EpiRelu2 E{WSP(bf16_t, WS_BIG)};
            pg8::gemm_phase<EpiRelu2>(L, g, S, E, tid);
        }
        if (IN(pb + 6) && IN(pb + 7)) SEAM();
        if (IN(pb + 7)) for (int rep_ = 0; rep_ < NREP(7); ++rep_) { if (rep_) __syncthreads();
            PHASE_BEGIN
            pg8::Gemm g{WSP(bf16_t, WS_BIG), WSP(bf16_t, WS_W2), TOK, DM, FFD}; pg8::StaticOrder S; S.init(TOK, DM, G, bx);
            EpiRes E{KARG(out), KARG(out)};
            pg8::gemm_phase<EpiRes>(L, g, S, E, tid);
        }
        if (IN(pb + 7) && IN(pb + 8)) SEAM();
        if (IN(pb + 8)) for (int rep_ = 0; rep_ < NREP(8); ++rep_) {
            PHASE_BEGIN
            for (int m = gw; m < TOK; m += NGW) rms_row_bf16(KARG(out) + (size_t)m * DM, KARG(norm_ple) + l * DM, WSP(bf16_t, WS_XN) + (size_t)m * DM, lane);
        }
        if (IN(pb + 8)) for (int rep_ = 0; rep_ < NREP(10); ++rep_) {
            __syncthreads();
            PHASE_BEGIN
            pg8::Gemm g{WSP(bf16_t, WS_P16), WSP(bf16_t, WS_WP), TOK, DM, PLE}; pg8::StaticOrder S; S.init(TOK, DM, G, bx);
            EpiPlain E{WSP(bf16_t, WS_BIG)};
            pg8::gemm_phase<EpiPlain>(L, g, S, E, tid);
        }
        if (IN(pb + 8) && IN(pb + 9)) SEAM();
        if (IN(pb + 9)) for (int rep_ = 0; rep_ < NREP(9); ++rep_) { if (rep_) __syncthreads();
            PHASE_BEGIN
            pg8::Gemm g{WSP(bf16_t, WS_XN), WSP(bf16_t, WS_WG), TOK, DM, DM}; pg8::StaticOrder S; S.init(TOK, DM, G, bx);
            EpiGate E{WSP(bf16_t, WS_BIG), KARG(out)};
            pg8::gemm_phase<EpiGate>(L, g, S, E, tid);
        }
        if (IN(pb + 9) && IN(pb + 10)) SEAM();
    }
    if (IN(20)) {
        const int lsel = 0;
        PHASE_BEGIN
        for (int m = gw; m < TOK; m += NGW) rms_row_f32(KARG(out) + (size_t)m * DM, KARG(norm_final), KARG(out) + (size_t)m * DM, lane);
    }
#undef IN
#undef SEAM
}

extern "C" void kernel_launch(void* const* d_in, const int* in_sizes, int n_in, void* d_out, int out_size, void* d_ws, size_t ws_size, hipStream_t stream) {
    static int grid = 0;
    if (grid == 0) {
        if (n_in != 23 || out_size != TOK * DM || ws_size < WS_END) { fprintf(stderr, "kernel_launch: unexpected shapes (n_in %d out %d ws %zu need %zu)\n", n_in, out_size, ws_size, (size_t)WS_END); grid = -1; return; }
        int dev = 0, cus = 0, per_cu = 0;
        hipGetDevice(&dev);
        hipDeviceGetAttribute(&cus, hipDeviceAttributeMultiprocessorCount, dev);
        if (hipFuncSetAttribute((const void*)hybrid_fwd, hipFuncAttributeMaxDynamicSharedMemorySize, LDS_BYTES) != hipSuccess) { fprintf(stderr, "kernel_launch: hipFuncSetAttribute failed\n"); grid = -1; return; }
        if (hipOccupancyMaxActiveBlocksPerMultiprocessor(&per_cu, (const void*)hybrid_fwd, NTHREADS, LDS_BYTES) != hipSuccess || per_cu < 1) { fprintf(stderr, "kernel_launch: occupancy query gave %d\n", per_cu); per_cu = 1; }
        (void)hipGetLastError();
        grid = cus * per_cu;
    }
    if (grid < 0) return;
    Args a{};
    const float** f = (const float**)&a;
    for (int i = 0; i < 23; ++i) f[i] = (const float*)d_in[i];
    a.out = (float*)d_out; a.ws = (unsigned char*)d_ws;
#if MK_COOP
    if (hipMemsetAsync((char*)d_ws + WS_BAR, 0, 16384, stream) != hipSuccess) { fprintf(stderr, "kernel_launch: memset failed\n"); return; }
    a.ph_lo = 0; a.ph_hi = 21; a.coop = 1;
    void* args[] = {&a};
    hipError_t e = hipLaunchCooperativeKernel((const void*)hybrid_fwd, dim3(grid), dim3(NTHREADS), args, LDS_BYTES, stream);
    if (e != hipSuccess) fprintf(stderr, "cooperative launch failed: %s (grid %d)\n", hipGetErrorString(e), grid);
#else
    for (int ph = 0; ph < 21; ++ph) {
        a.ph_lo = ph; a.ph_hi = ph + 1; a.coop = 0;
        hipLaunchKernelGGL(hybrid_fwd, dim3(grid), dim3(NTHREADS), LDS_BYTES, stream, a);
    }
#endif
}
```

```cpp
#include <hip/hip_runtime.h>
#include <hip/hip_cooperative_groups.h>
#include <cstdio>
#include <cstdint>
#include <cstddef>
namespace cg = cooperative_groups;

#ifndef MK_COOP
#define MK_COOP 1
#endif

#define LAS __attribute__((address_space(3)))
typedef unsigned short bf16_t;
typedef short bf16x8 __attribute__((ext_vector_type(8)));
typedef float f32x4 __attribute__((ext_vector_type(4)));
typedef float f32x2 __attribute__((ext_vector_type(2)));
typedef unsigned u32x4 __attribute__((ext_vector_type(4)));
typedef unsigned u32x2 __attribute__((ext_vector_type(2)));

namespace pg8 {
constexpr int BM = 256, BK = 64, HALF = 128, HTB = HALF * BK * 2, STAGE_BYTES = 8 * HTB, NXCD = 8, WGM = 8;
__host__ __device__ __forceinline__ int lds_byte(int r, int c) { const int st = (r >> 4) * 2 + (c >> 5), rr = r & 15, cc = c & 31, ob = rr * 64 + cc * 2; return st * 1024 + (ob ^ (((ob >> 9) & 1) << 5)); }
__host__ __device__ __forceinline__ void stage_rc(int b, int& R, int& C) { const int st = b / 1024, sb = b % 1024, swz = sb ^ (((sb >> 9) & 1) << 5); R = (st >> 1) * 16 + swz / 64; C = (st & 1) * 32 + (swz % 64) / 2; }
__host__ __device__ __forceinline__ int perm32(int rho) { const int n = rho >> 4, i = rho & 15; return 8 * (i >> 2) + 4 * n + (i & 3); }

struct Unit { int pm, pn; };
struct Gemm { const bf16_t* A; const bf16_t* Bt; int M, N, K; };

struct StaticOrder {
    int nM, nN, nwg, G, c;
    __host__ __device__ void init(int M, int N, int G_, int c_) { nM = M / BM; nN = N / BM; nwg = nM * nN; G = G_; c = c_; }
    __host__ __device__ bool next(int i, Unit& u) const {
        const long L = (long)i * G + c; if (L >= nwg) return false;
        int wgid = (int)L; { const int q = nwg / NXCD, r = nwg % NXCD, xcd = wgid % NXCD, off = wgid / NXCD; wgid = (xcd < r ? xcd * (q + 1) : r * (q + 1) + (xcd - r) * q) + off; }
        const int nig = WGM * nN, gid = wgid / nig, fm = gid * WGM, gsz = (nM - fm) < WGM ? (nM - fm) : WGM;
        u.pm = fm + ((wgid % nig) % gsz); u.pn = (wgid % nig) / gsz; return true;
    }
};

__device__ __forceinline__ unsigned cvt_pk_bf16(float lo, float hi) { unsigned r; asm volatile("v_cvt_pk_bf16_f32 %0, %1, %2" : "=v"(r) : "v"(lo), "v"(hi)); return r; }

template <class Epi>
__device__ __forceinline__ void gemm_phase(LAS unsigned char* lds, const Gemm g, const StaticOrder& S, const Epi& E, const int tid) {
    const int wid = __builtin_amdgcn_readfirstlane(tid >> 6), lane = tid & 63, wr = wid >> 2, wc = wid & 3, fr = lane & 15, fq = lane >> 4;
    int K_ = g.K; asm volatile("" : "+s"(K_)); const int K = K_, nt = K / BK;
    unsigned voffA[2], voffB[2];
#pragma unroll
    for (int i = 0; i < 2; ++i) { int R, C; stage_rc(tid * 16 + i * 8192, R, C); const int Rb = (R & ~31) + perm32(R & 31);
        voffA[i] = (unsigned)(R * K + C) * 2u; voffB[i] = (unsigned)(Rb * K + C) * 2u; }
    const size_t kstep = (size_t)(BK * 2);
    const size_t hstep = (size_t)HALF * K * 2;
    const size_t tstep = 2 * hstep;
    const unsigned ldsw = (unsigned)wid * 1024u;
    const int aoff = lds_byte(wr * 64 + fr, fq * 8), boff = lds_byte(wc * 32 + fr, fq * 8);
#define PG8_SA(b, h) (((b) * 2 + (h)) * HTB)
#define PG8_SB(b, h) ((4 + (b) * 2 + (h)) * HTB)
#define PG8_STAGE(bufoff, gbase, voff) do { _Pragma("unroll") for (int _i = 0; _i < 2; ++_i) \
        __builtin_amdgcn_global_load_lds((const unsigned*)((const char*)(gbase) + (voff)[_i]), (LAS unsigned*)(lds + (bufoff) + ldsw + _i * 8192), 16, 0, 0); } while (0)
#define PG8_LDA(dst, b, h) do { _Pragma("unroll") for (int m = 0; m < 4; ++m) _Pragma("unroll") for (int k = 0; k < 2; ++k) dst[m][k] = *(const LAS bf16x8*)(lds + PG8_SA(b, h) + aoff + m * 2048 + k * 1024); } while (0)
#define PG8_LDB(dst, b, h) do { _Pragma("unroll") for (int n = 0; n < 2; ++n) _Pragma("unroll") for (int k = 0; k < 2; ++k) dst[n][k] = *(const LAS bf16x8*)(lds + PG8_SB(b, h) + boff + n * 2048 + k * 1024); } while (0)
#define PG8_MMA(ai, bj, At, Bt) do { __builtin_amdgcn_s_setprio(1); _Pragma("unroll") for (int m = 0; m < 4; ++m) _Pragma("unroll") for (int n = 0; n < 2; ++n) _Pragma("unroll") for (int k = 0; k < 2; ++k) \
        acc[ai][bj][m][n] = __builtin_amdgcn_mfma_f32_16x16x32_bf16(Bt[n][k], At[m][k], acc[ai][bj][m][n], 0, 0, 0); __builtin_amdgcn_s_setprio(0); } while (0)
#define PG8_WAIT_V(n) asm volatile("s_waitcnt vmcnt(" #n ")" ::: "memory")
#define PG8_WAIT_L(n) asm volatile("s_waitcnt lgkmcnt(" #n ")" ::: "memory")
#define PG8_BAR __builtin_amdgcn_s_barrier()
#define PG8_SCHED __builtin_amdgcn_sched_barrier(0)
    Unit cur, nxt; int ui = 0;
    if (!S.next(0, cur)) return;
    f32x4 acc[2][2][4][2];
#pragma unroll
    for (int a = 0; a < 2; ++a)
#pragma unroll
        for (int b = 0; b < 2; ++b)
#pragma unroll
            for (int m = 0; m < 4; ++m)
#pragma unroll
                for (int n = 0; n < 2; ++n) acc[a][b][m][n] = (f32x4){0.f, 0.f, 0.f, 0.f};
    bf16x8 At[4][2], B0[2][2], B1[2][2];
    const char* cA = (const char*)g.A + (size_t)cur.pm * tstep; const char* cB = (const char*)g.Bt + (size_t)cur.pn * tstep;
    PG8_STAGE(PG8_SB(0, 0), cB, voffB); PG8_STAGE(PG8_SB(0, 1), cB + hstep, voffB); PG8_STAGE(PG8_SA(0, 0), cA, voffA); PG8_STAGE(PG8_SA(0, 1), cA + hstep, voffA);
    if (wr == 1) PG8_BAR;
    PG8_WAIT_V(2); PG8_BAR;
    PG8_STAGE(PG8_SB(1, 0), cB + kstep, voffB); PG8_STAGE(PG8_SA(1, 0), cA + kstep, voffA); PG8_STAGE(PG8_SB(1, 1), cB + hstep + kstep, voffB);
    PG8_WAIT_V(6); PG8_BAR;
    for (;;) {
        const bool has_next = S.next(ui + 1, nxt);
        const char* nA = has_next ? (const char*)g.A + (size_t)nxt.pm * tstep : cA; const char* nB = has_next ? (const char*)g.Bt + (size_t)nxt.pn * tstep : cB;
        for (int t = 0; t < nt; t += 2) {
            const bool last = (t == nt - 2);
            const char* a1 = cA + (size_t)(t + 1) * kstep;
            const char* a2 = last ? nA : cA + (size_t)(t + 2) * kstep; const char* b2 = last ? nB : cB + (size_t)(t + 2) * kstep;
            const char* a3 = a2 + kstep; const char* b3 = b2 + kstep;
            PG8_LDB(B0, 0, 0); PG8_LDB(B1, 0, 1); PG8_SCHED; PG8_LDA(At, 0, 0); PG8_STAGE(PG8_SA(1, 1), a1 + hstep, voffA);
            PG8_WAIT_V(8); PG8_WAIT_L(0); PG8_BAR; PG8_MMA(0, 0, At, B0); PG8_MMA(0, 1, At, B1); PG8_BAR; PG8_SCHED;
            PG8_LDA(At, 0, 1); PG8_STAGE(PG8_SB(0, 0), b2, voffB); PG8_STAGE(PG8_SB(0, 1), b2 + hstep, voffB); PG8_STAGE(PG8_SA(0, 0), a2, voffA);
            PG8_WAIT_V(8); PG8_WAIT_L(0); PG8_BAR; PG8_MMA(1, 0, At, B0); PG8_MMA(1, 1, At, B1); PG8_BAR; PG8_SCHED;
            PG8_LDB(B0, 1, 0); PG8_LDB(B1, 1, 1); PG8_SCHED; PG8_LDA(At, 1, 0); PG8_STAGE(PG8_SA(0, 1), a2 + hstep, voffA);
            PG8_WAIT_V(8); PG8_WAIT_L(0); PG8_BAR; PG8_MMA(0, 0, At, B0); PG8_MMA(0, 1, At, B1); PG8_BAR; PG8_SCHED;
            PG8_LDA(At, 1, 1); PG8_STAGE(PG8_SB(1, 0), b3, voffB); PG8_STAGE(PG8_SB(1, 1), b3 + hstep, voffB); PG8_STAGE(PG8_SA(1, 0), a3, voffA);
            PG8_WAIT_V(8); PG8_WAIT_L(0); PG8_BAR; PG8_MMA(1, 0, At, B0); PG8_MMA(1, 1, At, B1); PG8_BAR; PG8_SCHED;
        }
        if (wr == 0) PG8_BAR;
        E(acc, cur, wr, wc, fr, fq);
        if (!has_next) break;
#pragma unroll
        for (int a = 0; a < 2; ++a)
#pragma unroll
            for (int b = 0; b < 2; ++b)
#pragma unroll
                for (int m = 0; m < 4; ++m)
#pragma unroll
                    for (int n = 0; n < 2; ++n) acc[a][b][m][n] = (f32x4){0.f, 0.f, 0.f, 0.f};
        cur = nxt; cA = nA; cB = nB; ++ui;
        if (wr == 1) PG8_BAR;
    }
    PG8_WAIT_V(0);
    PG8_BAR;
#undef PG8_SA
#undef PG8_SB
#undef PG8_STAGE
#undef PG8_LDA
#undef PG8_LDB
#undef PG8_MMA
#undef PG8_WAIT_V
#undef PG8_WAIT_L
#undef PG8_BAR
#undef PG8_SCHED
}
}

constexpr int TOK = 16384, DM = 2048, SEQL = 4096, FFD = 8192, PLE = 256;
constexpr int INC = 6672, INP = 6912, PJ = 6656;
constexpr int C_U = 0, C_V = 512, C_GB = 1024, C_GC = 1536, C_XI = 2048, C_Q = 2560, C_Z = 5632;
constexpr float EPSF = 1e-6f;
constexpr int NTHREADS = 512, NWAVES = 8;
constexpr int LDS_BYTES = 147456;

constexpr size_t WS_AB = 0;
constexpr size_t WS_GL = 1048576;
constexpr size_t WS_WIN = 2097152;
constexpr size_t WS_WO = WS_WIN + (size_t)INP * DM * 2;
constexpr size_t WS_W1 = WS_WO + (size_t)DM * DM * 2;
constexpr size_t WS_W2 = WS_W1 + (size_t)FFD * DM * 2;
constexpr size_t WS_WG = WS_W2 + (size_t)FFD * DM * 2;
constexpr size_t WS_WP = WS_WG + (size_t)DM * DM * 2;
constexpr size_t WS_P16 = WS_WP + (size_t)DM * PLE * 2;
constexpr size_t WS_XN = WS_P16 + (size_t)TOK * PLE * 2;
constexpr size_t WS_BIG = WS_XN + (size_t)TOK * DM * 2;
constexpr size_t WS_GDN = WS_BIG + (size_t)TOK * FFD * 2;
constexpr size_t GDN_ITEM = 73728;
constexpr size_t WS_END = WS_GDN + 2048 * GDN_ITEM;

struct Args {
    const float *x, *p, *norm_mix, *w_in, *sg_ln_g, *sg_ln_b, *sg_w, *sg_b, *sc_conv, *gdn_conv, *gdn_a_log, *gdn_dt_bias, *gdn_norm,
        *out_norm_a, *out_norm_b, *w_o, *norm_ffn, *w_ff1, *w_ff2, *norm_ple, *w_ple_gate, *w_ple_proj, *norm_final;
    float* out; unsigned char* ws; int ph_lo, ph_hi, coop, pad;
};

__device__ __forceinline__ unsigned pk2(float lo, float hi) { return pg8::cvt_pk_bf16(lo, hi); }
__device__ __forceinline__ float bf2f(unsigned short v) { return __uint_as_float((unsigned)v << 16); }
__device__ __forceinline__ float bflo(unsigned w) { return __uint_as_float(w << 16); }
__device__ __forceinline__ float bfhi(unsigned w) { return __uint_as_float(w & 0xffff0000u); }
__device__ __forceinline__ float wave_sum(float v) {
#pragma unroll
    for (int o = 1; o < 64; o <<= 1) v += __shfl_xor(v, o);
    return v;
}
__device__ __forceinline__ float sigmoidf_(float x) { return 1.0f / (1.0f + __expf(-x)); }
__device__ __forceinline__ float gelu_tanh(float x) { const float y = 1.5957691216057308f * x * (1.0f + 0.044715f * x * x); return x / (1.0f + __expf(-y)); }
__device__ __forceinline__ bf16x8 pack8(const f32x4 a, const f32x4 b) {
    u32x4 w; w.x = pk2(a[0], a[1]); w.y = pk2(a[2], a[3]); w.z = pk2(b[0], b[1]); w.w = pk2(b[2], b[3]);
    return __builtin_bit_cast(bf16x8, w);
}
__host__ __device__ __forceinline__ int kperm(int d) { return (d & ~31) + 8 * ((d >> 2) & 3) + 4 * ((d >> 4) & 1) + (d & 3); }
#define LDS_WAIT() asm volatile("s_waitcnt lgkmcnt(0)" ::: "memory")
#define LBAR() do { asm volatile("s_waitcnt lgkmcnt(0)" ::: "memory"); __builtin_amdgcn_s_barrier(); asm volatile("" ::: "memory"); } while (0)

#define EPI_LOOP_BEGIN  _Pragma("unroll") for (int ai = 0; ai < 2; ++ai) _Pragma("unroll") for (int m = 0; m < 4; ++m) { const int row = u.pm * 256 + ai * 128 + wr * 64 + m * 16 + fr; \
                        _Pragma("unroll") for (int bj = 0; bj < 2; ++bj) { const int col = u.pn * 256 + bj * 128 + wc * 32 + 8 * fq; f32x4 v0 = acc[ai][bj][m][0], v1 = acc[ai][bj][m][1];
#define EPI_LOOP_END    } }
#define EPI_ARGS const f32x4 (&acc)[2][2][4][2], const pg8::Unit& u, int wr, int wc, int fr, int fq

struct EpiProj {
    bf16_t* P; float* AB;
    __device__ __forceinline__ void operator()(EPI_ARGS) const {
        if (u.pn < 26) {
            const bool act = u.pn < 4;
            EPI_LOOP_BEGIN
                if (act) {
#pragma unroll
                    for (int e = 0; e < 4; ++e) { v0[e] = gelu_tanh(v0[e]); v1[e] = gelu_tanh(v1[e]); }
                }
                u32x4 w; w.x = pk2(v0[0], v0[1]); w.y = pk2(v0[2], v0[3]); w.z = pk2(v1[0], v1[1]); w.w = pk2(v1[2], v1[3]);
                *(u32x4*)(P + (size_t)row * PJ + col) = w;
            EPI_LOOP_END
        } else {
            if (wc == 0 && fq < 2) {
#pragma unroll
                for (int ai = 0; ai < 2; ++ai)
#pragma unroll
                    for (int m = 0; m < 4; ++m) { const int row = u.pm * 256 + ai * 128 + wr * 64 + m * 16 + fr;
                        *(f32x4*)(AB + (size_t)row * 16 + 8 * fq) = acc[ai][0][m][0]; *(f32x4*)(AB + (size_t)row * 16 + 8 * fq + 4) = acc[ai][0][m][1]; }
            }
        }
    }
};
struct EpiRes {
    const float* base; float* out;
    __device__ __forceinline__ void operator()(EPI_ARGS) const {
        EPI_LOOP_BEGIN
            const size_t off = (size_t)row * DM + col;
            const f32x4 b0 = *(const f32x4*)(base + off), b1 = *(const f32x4*)(base + off + 4);
            *(f32x4*)(out + off) = b0 + v0; *(f32x4*)(out + off + 4) = b1 + v1;
        EPI_LOOP_END
    }
};
struct EpiRelu2 {
    bf16_t* O;
    __device__ __forceinline__ void operator()(EPI_ARGS) const {
        EPI_LOOP_BEGIN
#pragma unroll
            for (int e = 0; e < 4; ++e) { const float a = fmaxf(v0[e], 0.f), b = fmaxf(v1[e], 0.f); v0[e] = a * a; v1[e] = b * b; }
            u32x4 w; w.x = pk2(v0[0], v0[1]); w.y = pk2(v0[2], v0[3]); w.z = pk2(v1[0], v1[1]); w.w = pk2(v1[2], v1[3]);
            *(u32x4*)(O + (size_t)row * FFD + col) = w;
        EPI_LOOP_END
    }
};
struct EpiPlain {
    bf16_t* O;
    __device__ __forceinline__ void operator()(EPI_ARGS) const {
        EPI_LOOP_BEGIN
            u32x4 w; w.x = pk2(v0[0], v0[1]); w.y = pk2(v0[2], v0[3]); w.z = pk2(v1[0], v1[1]); w.w = pk2(v1[2], v1[3]);
            *(u32x4*)(O + (size_t)row * DM + col) = w;
        EPI_LOOP_END
    }
};
struct EpiGate {
    const bf16_t* PP; float* out;
    __device__ __forceinline__ void operator()(EPI_ARGS) const {
        EPI_LOOP_BEGIN
            const size_t off = (size_t)row * DM + col;
            const u32x4 pw = *(const u32x4*)(PP + off);
            const f32x4 b0 = *(const f32x4*)(out + off), b1 = *(const f32x4*)(out + off + 4);
            f32x4 o0, o1;
            o0[0] = b0[0] + bflo(pw.x) * sigmoidf_(v0[0]); o0[1] = b0[1] + bfhi(pw.x) * sigmoidf_(v0[1]);
            o0[2] = b0[2] + bflo(pw.y) * sigmoidf_(v0[2]); o0[3] = b0[3] + bfhi(pw.y) * sigmoidf_(v0[3]);
            o1[0] = b1[0] + bflo(pw.z) * sigmoidf_(v1[0]); o1[1] = b1[1] + bfhi(pw.z) * sigmoidf_(v1[1]);
            o1[2] = b1[2] + bflo(pw.w) * sigmoidf_(v1[2]); o1[3] = b1[3] + bfhi(pw.w) * sigmoidf_(v1[3]);
            *(f32x4*)(out + off) = o0; *(f32x4*)(out + off + 4) = o1;
        EPI_LOOP_END
    }
};

__device__ __forceinline__ void transpose_item(const float* W, int K, int N, int Npad, bf16_t* WT, LAS float* scr, int item, int lane) {
    const int nblk = Npad / 32, kb = item / nblk, nb = item % nblk, k0 = 64 * kb, n0 = 32 * nb;
    const int nn = n0 + (lane & 31); const bool ok = nn < N;
#pragma unroll 8
    for (int i = 0; i < 32; ++i) { const int kk = 2 * i + (lane >> 5); scr[kk * 33 + (lane & 31)] = ok ? W[(size_t)(k0 + kk) * N + nn] : 0.f; }
    LDS_WAIT(); asm volatile("" ::: "memory");
    const int c = lane & 7;
#pragma unroll
    for (int j = 0; j < 4; ++j) { const int n = (lane >> 3) + 8 * j; const LAS float* s = scr + (8 * c) * 33 + n;
        u32x4 o; o.x = pk2(s[0 * 33], s[1 * 33]); o.y = pk2(s[2 * 33], s[3 * 33]); o.z = pk2(s[4 * 33], s[5 * 33]); o.w = pk2(s[6 * 33], s[7 * 33]);
        *(u32x4*)(WT + (size_t)(n0 + n) * K + k0 + 8 * c) = o; }
    LDS_WAIT(); asm volatile("" ::: "memory");
}
__device__ __forceinline__ void rms_row_bf16(const float* xrow, const float* g, bf16_t* orow, int lane) {
    const f32x4* xr = (const f32x4*)xrow + lane; const f32x4* gr = (const f32x4*)g + lane;
    f32x4 v[8]; float s = 0.f;
#pragma unroll
    for (int j = 0; j < 8; ++j) { v[j] = xr[64 * j]; s += (v[j][0] * v[j][0] + v[j][1] * v[j][1]) + (v[j][2] * v[j][2] + v[j][3] * v[j][3]); }
    const float rstd = 1.0f / sqrtf(wave_sum(s) * (1.0f / DM) + EPSF);
    u32x2* o8 = (u32x2*)orow + lane;
#pragma unroll
    for (int j = 0; j < 8; ++j) { const f32x4 gg = gr[64 * j]; u32x2 w; w.x = pk2(v[j][0] * rstd * gg[0], v[j][1] * rstd * gg[1]); w.y = pk2(v[j][2] * rstd * gg[2], v[j][3] * rstd * gg[3]); o8[64 * j] = w; }
}
__device__ __forceinline__ void rms_row_f32(const float* xrow, const float* g, float* orow, int lane) {
    const f32x4* xr = (const f32x4*)xrow + lane; const f32x4* gr = (const f32x4*)g + lane;
    f32x4 v[8]; float s = 0.f;
#pragma unroll
    for (int j = 0; j < 8; ++j) { v[j] = xr[64 * j]; s += (v[j][0] * v[j][0] + v[j][1] * v[j][1]) + (v[j][2] * v[j][2] + v[j][3] * v[j][3]); }
    const float rstd = 1.0f / sqrtf(wave_sum(s) * (1.0f / DM) + EPSF);
    f32x4* o = (f32x4*)orow + lane;
#pragma unroll
    for (int j = 0; j < 8; ++j) { const f32x4 gg = gr[64 * j]; o[64 * j] = v[j] * rstd * gg; }
}

__device__ __forceinline__ void gdn_chunk_item(LAS unsigned char* L, int item, const bf16_t* P, const float* AB, const float* convw, const float* a_log, const float* dt_bias,
                                               unsigned char* GDN, float* GL, int tid_in) {
    int tid = tid_in; asm volatile("" : "+v"(tid));
    const int n = item & 63, bh = item >> 6, h = bh & 7, b = bh >> 3;
    const int tok0 = b * SEQL + n * 64;
    const int wave = tid >> 6, lane = tid & 63, q4 = lane >> 4, c15 = lane & 15;
    LAS bf16_t* Kb = (LAS bf16_t*)(L);
    LAS bf16_t* Qb = (LAS bf16_t*)(L + 17408);
    LAS float* Af = (LAS float*)(L + 34816);
    LAS float* X = (LAS float*)(L + 51200);
    LAS float* gcs = (LAS float*)(L + 116736);
    LAS float* bts = gcs + 64;
    LAS float* egc = gcs + 128;
    unsigned char* gbase = GDN + (size_t)item * GDN_ITEM;
    bf16_t* g_qexp = (bf16_t*)gbase; bf16_t* g_kcd = (bf16_t*)(gbase + 16384); bf16_t* g_ktT = (bf16_t*)(gbase + 32768);
    bf16_t* g_valT = (bf16_t*)(gbase + 49152); bf16_t* g_intra = (bf16_t*)(gbase + 65536);

    const int cgi = tid % 48, seg = tid / 48, which = cgi >> 4, cc = (cgi & 15) * 8;
    const int col = C_Q + which * 1024 + h * 128 + cc;
    u32x4 raw[11];
    if (wave < 6) {
#pragma unroll
        for (int i = 0; i < 11; ++i) { const int r = seg * 8 - 3 + i;
            if (n * 64 + r >= 0) raw[i] = *(const u32x4*)(P + (size_t)(tok0 + r) * PJ + col); else raw[i] = (u32x4){0u, 0u, 0u, 0u}; }
    }
    if (wave == 0) {
        const float a = AB[(size_t)(tok0 + lane) * 16 + h], bb = AB[(size_t)(tok0 + lane) * 16 + 8 + h];
        const float xs = a + dt_bias[h];
        const float sp = xs > 20.f ? xs : log1pf(__expf(xs));
        float c = -__expf(a_log[h]) * sp;
#pragma unroll
        for (int o = 1; o < 64; o <<= 1) { const float t = __shfl_up(c, o); if (lane >= o) c += t; }
        gcs[lane] = c; bts[lane] = sigmoidf_(bb); egc[lane] = __expf(c);
    }
    LBAR();
    if (wave < 6) {
        float w[4][8];
#pragma unroll
        for (int j = 0; j < 4; ++j) { const f32x4 a = *(const f32x4*)(convw + j * 3072 + which * 1024 + h * 128 + cc), bq = *(const f32x4*)(convw + j * 3072 + which * 1024 + h * 128 + cc + 4);
            w[j][0] = a[0]; w[j][1] = a[1]; w[j][2] = a[2]; w[j][3] = a[3]; w[j][4] = bq[0]; w[j][5] = bq[1]; w[j][6] = bq[2]; w[j][7] = bq[3]; }
        float x0[8], x1[8], x2[8], x3[8];
        auto ldrow = [&](int i, float (&dst)[8]) { const u32x4 v = raw[i];
            dst[0] = bflo(v.x); dst[1] = bfhi(v.x); dst[2] = bflo(v.y); dst[3] = bfhi(v.y); dst[4] = bflo(v.z); dst[5] = bfhi(v.z); dst[6] = bflo(v.w); dst[7] = bfhi(v.w); };
        ldrow(0, x0); ldrow(1, x1); ldrow(2, x2);
#pragma unroll
        for (int i = 0; i < 8; ++i) {
            const int t = seg * 8 + i;
            ldrow(i + 3, x3);
            float y[8]; float ss = 0.f;
#pragma unroll
            for (int e = 0; e < 8; ++e) { const float c = w[0][e] * x0[e] + w[1][e] * x1[e] + w[2][e] * x2[e] + w[3][e] * x3[e]; y[e] = c * sigmoidf_(c); ss += y[e] * y[e]; }
            ss += __shfl_xor(ss, 1); ss += __shfl_xor(ss, 2); ss += __shfl_xor(ss, 4); ss += __shfl_xor(ss, 8);
            const float rn = 1.0f / sqrtf(ss + EPSF);
            const float bt = bts[t], eg = egc[t];
            if (which == 0) {
                const float s = rn * 0.08838834764831845f;
                u32x4 o; o.x = pk2(y[0] * s, y[1] * s); o.y = pk2(y[2] * s, y[3] * s); o.z = pk2(y[4] * s, y[5] * s); o.w = pk2(y[6] * s, y[7] * s);
                *(LAS u32x4*)(Qb + t * 136 + cc) = o;
            } else if (which == 1) {
                u32x4 o; o.x = pk2(y[0] * rn, y[1] * rn); o.y = pk2(y[2] * rn, y[3] * rn); o.z = pk2(y[4] * rn, y[5] * rn); o.w = pk2(y[6] * rn, y[7] * rn);
                *(LAS u32x4*)(Kb + t * 136 + cc) = o;
                const float s = rn * bt * eg;
                *(LAS f32x4*)(X + t * 256 + 128 + cc) = (f32x4){y[0] * s, y[1] * s, y[2] * s, y[3] * s};
                *(LAS f32x4*)(X + t * 256 + 128 + cc + 4) = (f32x4){y[4] * s, y[5] * s, y[6] * s, y[7] * s};
            } else {
                *(LAS f32x4*)(X + t * 256 + cc) = (f32x4){y[0] * bt, y[1] * bt, y[2] * bt, y[3] * bt};
                *(LAS f32x4*)(X + t * 256 + cc + 4) = (f32x4){y[4] * bt, y[5] * bt, y[6] * bt, y[7] * bt};
            }
#pragma unroll
            for (int e = 0; e < 8; ++e) { x0[e] = x1[e]; x1[e] = x2[e]; x2[e] = x3[e]; }
            __builtin_amdgcn_sched_barrier(0);
        }
    }
    LBAR();
    {
        const int ti = wave >> 1;
        bf16x8 ak[4], aq[4];
#pragma unroll
        for (int kb = 0; kb < 4; ++kb) { ak[kb] = *(const LAS bf16x8*)(Kb + (16 * ti + c15) * 136 + 32 * kb + 8 * q4); aq[kb] = *(const LAS bf16x8*)(Qb + (16 * ti + c15) * 136 + 32 * kb + 8 * q4); }
#pragma unroll
        for (int jj = 0; jj < 2; ++jj) {
            const int tj = 2 * (wave & 1) + jj;
            f32x4 dk = (f32x4){0.f, 0.f, 0.f, 0.f}, dq = (f32x4){0.f, 0.f, 0.f, 0.f};
#pragma unroll
            for (int kb = 0; kb < 4; ++kb) { const bf16x8 bk = *(const LAS bf16x8*)(Kb + (16 * tj + c15) * 136 + 32 * kb + 8 * q4);
                dk = __builtin_amdgcn_mfma_f32_16x16x32_bf16(ak[kb], bk, dk, 0, 0, 0); dq = __builtin_amdgcn_mfma_f32_16x16x32_bf16(aq[kb], bk, dq, 0, 0, 0); }
            const int j = 16 * tj + c15; const float gj = gcs[j];
#pragma unroll
            for (int r = 0; r < 4; ++r) { const int i = 16 * ti + 4 * q4 + r;
                const float dec = (j <= i) ? __expf(fminf(gcs[i] - gj, 0.f)) : 0.f;
                Af[i * 64 + j] = (j < i) ? bts[i] * dk[r] * dec : 0.f;
                g_intra[i * 64 + kperm(j)] = (bf16_t)(pk2(dq[r] * dec, 0.f) & 0xffffu); }
        }
    }
    LBAR();
    int tid2 = tid; asm volatile("" : "+v"(tid2));
    if (tid2 < 256) {
        const int c = tid2;
        float x[64];
        f32x4 arA[2][4], arB[12]; float xin[2];
        xin[0] = X[c]; xin[1] = X[256 + c]; arA[1][0] = *(const LAS f32x4*)(Af + 64);
#pragma unroll
        for (int i = 0; i < 64; ++i) {
            if (i >= 1 && i + 1 < 64) {
#pragma unroll
                for (int qd = 0; qd < ((i + 4) / 4 < 4 ? (i + 4) / 4 : 4); ++qd) arA[(i + 1) & 1][qd] = *(const LAS f32x4*)(Af + (i + 1) * 64 + 4 * qd);
                xin[(i + 1) & 1] = X[(i + 1) * 256 + c];
            }
            if (i > 16) {
#pragma unroll
                for (int qd = 4; qd < (i + 3) / 4; ++qd) arB[qd - 4] = *(const LAS f32x4*)(Af + i * 64 + 4 * qd);
            }
            __builtin_amdgcn_sched_barrier(0);
            float a0 = xin[i & 1], a1 = 0.f;
#pragma unroll
            for (int j = 0; j < (i < 16 ? i : 16); ++j) { if (j & 1) a1 -= arA[i & 1][j >> 2][j & 3] * x[j]; else a0 -= arA[i & 1][j >> 2][j & 3] * x[j]; }
#pragma unroll
            for (int j = 16; j < i; ++j) { if (j & 1) a1 -= arB[(j >> 2) - 4][j & 3] * x[j]; else a0 -= arB[(j >> 2) - 4][j & 3] * x[j]; }
            x[i] = a0 + a1;
            __builtin_amdgcn_sched_barrier(0);
        }
        if (c < 128) {
#pragma unroll
            for (int k = 0; k < 8; ++k) { u32x4 o; o.x = pk2(x[8 * k], x[8 * k + 1]); o.y = pk2(x[8 * k + 2], x[8 * k + 3]); o.z = pk2(x[8 * k + 4], x[8 * k + 5]); o.w = pk2(x[8 * k + 6], x[8 * k + 7]);
                *(u32x4*)(g_valT + c * 64 + 8 * k) = o; }
        } else {
            const int pd = kperm(c - 128);
#pragma unroll
            for (int i = 0; i < 64; ++i) g_kcd[i * 128 + pd] = (bf16_t)(pk2(x[i], 0.f) & 0xffffu);
        }
    } else {
        const int t2 = tid2 - 256;
        {
            const int l = t2 >> 2, kb = t2 & 3; const float eg = egc[l];
#pragma unroll
            for (int k4 = 0; k4 < 4; ++k4) { float v[8];
#pragma unroll
                for (int e = 0; e < 8; ++e) { const int pos = 8 * k4 + e, qq = pos >> 3, jh = (pos >> 2) & 1, r = pos & 3; v[e] = bf2f(Qb[l * 136 + 32 * kb + 16 * jh + 4 * qq + r]) * eg; }
                u32x4 o; o.x = pk2(v[0], v[1]); o.y = pk2(v[2], v[3]); o.z = pk2(v[4], v[5]); o.w = pk2(v[6], v[7]);
                *(u32x4*)(g_qexp + l * 128 + 32 * kb + 8 * k4) = o; }
        }
        {
            const int d = t2 >> 1, kb2 = t2 & 1; const float glast = gcs[63];
#pragma unroll
            for (int k4 = 0; k4 < 4; ++k4) { float v[8];
#pragma unroll
                for (int e = 0; e < 8; ++e) { const int pos = 8 * k4 + e, qq = pos >> 3, jh = (pos >> 2) & 1, r = pos & 3; const int l = 32 * kb2 + 16 * jh + 4 * qq + r; v[e] = bf2f(Kb[l * 136 + d]) * __expf(glast - gcs[l]); }
                u32x4 o; o.x = pk2(v[0], v[1]); o.y = pk2(v[2], v[3]); o.z = pk2(v[4], v[5]); o.w = pk2(v[6], v[7]);
                *(u32x4*)(g_ktT + d * 64 + 32 * kb2 + 8 * k4) = o; }
        }
        if (t2 == 0) GL[item] = egc[63];
    }
    LBAR();
}

__device__ __forceinline__ void gdn_scan(LAS unsigned char* L, int bh, const unsigned char* GDN, const float* GL, const bf16_t* P, const float* gnorm, bf16_t* MIX, int tid) {
    const int h = bh & 7, b = bh >> 3;
    const int wave = tid >> 6, lane = tid & 63, q4 = lane >> 4, c15 = lane & 15;
    LAS unsigned char* Lq = L;
    LAS unsigned char* Lk = L + 17408;
    LAS unsigned char* Lt = L + 34816;
    LAS unsigned char* Li = L + 53248;
    LAS unsigned char* Lv = L + 62464;
    LAS float* Lo = (LAS float*)(L + 80896);
    f32x4 S[8];
#pragma unroll
    for (int T = 0; T < 8; ++T) S[T] = (f32x4){0.f, 0.f, 0.f, 0.f};
    u32x4 pf[9];
    const int c0 = tid, c1 = tid + 512;
    const int fl = tid >> 3, fpart = tid & 7;
    LAS float* Lg = (LAS float*)(L + 114688);
    if (tid < 128) Lg[tid] = gnorm[tid];
#define SCAN_LOAD(nn) do { const unsigned char* gb_ = GDN + (size_t)(bh * 64 + (nn)) * GDN_ITEM; \
        pf[0] = *(const u32x4*)(gb_ + c0 * 16); pf[1] = *(const u32x4*)(gb_ + c1 * 16); \
        pf[2] = *(const u32x4*)(gb_ + 16384 + c0 * 16); pf[3] = *(const u32x4*)(gb_ + 16384 + c1 * 16); \
        pf[4] = *(const u32x4*)(gb_ + 32768 + c0 * 16); pf[5] = *(const u32x4*)(gb_ + 32768 + c1 * 16); \
        pf[6] = *(const u32x4*)(gb_ + 65536 + c0 * 16); \
        pf[7] = *(const u32x4*)(gb_ + 49152 + c0 * 16); pf[8] = *(const u32x4*)(gb_ + 49152 + c1 * 16); } while (0)
#define SCAN_STORE() do { \
        *(LAS u32x4*)(Lq + (c0 >> 4) * 272 + (c0 & 15) * 16) = pf[0]; *(LAS u32x4*)(Lq + (c1 >> 4) * 272 + (c1 & 15) * 16) = pf[1]; \
        *(LAS u32x4*)(Lk + (c0 >> 4) * 272 + (c0 & 15) * 16) = pf[2]; *(LAS u32x4*)(Lk + (c1 >> 4) * 272 + (c1 & 15) * 16) = pf[3]; \
        *(LAS u32x4*)(Lt + (c0 >> 3) * 144 + (c0 & 7) * 16) = pf[4]; *(LAS u32x4*)(Lt + (c1 >> 3) * 144 + (c1 & 7) * 16) = pf[5]; \
        *(LAS u32x4*)(Li + (c0 >> 3) * 144 + (c0 & 7) * 16) = pf[6]; \
        *(LAS u32x4*)(Lv + (c0 >> 3) * 144 + (c0 & 7) * 16) = pf[7]; *(LAS u32x4*)(Lv + (c1 >> 3) * 144 + (c1 & 7) * 16) = pf[8]; } while (0)
    SCAN_LOAD(0); SCAN_STORE();
    float gl_next = GL[bh * 64];
    __syncthreads();
    for (int n = 0; n < 64; ++n) {
        const float gl = gl_next;
        if (n + 1 < 64) { SCAN_LOAD(n + 1); gl_next = GL[bh * 64 + n + 1]; }
        const size_t tok = (size_t)b * SEQL + n * 64 + fl;
        const u32x4 z0 = *(const u32x4*)(P + tok * PJ + C_Z + h * 128 + fpart * 16), z1 = *(const u32x4*)(P + tok * PJ + C_Z + h * 128 + fpart * 16 + 8);
        bf16x8 Sp[4];
#pragma unroll
        for (int kb = 0; kb < 4; ++kb) Sp[kb] = pack8(S[2 * kb], S[2 * kb + 1]);
        u32x2 vr[4];
#pragma unroll
        for (int t = 0; t < 4; ++t) vr[t] = *(const LAS u32x2*)(Lv + (16 * wave + c15) * 144 + (16 * t + 4 * q4) * 2);
        f32x4 pa[4], oo[4];
#pragma unroll
        for (int t = 0; t < 4; ++t) { pa[t] = (f32x4){0.f, 0.f, 0.f, 0.f}; oo[t] = (f32x4){0.f, 0.f, 0.f, 0.f}; }
#pragma unroll
        for (int hh = 0; hh < 2; ++hh) {
            bf16x8 fk[2][4], fq[2][4];
#pragma unroll
            for (int tt = 0; tt < 2; ++tt)
#pragma unroll
                for (int kb = 0; kb < 4; ++kb) { fk[tt][kb] = *(const LAS bf16x8*)(Lk + (16 * (2 * hh + tt) + c15) * 272 + (32 * kb + 8 * q4) * 2); fq[tt][kb] = *(const LAS bf16x8*)(Lq + (16 * (2 * hh + tt) + c15) * 272 + (32 * kb + 8 * q4) * 2); }
            __builtin_amdgcn_sched_barrier(0);
#pragma unroll
            for (int kb = 0; kb < 4; ++kb)
#pragma unroll
                for (int tt = 0; tt < 2; ++tt) { pa[2 * hh + tt] = __builtin_amdgcn_mfma_f32_16x16x32_bf16(fk[tt][kb], Sp[kb], pa[2 * hh + tt], 0, 0, 0); oo[2 * hh + tt] = __builtin_amdgcn_mfma_f32_16x16x32_bf16(fq[tt][kb], Sp[kb], oo[2 * hh + tt], 0, 0, 0); }
            __builtin_amdgcn_sched_barrier(0);
        }
        f32x4 Vn[4];
#pragma unroll
        for (int t = 0; t < 4; ++t) Vn[t] = (f32x4){bflo(vr[t].x), bfhi(vr[t].x), bflo(vr[t].y), bfhi(vr[t].y)} - pa[t];
        bf16x8 Vp[2];
        Vp[0] = pack8(Vn[0], Vn[1]); Vp[1] = pack8(Vn[2], Vn[3]);
        {
            bf16x8 fi[4][2], ft[4][2];
#pragma unroll
            for (int t = 0; t < 4; ++t)
#pragma unroll
                for (int kb = 0; kb < 2; ++kb) { fi[t][kb] = *(const LAS bf16x8*)(Li + (16 * t + c15) * 144 + (32 * kb + 8 * q4) * 2); ft[t][kb] = *(const LAS bf16x8*)(Lt + (16 * t + c15) * 144 + (32 * kb + 8 * q4) * 2); }
            __builtin_amdgcn_sched_barrier(0);
#pragma unroll
            for (int T = 0; T < 4; ++T) S[T] = S[T] * gl;
#pragma unroll
            for (int kb = 0; kb < 2; ++kb)
#pragma unroll
                for (int t = 0; t < 4; ++t) { oo[t] = __builtin_amdgcn_mfma_f32_16x16x32_bf16(fi[t][kb], Vp[kb], oo[t], 0, 0, 0); S[t] = __builtin_amdgcn_mfma_f32_16x16x32_bf16(ft[t][kb], Vp[kb], S[t], 0, 0, 0); }
            __builtin_amdgcn_sched_barrier(0);
        }
        {
            bf16x8 ft[4][2];
#pragma unroll
            for (int t = 0; t < 4; ++t)
#pragma unroll
                for (int kb = 0; kb < 2; ++kb) ft[t][kb] = *(const LAS bf16x8*)(Lt + (16 * (4 + t) + c15) * 144 + (32 * kb + 8 * q4) * 2);
#pragma unroll
            for (int t = 0; t < 4; ++t)
#pragma unroll
                for (int r = 0; r < 4; ++r) Lo[(16 * t + 4 * q4 + r) * 132 + 16 * wave + c15] = oo[t][r];
            __builtin_amdgcn_sched_barrier(0);
#pragma unroll
            for (int T = 4; T < 8; ++T) S[T] = S[T] * gl;
#pragma unroll
            for (int kb = 0; kb < 2; ++kb)
#pragma unroll
                for (int t = 0; t < 4; ++t) S[4 + t] = __builtin_amdgcn_mfma_f32_16x16x32_bf16(ft[t][kb], Vp[kb], S[4 + t], 0, 0, 0);
            __builtin_amdgcn_sched_barrier(0);
        }
        LBAR();
        {
            u32x4 zp0 = z0, zp1 = z1; asm volatile("" : "+v"(zp0), "+v"(zp1));
            f32x4 ov[4]; float ss = 0.f;
#pragma unroll
            for (int k = 0; k < 4; ++k) { ov[k] = *(const LAS f32x4*)(Lo + fl * 132 + fpart * 16 + 4 * k); ss += (ov[k][0] * ov[k][0] + ov[k][1] * ov[k][1]) + (ov[k][2] * ov[k][2] + ov[k][3] * ov[k][3]); }
            ss += __shfl_xor(ss, 1); ss += __shfl_xor(ss, 2); ss += __shfl_xor(ss, 4);
            const float rstd = 1.0f / sqrtf(ss * (1.0f / 128.f) + EPSF);
            float zz[16] = {bflo(zp0.x), bfhi(zp0.x), bflo(zp0.y), bfhi(zp0.y), bflo(zp0.z), bfhi(zp0.z), bflo(zp0.w), bfhi(zp0.w), bflo(zp1.x), bfhi(zp1.x), bflo(zp1.y), bfhi(zp1.y), bflo(zp1.z), bfhi(zp1.z), bflo(zp1.w), bfhi(zp1.w)};
            float res[16];
#pragma unroll
            for (int k = 0; k < 4; ++k) { const f32x4 gq = *(const LAS f32x4*)(Lg + fpart * 16 + 4 * k);
#pragma unroll
                for (int e = 0; e < 4; ++e) { const float z = zz[4 * k + e]; res[4 * k + e] = ov[k][e] * rstd * gq[e] * (z * __builtin_amdgcn_rcpf(1.0f + __expf(-z))); } }
            u32x4 w0, w1; w0.x = pk2(res[0], res[1]); w0.y = pk2(res[2], res[3]); w0.z = pk2(res[4], res[5]); w0.w = pk2(res[6], res[7]);
            w1.x = pk2(res[8], res[9]); w1.y = pk2(res[10], res[11]); w1.z = pk2(res[12], res[13]); w1.w = pk2(res[14], res[15]);
            *(u32x4*)(MIX + tok * DM + 1024 + h * 128 + fpart * 16) = w0; *(u32x4*)(MIX + tok * DM + 1024 + h * 128 + fpart * 16 + 8) = w1;
        }
        if (n + 1 < 64) SCAN_STORE();
        LBAR();
    }
#undef SCAN_LOAD
#undef SCAN_STORE
}

__device__ __forceinline__ void sgu_item(LAS unsigned char* L, int item, const bf16_t* P, const float* sgw, const float* sgb, const float* lng, const float* lnb, const float* ona, bf16_t* MIX, int tid) {
    const int h = item & 3, n = (item >> 2) & 31, b = item >> 7;
    const size_t tok0 = (size_t)b * SEQL + n * 128;
    const int wave = tid >> 6, lane = tid & 63, q4 = lane >> 4, c15 = lane & 15;
    LAS bf16_t* Wl = (LAS bf16_t*)L;
    LAS bf16_t* Vt = (LAS bf16_t*)(L + 34816);
    {
        const int t = tid >> 2, s0 = (tid & 3) * 32; const float* wr = sgw + (size_t)h * 16384 + t * 128 + s0;
#pragma unroll
        for (int k = 0; k < 4; ++k) { const f32x4 a = *(const f32x4*)(wr + 8 * k), c = *(const f32x4*)(wr + 8 * k + 4); float v[8] = {a[0], a[1], a[2], a[3], c[0], c[1], c[2], c[3]};
#pragma unroll
            for (int e = 0; e < 8; ++e) v[e] = (s0 + 8 * k + e <= t) ? v[e] : 0.f;
            u32x4 o; o.x = pk2(v[0], v[1]); o.y = pk2(v[2], v[3]); o.z = pk2(v[4], v[5]); o.w = pk2(v[6], v[7]);
            *(LAS u32x4*)(Wl + t * 136 + s0 + 8 * k) = o; }
    }
    {
        const int s = tid >> 2, d0 = (tid & 3) * 32; const bf16_t* vr = P + (tok0 + s) * PJ + C_V + h * 128 + d0;
        float v[32]; float sm = 0.f;
#pragma unroll
        for (int k = 0; k < 4; ++k) { const u32x4 w = *(const u32x4*)(vr + 8 * k); v[8 * k] = bflo(w.x); v[8 * k + 1] = bfhi(w.x); v[8 * k + 2] = bflo(w.y); v[8 * k + 3] = bfhi(w.y); v[8 * k + 4] = bflo(w.z); v[8 * k + 5] = bfhi(w.z); v[8 * k + 6] = bflo(w.w); v[8 * k + 7] = bfhi(w.w); }
#pragma unroll
        for (int e = 0; e < 32; ++e) sm += v[e];
        sm += __shfl_xor(sm, 1); sm += __shfl_xor(sm, 2);
        const float mu = sm * (1.0f / 128.f); float sq = 0.f;
#pragma unroll
        for (int e = 0; e < 32; ++e) { v[e] -= mu; sq += v[e] * v[e]; }
        sq += __shfl_xor(sq, 1); sq += __shfl_xor(sq, 2);
        const float rstd = 1.0f / sqrtf(sq * (1.0f / 128.f) + EPSF);
#pragma unroll
        for (int e = 0; e < 32; ++e) { const float y = v[e] * rstd * lng[h * 128 + d0 + e] + lnb[h * 128 + d0 + e]; Vt[(d0 + e) * 136 + s] = (bf16_t)(pk2(y, 0.f) & 0xffffu); }
    }
    __syncthreads();
    {
        f32x4 D[8];
#pragma unroll
        for (int tj = 0; tj < 8; ++tj) D[tj] = (f32x4){0.f, 0.f, 0.f, 0.f};
        const int nkb = (wave >> 1) + 1;
        for (int kb = 0; kb < nkb; ++kb) {
            const bf16x8 a = *(const LAS bf16x8*)(Wl + (16 * wave + c15) * 136 + 32 * kb + 8 * q4);
#pragma unroll
            for (int tj = 0; tj < 8; ++tj) { const bf16x8 bv = *(const LAS bf16x8*)(Vt + (16 * tj + c15) * 136 + 32 * kb + 8 * q4); D[tj] = __builtin_amdgcn_mfma_f32_16x16x32_bf16(a, bv, D[tj], 0, 0, 0); }
        }
        float ss[4] = {0.f, 0.f, 0.f, 0.f};
#pragma unroll
        for (int r = 0; r < 4; ++r) { const int t = 16 * wave + 4 * q4 + r; const float bias = sgb[h * 128 + t]; const bf16_t* ur = P + (tok0 + t) * PJ + C_U + h * 128 + c15;
#pragma unroll
            for (int tj = 0; tj < 8; ++tj) { const float uu = bf2f(ur[16 * tj]); const float y = uu * (D[tj][r] + bias); D[tj][r] = y; ss[r] += y * y; } }
#pragma unroll
        for (int r = 0; r < 4; ++r) { float s = ss[r]; s += __shfl_xor(s, 1); s += __shfl_xor(s, 2); s += __shfl_xor(s, 4); s += __shfl_xor(s, 8); ss[r] = 1.0f / sqrtf(s * (1.0f / 128.f) + EPSF); }
#pragma unroll
        for (int r = 0; r < 4; ++r) { const int t = 16 * wave + 4 * q4 + r; bf16_t* orow = MIX + (tok0 + t) * DM + h * 128 + c15;
#pragma unroll
            for (int tj = 0; tj < 8; ++tj) orow[16 * tj] = (bf16_t)(pk2(D[tj][r] * ss[r] * ona[h * 128 + 16 * tj + c15], 0.f) & 0xffffu); }
    }
    __syncthreads();
}

__device__ __forceinline__ void unpack8(const u32x4 w, float (&v)[8]) { v[0] = bflo(w.x); v[1] = bfhi(w.x); v[2] = bflo(w.y); v[3] = bfhi(w.y); v[4] = bflo(w.z); v[5] = bfhi(w.z); v[6] = bflo(w.w); v[7] = bfhi(w.w); }
__device__ __forceinline__ void shortconv_token(int tok, const bf16_t* P, const float* scw, const float* onb, bf16_t* MIX, int lane) {
    const int c = lane * 8, pos = tok & (SEQL - 1);
    const bf16_t* row = P + (size_t)tok * PJ;
    float gb[8], acc[8];
    unpack8(*(const u32x4*)(row + C_GB + c), gb);
#pragma unroll
    for (int e = 0; e < 8; ++e) acc[e] = 0.f;
#pragma unroll
    for (int j = 0; j < 3; ++j) {
        const int back = 2 - j;
        if (pos - back >= 0) { float g[8], xi[8]; const bf16_t* r2 = row - (size_t)back * PJ;
            unpack8(*(const u32x4*)(r2 + C_GC + c), g); unpack8(*(const u32x4*)(r2 + C_XI + c), xi);
            const f32x4 w0 = *(const f32x4*)(scw + j * 512 + c), w1 = *(const f32x4*)(scw + j * 512 + c + 4);
#pragma unroll
            for (int e = 0; e < 4; ++e) { acc[e] += w0[e] * (g[e] * xi[e]); acc[4 + e] += w1[e] * (g[4 + e] * xi[4 + e]); } }
    }
    float ss = 0.f;
#pragma unroll
    for (int e = 0; e < 8; ++e) { acc[e] *= gb[e]; ss += acc[e] * acc[e]; }
    ss += __shfl_xor(ss, 1); ss += __shfl_xor(ss, 2); ss += __shfl_xor(ss, 4); ss += __shfl_xor(ss, 8);
    const float rstd = 1.0f / sqrtf(ss * (1.0f / 128.f) + EPSF);
    const f32x4 g0 = *(const f32x4*)(onb + c), g1 = *(const f32x4*)(onb + c + 4);
    u32x4 o; o.x = pk2(acc[0] * rstd * g0[0], acc[1] * rstd * g0[1]); o.y = pk2(acc[2] * rstd * g0[2], acc[3] * rstd * g0[3]);
    o.z = pk2(acc[4] * rstd * g1[0], acc[5] * rstd * g1[1]); o.w = pk2(acc[6] * rstd * g1[2], acc[7] * rstd * g1[3]);
    *(u32x4*)(MIX + (size_t)tok * DM + 512 + c) = o;
}


#define XB_TMO      128
#define XB_XCNT(j)  (256  + 64 * (j))
#define XB_XSUB(j)  (1280 + 64 * (j))
#define XB_XGEN(j)  (2304 + 64 * (j))
#define XB_TOP      3328
#define XB_TOPGEN   3392
#define XCD_BAR_WORDS 3456
#define XB_SPIN_CAP (1u << 22)
__device__ __forceinline__ unsigned xb_ld(unsigned* p)              { return __hip_atomic_load(p, __ATOMIC_RELAXED, __HIP_MEMORY_SCOPE_AGENT); }
__device__ __forceinline__ unsigned xb_add(unsigned* p, unsigned v) { return __hip_atomic_fetch_add(p, v, __ATOMIC_RELAXED, __HIP_MEMORY_SCOPE_AGENT); }
__device__ __forceinline__ unsigned xb_xcc_id() { return (unsigned)__builtin_amdgcn_s_getreg((3 << 11) | 20) & 0xFu; }
#define XB_SPIN(cond, bar) do { unsigned _sp = 0; while (cond) { __builtin_amdgcn_s_sleep(1); \
    if ((++_sp & 255u) == 0u) { if (xb_ld(&(bar)[XB_TMO])) break; if (_sp > XB_SPIN_CAP) { atomicAdd(&(bar)[XB_TMO], 1u); break; } } } } while (0)
struct XcdBarrier { unsigned* bar; unsigned x; volatile LAS unsigned* st; };
__device__ __forceinline__ XcdBarrier xcd_barrier_post(unsigned* bar, volatile LAS unsigned* st, int tid) {
    XcdBarrier b; b.bar = bar; b.x = xb_xcc_id(); b.st = st;
    if (tid == 0) (void)xb_add(&bar[XB_XCNT(b.x)], 1u);
    return b;
}
__device__ __forceinline__ void xcd_barrier_complete(unsigned* bar, unsigned x, unsigned& nloc, unsigned& nx) {
    const unsigned G = gridDim.x * gridDim.y * gridDim.z;
    unsigned sum, cnt, mine, sp = 0u;
    for (;;) {
        sum = 0u; cnt = 0u; mine = 0u;
#pragma unroll
        for (unsigned j = 0; j < 16; ++j) { const unsigned c = xb_ld(&bar[XB_XCNT(j)]); sum += c; cnt += (c > 0u) ? 1u : 0u; mine = (j == x) ? c : mine; }
        if (sum == G) break;
        __builtin_amdgcn_s_sleep(1);
        if ((++sp & 255u) == 0u) { if (xb_ld(&bar[XB_TMO])) break; if (sp > XB_SPIN_CAP) { atomicAdd(&bar[XB_TMO], 1u); break; } }
    }
    nloc = mine > 0u ? mine : 1u; nx = cnt > 0u ? cnt : 1u;
}
__device__ __forceinline__ void xcd_barrier(const XcdBarrier& b, int tid) {
    asm volatile("s_waitcnt vmcnt(0)" ::: "memory");
    __syncthreads();
    if (tid == 0) {
        unsigned* bar = b.bar;
        __builtin_amdgcn_s_waitcnt(0);
        unsigned nloc = b.st[0], nx = b.st[1];
        if (nloc == 0u) { xcd_barrier_complete(bar, b.x, nloc, nx); b.st[0] = nloc; b.st[1] = nx; }
        const unsigned old = xb_add(&bar[XB_XSUB(b.x)], 1u);
        const unsigned gen = old / nloc;
        if (old + 1u == (gen + 1u) * nloc) {
            __builtin_amdgcn_fence(__ATOMIC_RELEASE, "agent");
            asm volatile("s_waitcnt vmcnt(0)" ::: "memory");
            const unsigned og = xb_add(&bar[XB_TOP], 1u);
            const unsigned tg = og / nx;
            if (og + 1u == (tg + 1u) * nx) xb_add(&bar[XB_TOPGEN], 1u);
            else XB_SPIN(xb_ld(&bar[XB_TOPGEN]) == tg, bar);
            __builtin_amdgcn_fence(__ATOMIC_ACQUIRE, "agent");
            xb_add(&bar[XB_XGEN(b.x)], 1u);
            asm volatile("s_waitcnt vmcnt(0)" ::: "memory");
        } else {
            XB_SPIN(xb_ld(&bar[XB_XGEN(b.x)]) == gen, bar);
            __builtin_amdgcn_fence(__ATOMIC_ACQUIRE, "agent");
            asm volatile("s_waitcnt vmcnt(0)" ::: "memory");
        }
    }
    __syncthreads();
}
constexpr size_t WS_BAR = 1048576 + 65536;
constexpr int LDS_MISC = 131072 + 320;

typedef const char __attribute__((address_space(4))) kchar_t;
#define KARG(field) (*(decltype(Args::field) const __attribute__((address_space(4)))*)(kp + offsetof(Args, field)))
#define MYTID() (wave0 * 64 + (int)__builtin_amdgcn_mbcnt_hi(~0u, __builtin_amdgcn_mbcnt_lo(~0u, 0u)))
#define PHASE_BEGIN int tid = MYTID(); asm volatile("" : "+v"(tid)); const int lane = tid & 63, wave = __builtin_amdgcn_readfirstlane(tid >> 6); \
    const int G = gridDim.x, bx = blockIdx.x, gw = bx * NWAVES + wave, NGW = G * NWAVES; (void)lane; (void)gw; (void)NGW; \
    kchar_t* kp = (kchar_t*)__builtin_amdgcn_kernarg_segment_ptr(); asm volatile("" : "+s"(kp)); \
    unsigned char* ws = KARG(ws); (void)ws; int l = lsel; asm volatile("" : "+s"(l));
#define WSP(T, off) ((T*)(ws + (off)))
__global__ void __launch_bounds__(NTHREADS, 2) hybrid_fwd(Args a) {
    extern __shared__ __attribute__((aligned(16))) unsigned char lds_raw[];
    LAS unsigned char* L = (LAS unsigned char*)lds_raw;
    const int lo = a.ph_lo, hi = a.ph_hi, coop = a.coop;
    const int wave0 = __builtin_amdgcn_readfirstlane(threadIdx.x >> 6);
    { const int t0 = MYTID(); if (t0 < 8) ((LAS unsigned*)(L + LDS_MISC))[t0] = 0u; }
    __syncthreads();
    XcdBarrier xbar; xbar.bar = (unsigned*)(a.ws + WS_BAR); xbar.x = 0; xbar.st = nullptr;
    if (coop) xbar = xcd_barrier_post((unsigned*)(a.ws + WS_BAR), (volatile LAS unsigned*)(L + LDS_MISC), MYTID());
    bool first_seam = true;
#ifndef PH_MASK
#define PH_MASK 0xFFFFu
#endif
#define IN(k) (((PH_MASK >> ((k) >= 20 ? 10 : (k) % 10)) & 1u) && lo <= (k) && (k) < hi)
#ifndef PROBE_DUP
#define PROBE_DUP 0u
#endif
#define NREP(k) (1 + (int)((PROBE_DUP >> (k)) & 1u))
#ifndef PROBE_SYNC
#define PROBE_SYNC 1
#endif
#define SEAM() do { if (coop) { for (int s_ = 0; s_ < PROBE_SYNC; ++s_) { if (first_seam) { cg::this_grid().sync(); first_seam = false; } else xcd_barrier(xbar, MYTID()); } } else __syncthreads(); } while (0)

#pragma unroll 1
    for (int lsel = 0; lsel < 2; ++lsel) {
        const int pb = lsel * 10;
        if (IN(pb + 0)) for (int rep_ = 0; rep_ < NREP(0); ++rep_) { if (rep_) __syncthreads();
            PHASE_BEGIN
            LAS float* scr = (LAS float*)(L + wave * 16384);
            constexpr int I_IN = 32 * (INP / 32), I_O = 32 * 64, I_1 = 32 * 256, I_2 = 128 * 64, I_G = 32 * 64, I_P = 4 * 64;
            constexpr int NITEMS = I_IN + I_O + I_1 + I_2 + I_G + I_P;
            for (int it = gw; it < NITEMS; it += NGW) {
                int r = it;
                if (r < I_IN) { transpose_item(KARG(w_in) + (size_t)l * DM * INC, DM, INC, INP, WSP(bf16_t, WS_WIN), scr, r, lane); continue; } r -= I_IN;
                if (r < I_O) { transpose_item(KARG(w_o) + (size_t)l * DM * DM, DM, DM, DM, WSP(bf16_t, WS_WO), scr, r, lane); continue; } r -= I_O;
                if (r < I_1) { transpose_item(KARG(w_ff1) + (size_t)l * DM * FFD, DM, FFD, FFD, WSP(bf16_t, WS_W1), scr, r, lane); continue; } r -= I_1;
                if (r < I_2) { transpose_item(KARG(w_ff2) + (size_t)l * DM * FFD, FFD, DM, DM, WSP(bf16_t, WS_W2), scr, r, lane); continue; } r -= I_2;
                if (r < I_G) { transpose_item(KARG(w_ple_gate) + (size_t)l * DM * DM, DM, DM, DM, WSP(bf16_t, WS_WG), scr, r, lane); continue; } r -= I_G;
                transpose_item(KARG(w_ple_proj) + (size_t)l * PLE * DM, PLE, DM, DM, WSP(bf16_t, WS_WP), scr, r, lane);
            }
            {
                const f32x4* src = (const f32x4*)(KARG(p) + (size_t)l * TOK * PLE); u32x2* dst = WSP(u32x2, WS_P16);
                for (int i = bx * NTHREADS + tid; i < TOK * PLE / 4; i += G * NTHREADS) { const f32x4 v = src[i]; u32x2 w; w.x = pk2(v[0], v[1]); w.y = pk2(v[2], v[3]); dst[i] = w; }
            }
            const float* hsrc = (l == 0) ? KARG(x) : (const float*)KARG(out);
            for (int m = gw; m < TOK; m += NGW) rms_row_bf16(hsrc + (size_t)m * DM, KARG(norm_mix) + l * DM, WSP(bf16_t, WS_XN) + (size_t)m * DM, lane);
        }
        if (IN(pb + 0) && IN(pb + 1)) SEAM();
        if (IN(pb + 1)) for (int rep_ = 0; rep_ < NREP(1); ++rep_) { if (rep_) __syncthreads();
            PHASE_BEGIN
            pg8::Gemm g{WSP(bf16_t, WS_XN), WSP(bf16_t, WS_WIN), TOK, INP, DM}; pg8::StaticOrder S; S.init(TOK, INP, G, bx);
            EpiProj E{WSP(bf16_t, WS_BIG), WSP(float, WS_AB)};
            pg8::gemm_phase<EpiProj>(L, g, S, E, tid);
        }
        if (IN(pb + 1) && IN(pb + 2)) SEAM();
        if (IN(pb + 2)) for (int rep_ = 0; rep_ < NREP(2); ++rep_) { if (rep_) __syncthreads();
            PHASE_BEGIN
            for (int it = bx; it < 2048; it += G)
                gdn_chunk_item(L, it, WSP(bf16_t, WS_BIG), WSP(float, WS_AB), KARG(gdn_conv) + (size_t)l * 4 * 3072, KARG(gdn_a_log) + l * 8, KARG(gdn_dt_bias) + l * 8, ws + WS_GDN, WSP(float, WS_GL), tid);
        }
        if (IN(pb + 2) && IN(pb + 3)) SEAM();
        if (IN(pb + 3)) for (int rep_ = 0; rep_ < NREP(3); ++rep_) { if (rep_) __syncthreads();
            PHASE_BEGIN
            const int nscan = (G > 32) ? 32 : 0;
            if (bx < nscan) {
                gdn_scan(L, bx, ws + WS_GDN, WSP(float, WS_GL), WSP(bf16_t, WS_BIG), KARG(gdn_norm) + l * 128, WSP(bf16_t, WS_XN), tid);
            } else {
                if (nscan == 0) { for (int bh = bx; bh < 32; bh += G) gdn_scan(L, bh, ws + WS_GDN, WSP(float, WS_GL), WSP(bf16_t, WS_BIG), KARG(gdn_norm) + l * 128, WSP(bf16_t, WS_XN), tid); }
                const int rb = bx - nscan, RG = G - nscan;
                for (int it = rb; it < 512; it += RG)
                    sgu_item(L, it, WSP(bf16_t, WS_BIG), KARG(sg_w) + (size_t)l * 4 * 16384, KARG(sg_b) + l * 512, KARG(sg_ln_g) + l * 512, KARG(sg_ln_b) + l * 512, KARG(out_norm_a) + l * 512, WSP(bf16_t, WS_XN), tid);
                for (int tk = rb * NWAVES + wave; tk < TOK; tk += RG * NWAVES)
                    shortconv_token(tk, WSP(bf16_t, WS_BIG), KARG(sc_conv) + l * 3 * 512, KARG(out_norm_b) + l * 512, WSP(bf16_t, WS_XN), lane);
            }
        }
        if (IN(pb + 3) && IN(pb + 4)) SEAM();
        if (IN(pb + 4)) for (int rep_ = 0; rep_ < NREP(4); ++rep_) { if (rep_) __syncthreads();
            PHASE_BEGIN
            pg8::Gemm g{WSP(bf16_t, WS_XN), WSP(bf16_t, WS_WO), TOK, DM, DM}; pg8::StaticOrder S; S.init(TOK, DM, G, bx);
            const float* hsrc = (l == 0) ? KARG(x) : (const float*)KARG(out);
            EpiRes E{hsrc, KARG(out)};
            pg8::gemm_phase<EpiRes>(L, g, S, E, tid);
        }
        if (IN(pb + 4) && IN(pb + 5)) SEAM();
        if (IN(pb + 5)) for (int rep_ = 0; rep_ < NREP(5); ++rep_) { if (rep_) __syncthreads();
            PHASE_BEGIN
            for (int m = gw; m < TOK; m += NGW) rms_row_bf16(KARG(out) + (size_t)m * DM, KARG(norm_ffn) + l * DM, WSP(bf16_t, WS_XN) + (size_t)m * DM, lane);
        }
        if (IN(pb + 5) && IN(pb + 6)) SEAM();
        if (IN(pb + 6)) for (int rep_ = 0; rep_ < NREP(6); ++rep_) { if (rep_) __syncthreads();
            PHASE_BEGIN
            pg8::Gemm g{WSP(bf16_t, WS_XN), WSP(bf16_t, WS_W1), TOK, FFD, DM}; pg8::StaticOrder S; S.init(TOK, FFD, G, bx);
            EpiRelu2 E{WSP(bf16_t, WS_BIG)};
            pg8::gemm_phase<EpiRelu2>(L, g, S, E, tid);
        }
        if (IN(pb + 6) && IN(pb + 7)) SEAM();
        if (IN(pb + 7)) for (int rep_ = 0; rep_ < NREP(7); ++rep_) { if (rep_) __syncthreads();
            PHASE_BEGIN
            pg8::Gemm g{WSP(bf16_t, WS_BIG), WSP(bf16_t, WS_W2), TOK, DM, FFD}; pg8::StaticOrder S; S.init(TOK, DM, G, bx);
            EpiRes E{KARG(out), KARG(out)};
            pg8::gemm_phase<EpiRes>(L, g, S, E, tid);
        }
        if (IN(pb + 7) && IN(pb + 8)) SEAM();
        if (IN(pb + 8)) for (int rep_ = 0; rep_ < NREP(8); ++rep_) {
            PHASE_BEGIN
            for (int m = gw; m < TOK; m += NGW) rms_row_bf16(KARG(out) + (size_t)m * DM, KARG(norm_ple) + l * DM, WSP(bf16_t, WS_XN) + (size_t)m * DM, lane);
        }
        if (IN(pb + 8)) for (int rep_ = 0; rep_ < NREP(10); ++rep_) {
            __syncthreads();
            PHASE_BEGIN
            pg8::Gemm g{WSP(bf16_t, WS_P16), WSP(bf16_t, WS_WP), TOK, DM, PLE}; pg8::StaticOrder S; S.init(TOK, DM, G, bx);
            EpiPlain E{WSP(bf16_t, WS_BIG)};
            pg8::gemm_phase<EpiPlain>(L, g, S, E, tid);
        }
        if (IN(pb + 8) && IN(pb + 9)) SEAM();
        if (IN(pb + 9)) for (int rep_ = 0; rep_ < NREP(9); ++rep_) { if (rep_) __syncthreads();
            PHASE_BEGIN
            pg8::Gemm g{WSP(bf16_t, WS_XN), WSP(bf16_t, WS_WG), TOK, DM, DM}; pg8::StaticOrder S; S.init(TOK, DM, G, bx);
            EpiGate E{WSP(bf16_t, WS_BIG), KARG(out)};
            pg8::gemm_phase<EpiGate>(L, g, S, E, tid);
        }
        if (IN(pb + 9) && IN(pb + 10)) SEAM();
    }
    if (IN(20)) {
        const int lsel = 0;
        PHASE_BEGIN
        for (int m = gw; m < TOK; m += NGW) rms_row_f32(KARG(out) + (size_t)m * DM, KARG(norm_final), KARG(out) + (size_t)m * DM, lane);
    }
#undef IN
#undef SEAM
}

extern "C" void kernel_launch(void* const* d_in, const int* in_sizes, int n_in, void* d_out, int out_size, void* d_ws, size_t ws_size, hipStream_t stream) {
    static int grid = 0;
    if (grid == 0) {
        if (n_in != 23 || out_size != TOK * DM || ws_size < WS_END) { fprintf(stderr, "kernel_launch: unexpected shapes (n_in %d out %d ws %zu need %zu)\n", n_in, out_size, ws_size, (size_t)WS_END); grid = -1; return; }
        int dev = 0, cus = 0, per_cu = 0;
        hipGetDevice(&dev);
        hipDeviceGetAttribute(&cus, hipDeviceAttributeMultiprocessorCount, dev);
        if (hipFuncSetAttribute((const void*)hybrid_fwd, hipFuncAttributeMaxDynamicSharedMemorySize, LDS_BYTES) != hipSuccess) { fprintf(stderr, "kernel_launch: hipFuncSetAttribute failed\n"); grid = -1; return; }
        if (hipOccupancyMaxActiveBlocksPerMultiprocessor(&per_cu, (const void*)hybrid_fwd, NTHREADS, LDS_BYTES) != hipSuccess || per_cu < 1) { fprintf(stderr, "kernel_launch: occupancy query gave %d\n", per_cu); per_cu = 1; }
        (void)hipGetLastError();
        grid = cus * per_cu;
    }
    if (grid < 0) return;
    Args a{};
    const float** f = (const float**)&a;
    for (int i = 0; i < 23; ++i) f[i] = (const float*)d_in[i];
    a.out = (float*)d_out; a.ws = (unsigned char*)d_ws;
#if MK_COOP
    if (hipMemsetAsync((char*)d_ws + WS_BAR, 0, 16384, stream) != hipSuccess) { fprintf(stderr, "kernel_launch: memset failed\n"); return; }
    a.ph_lo = 0; a.ph_hi = 21; a.coop = 1;
    void* args[] = {&a};
    hipError_t e = hipLaunchCooperativeKernel((const void*)hybrid_fwd, dim3(grid), dim3(NTHREADS), args, LDS_BYTES, stream);
    if (e != hipSuccess) fprintf(stderr, "cooperative launch failed: %s (grid %d)\n", hipGetErrorString(e), grid);
#else
    for (int ph = 0; ph < 21; ++ph) {
        a.ph_lo = ph; a.ph_hi = ph + 1; a.coop = 0;
        hipLaunchKernelGGL(hybrid_fwd, dim3(grid), dim3(NTHREADS), LDS_BYTES, stream, a);
    }
#endif
}
```

```cpp
#include <hip/hip_runtime.h>
#include <hip/hip_cooperative_groups.h>
#include <cstdio>
#include <cstdint>
#include <cstddef>
namespace cg = cooperative_groups;

#ifndef MK_COOP
#define MK_COOP 1
#endif

#define LAS __attribute__((address_space(3)))
typedef unsigned short bf16_t;
typedef short bf16x8 __attribute__((ext_vector_type(8)));
typedef float f32x4 __attribute__((ext_vector_type(4)));
typedef float f32x2 __attribute__((ext_vector_type(2)));
typedef unsigned u32x4 __attribute__((ext_vector_type(4)));
typedef unsigned u32x2 __attribute__((ext_vector_type(2)));

namespace pg8 {
constexpr int BM = 256, BK = 64, HALF = 128, HTB = HALF * BK * 2, STAGE_BYTES = 8 * HTB, NXCD = 8, WGM = 8;
__host__ __device__ __forceinline__ int lds_byte(int r, int c) { const int st = (r >> 4) * 2 + (c >> 5), rr = r & 15, cc = c & 31, ob = rr * 64 + cc * 2; return st * 1024 + (ob ^ (((ob >> 9) & 1) << 5)); }
__host__ __device__ __forceinline__ void stage_rc(int b, int& R, int& C) { const int st = b / 1024, sb = b % 1024, swz = sb ^ (((sb >> 9) & 1) << 5); R = (st >> 1) * 16 + swz / 64; C = (st & 1) * 32 + (swz % 64) / 2; }
__host__ __device__ __forceinline__ int perm32(int rho) { const int n = rho >> 4, i = rho & 15; return 8 * (i >> 2) + 4 * n + (i & 3); }

struct Unit { int pm, pn; };
struct Gemm { const bf16_t* A; const bf16_t* Bt; int M, N, K; };

struct StaticOrder {
    int nM, nN, nwg, G, c;
    __host__ __device__ void init(int M, int N, int G_, int c_) { nM = M / BM; nN = N / BM; nwg = nM * nN; G = G_; c = c_; }
    __host__ __device__ bool next(int i, Unit& u) const {
        const long L = (long)i * G + c; if (L >= nwg) return false;
        int wgid = (int)L; { const int q = nwg / NXCD, r = nwg % NXCD, xcd = wgid % NXCD, off = wgid / NXCD; wgid = (xcd < r ? xcd * (q + 1) : r * (q + 1) + (xcd - r) * q) + off; }
        const int nig = WGM * nN, gid = wgid / nig, fm = gid * WGM, gsz = (nM - fm) < WGM ? (nM - fm) : WGM;
        u.pm = fm + ((wgid % nig) % gsz); u.pn = (wgid % nig) / gsz; return true;
    }
};

__device__ __forceinline__ unsigned cvt_pk_bf16(float lo, float hi) { unsigned r; asm volatile("v_cvt_pk_bf16_f32 %0, %1, %2" : "=v"(r) : "v"(lo), "v"(hi)); return r; }

template <class Epi>
__device__ __forceinline__ void gemm_phase(LAS unsigned char* lds, const Gemm g, const StaticOrder& S, const Epi& E, const int tid) {
    const int wid = __builtin_amdgcn_readfirstlane(tid >> 6), lane = tid & 63, wr = wid >> 2, wc = wid & 3, fr = lane & 15, fq = lane >> 4;
    int K_ = g.K; asm volatile("" : "+s"(K_)); const int K = K_, nt = K / BK;
    unsigned voffA[2], voffB[2];
#pragma unroll
    for (int i = 0; i < 2; ++i) { int R, C; stage_rc(tid * 16 + i * 8192, R, C); const int Rb = (R & ~31) + perm32(R & 31);
        voffA[i] = (unsigned)(R * K + C) * 2u; voffB[i] = (unsigned)(Rb * K + C) * 2u; }
    const size_t kstep = (size_t)(BK * 2);
    const size_t hstep = (size_t)HALF * K * 2;
    const size_t tstep = 2 * hstep;
    const unsigned ldsw = (unsigned)wid * 1024u;
    const int aoff = lds_byte(wr * 64 + fr, fq * 8), boff = lds_byte(wc * 32 + fr, fq * 8);
#define PG8_SA(b, h) (((b) * 2 + (h)) * HTB)
#define PG8_SB(b, h) ((4 + (b) * 2 + (h)) * HTB)
#define PG8_STAGE(bufoff, gbase, voff) do { _Pragma("unroll") for (int _i = 0; _i < 2; ++_i) \
        __builtin_amdgcn_global_load_lds((const unsigned*)((const char*)(gbase) + (voff)[_i]), (LAS unsigned*)(lds + (bufoff) + ldsw + _i * 8192), 16, 0, 0); } while (0)
#define PG8_LDA(dst, b, h) do { _Pragma("unroll") for (int m = 0; m < 4; ++m) _Pragma("unroll") for (int k = 0; k < 2; ++k) dst[m][k] = *(const LAS bf16x8*)(lds + PG8_SA(b, h) + aoff + m * 2048 + k * 1024); } while (0)
#define PG8_LDB(dst, b, h) do { _Pragma("unroll") for (int n = 0; n < 2; ++n) _Pragma("unroll") for (int k = 0; k < 2; ++k) dst[n][k] = *(const LAS bf16x8*)(lds + PG8_SB(b, h) + boff + n * 2048 + k * 1024); } while (0)
#define PG8_MMA(ai, bj, At, Bt) do { __builtin_amdgcn_s_setprio(1); _Pragma("unroll") for (int m = 0; m < 4; ++m) _Pragma("unroll") for (int n = 0; n < 2; ++n) _Pragma("unroll") for (int k = 0; k < 2; ++k) \
        acc[ai][bj][m][n] = __builtin_amdgcn_mfma_f32_16x16x32_bf16(Bt[n][k], At[m][k], acc[ai][bj][m][n], 0, 0, 0); __builtin_amdgcn_s_setprio(0); } while (0)
#define PG8_WAIT_V(n) asm volatile("s_waitcnt vmcnt(" #n ")" ::: "memory")
#define PG8_WAIT_L(n) asm volatile("s_waitcnt lgkmcnt(" #n ")" ::: "memory")
#define PG8_BAR __builtin_amdgcn_s_barrier()
#define PG8_SCHED __builtin_amdgcn_sched_barrier(0)
    Unit cur, nxt; int ui = 0;
    if (!S.next(0, cur)) return;
    f32x4 acc[2][2][4][2];
#pragma unroll
    for (int a = 0; a < 2; ++a)
#pragma unroll
        for (int b = 0; b < 2; ++b)
#pragma unroll
            for (int m = 0; m < 4; ++m)
#pragma unroll
                for (int n = 0; n < 2; ++n) acc[a][b][m][n] = (f32x4){0.f, 0.f, 0.f, 0.f};
    bf16x8 At[4][2], B0[2][2], B1[2][2];
    const char* cA = (const char*)g.A + (size_t)cur.pm * tstep; const char* cB = (const char*)g.Bt + (size_t)cur.pn * tstep;
    PG8_STAGE(PG8_SB(0, 0), cB, voffB); PG8_STAGE(PG8_SB(0, 1), cB + hstep, voffB); PG8_STAGE(PG8_SA(0, 0), cA, voffA); PG8_STAGE(PG8_SA(0, 1), cA + hstep, voffA);
    if (wr == 1) PG8_BAR;
    PG8_WAIT_V(2); PG8_BAR;
    PG8_STAGE(PG8_SB(1, 0), cB + kstep, voffB); PG8_STAGE(PG8_SA(1, 0), cA + kstep, voffA); PG8_STAGE(PG8_SB(1, 1), cB + hstep + kstep, voffB);
    PG8_WAIT_V(6); PG8_BAR;
    for (;;) {
        const bool has_next = S.next(ui + 1, nxt);
        const char* nA = has_next ? (const char*)g.A + (size_t)nxt.pm * tstep : cA; const char* nB = has_next ? (const char*)g.Bt + (size_t)nxt.pn * tstep : cB;
        for (int t = 0; t < nt; t += 2) {
            const bool last = (t == nt - 2);
            const char* a1 = cA + (size_t)(t + 1) * kstep;
            const char* a2 = last ? nA : cA + (size_t)(t + 2) * kstep; const char* b2 = last ? nB : cB + (size_t)(t + 2) * kstep;
            const char* a3 = a2 + kstep; const char* b3 = b2 + kstep;
            PG8_LDB(B0, 0, 0); PG8_LDB(B1, 0, 1); PG8_SCHED; PG8_LDA(At, 0, 0); PG8_STAGE(PG8_SA(1, 1), a1 + hstep, voffA);
            PG8_WAIT_V(8); PG8_WAIT_L(0); PG8_BAR; PG8_MMA(0, 0, At, B0); PG8_MMA(0, 1, At, B1); PG8_BAR; PG8_SCHED;
            PG8_LDA(At, 0, 1); PG8_STAGE(PG8_SB(0, 0), b2, voffB); PG8_STAGE(PG8_SB(0, 1), b2 + hstep, voffB); PG8_STAGE(PG8_SA(0, 0), a2, voffA);
            PG8_WAIT_V(8); PG8_WAIT_L(0); PG8_BAR; PG8_MMA(1, 0, At, B0); PG8_MMA(1, 1, At, B1); PG8_BAR; PG8_SCHED;
            PG8_LDB(B0, 1, 0); PG8_LDB(B1, 1, 1); PG8_SCHED; PG8_LDA(At, 1, 0); PG8_STAGE(PG8_SA(0, 1), a2 + hstep, voffA);
            PG8_WAIT_V(8); PG8_WAIT_L(0); PG8_BAR; PG8_MMA(0, 0, At, B0); PG8_MMA(0, 1, At, B1); PG8_BAR; PG8_SCHED;
            PG8_LDA(At, 1, 1); PG8_STAGE(PG8_SB(1, 0), b3, voffB); PG8_STAGE(PG8_SB(1, 1), b3 + hstep, voffB); PG8_STAGE(PG8_SA(1, 0), a3, voffA);
            PG8_WAIT_V(8); PG8_WAIT_L(0); PG8_BAR; PG8_MMA(1, 0, At, B0); PG8_MMA(1, 1, At, B1); PG8_BAR; PG8_SCHED;
        }
        if (wr == 0) PG8_BAR;
        E(acc, cur, wr, wc, fr, fq);
        if (!has_next) break;
#pragma unroll
        for (int a = 0; a < 2; ++a)
#pragma unroll
            for (int b = 0; b < 2; ++b)
#pragma unroll
                for (int m = 0; m < 4; ++m)
#pragma unroll
                    for (int n = 0; n < 2; ++n) acc[a][b][m][n] = (f32x4){0.f, 0.f, 0.f, 0.f};
        cur = nxt; cA = nA; cB = nB; ++ui;
        if (wr == 1) PG8_BAR;
    }
    PG8_WAIT_V(0);
    PG8_BAR;
#undef PG8_SA
#undef PG8_SB
#undef PG8_STAGE
#undef PG8_LDA
#undef PG8_LDB
#undef PG8_MMA
#undef PG8_WAIT_V
#undef PG8_WAIT_L
#undef PG8_BAR
#undef PG8_SCHED
}
}

constexpr int TOK = 16384, DM = 2048, SEQL = 4096, FFD = 8192, PLE = 256;
constexpr int INC = 6672, INP = 6912, PJ = 6656;
constexpr int C_U = 0, C_V = 512, C_GB = 1024, C_GC = 1536, C_XI = 2048, C_Q = 2560, C_Z = 5632;
constexpr float EPSF = 1e-6f;
constexpr int NTHREADS = 512, NWAVES = 8;
constexpr int LDS_BYTES = 147456;

constexpr size_t WS_AB = 0;
constexpr size_t WS_GL = 1048576;
constexpr size_t WS_WIN = 2097152;
constexpr size_t WS_WO = WS_WIN + (size_t)INP * DM * 2;
constexpr size_t WS_W1 = WS_WO + (size_t)DM * DM * 2;
constexpr size_t WS_W2 = WS_W1 + (size_t)FFD * DM * 2;
constexpr size_t WS_WG = WS_W2 + (size_t)FFD * DM * 2;
constexpr size_t WS_WP = WS_WG + (size_t)DM * DM * 2;
constexpr size_t WS_P16 = WS_WP + (size_t)DM * PLE * 2;
constexpr size_t WS_XN = WS_P16 + (size_t)TOK * PLE * 2;
constexpr size_t WS_BIG = WS_XN + (size_t)TOK * DM * 2;
constexpr size_t WS_GDN = WS_BIG + (size_t)TOK * FFD * 2;
constexpr size_t GDN_ITEM = 73728;
constexpr size_t WS_END = WS_GDN + 2048 * GDN_ITEM;

struct Args {
    const float *x, *p, *norm_mix, *w_in, *sg_ln_g, *sg_ln_b, *sg_w, *sg_b, *sc_conv, *gdn_conv, *gdn_a_log, *gdn_dt_bias, *gdn_norm,
        *out_norm_a, *out_norm_b, *w_o, *norm_ffn, *w_ff1, *w_ff2, *norm_ple, *w_ple_gate, *w_ple_proj, *norm_final;
    float* out; unsigned char* ws; int ph_lo, ph_hi, coop, pad;
};

__device__ __forceinline__ unsigned pk2(float lo, float hi) { return pg8::cvt_pk_bf16(lo, hi); }
__device__ __forceinline__ float bf2f(unsigned short v) { return __uint_as_float((unsigned)v << 16); }
__device__ __forceinline__ float bflo(unsigned w) { return __uint_as_float(w << 16); }
__device__ __forceinline__ float bfhi(unsigned w) { return __uint_as_float(w & 0xffff0000u); }
__device__ __forceinline__ float wave_sum(float v) {
#pragma unroll
    for (int o = 1; o < 64; o <<= 1) v += __shfl_xor(v, o);
    return v;
}
__device__ __forceinline__ float sigmoidf_(float x) { return 1.0f / (1.0f + __expf(-x)); }
__device__ __forceinline__ float gelu_tanh(float x) { const float y = 1.5957691216057308f * x * (1.0f + 0.044715f * x * x); return x / (1.0f + __expf(-y)); }
__device__ __forceinline__ bf16x8 pack8(const f32x4 a, const f32x4 b) {
    u32x4 w; w.x = pk2(a[0], a[1]); w.y = pk2(a[2], a[3]); w.z = pk2(b[0], b[1]); w.w = pk2(b[2], b[3]);
    return __builtin_bit_cast(bf16x8, w);
}
__device__ __forceinline__ void unpack8(const u32x4 w, float (&v)[8]) { v[0] = bflo(w.x); v[1] = bfhi(w.x); v[2] = bflo(w.y); v[3] = bfhi(w.y); v[4] = bflo(w.z); v[5] = bfhi(w.z); v[6] = bflo(w.w); v[7] = bfhi(w.w); }
__host__ __device__ __forceinline__ int kperm(int d) { return (d & ~31) + 8 * ((d >> 2) & 3) + 4 * ((d >> 4) & 1) + (d & 3); }
#define LDS_WAIT() asm volatile("s_waitcnt lgkmcnt(0)" ::: "memory")
#define LBAR() do { asm volatile("s_waitcnt lgkmcnt(0)" ::: "memory"); __builtin_amdgcn_s_barrier(); asm volatile("" ::: "memory"); } while (0)

#define EPI_LOOP_BEGIN  _Pragma("unroll") for (int ai = 0; ai < 2; ++ai) _Pragma("unroll") for (int m = 0; m < 4; ++m) { const int row = u.pm * 256 + ai * 128 + wr * 64 + m * 16 + fr; \
                        _Pragma("unroll") for (int bj = 0; bj < 2; ++bj) { const int col = u.pn * 256 + bj * 128 + wc * 32 + 8 * fq; f32x4 v0 = acc[ai][bj][m][0], v1 = acc[ai][bj][m][1];
#define EPI_LOOP_END    } }
#define EPI_ARGS const f32x4 (&acc)[2][2][4][2], const pg8::Unit& u, int wr, int wc, int fr, int fq

struct EpiProj {
    bf16_t* P; float* AB;
    __device__ __forceinline__ void operator()(EPI_ARGS) const {
        if (u.pn < 26) {
            const bool act = u.pn < 4;
            EPI_LOOP_BEGIN
                if (act) {
#pragma unroll
                    for (int e = 0; e < 4; ++e) { v0[e] = gelu_tanh(v0[e]); v1[e] = gelu_tanh(v1[e]); }
                }
                u32x4 w; w.x = pk2(v0[0], v0[1]); w.y = pk2(v0[2], v0[3]); w.z = pk2(v1[0], v1[1]); w.w = pk2(v1[2], v1[3]);
                *(u32x4*)(P + (size_t)row * PJ + col) = w;
            EPI_LOOP_END
        } else {
            if (wc == 0 && fq < 2) {
#pragma unroll
                for (int ai = 0; ai < 2; ++ai)
#pragma unroll
                    for (int m = 0; m < 4; ++m) { const int row = u.pm * 256 + ai * 128 + wr * 64 + m * 16 + fr;
                        *(f32x4*)(AB + (size_t)row * 16 + 8 * fq) = acc[ai][0][m][0]; *(f32x4*)(AB + (size_t)row * 16 + 8 * fq + 4) = acc[ai][0][m][1]; }
            }
        }
    }
};
struct EpiRes {
    const float* base; float* out;
    __device__ __forceinline__ void operator()(EPI_ARGS) const {
        EPI_LOOP_BEGIN
            const size_t off = (size_t)row * DM + col;
            const f32x4 b0 = *(const f32x4*)(base + off), b1 = *(const f32x4*)(base + off + 4);
            *(f32x4*)(out + off) = b0 + v0; *(f32x4*)(out + off + 4) = b1 + v1;
        EPI_LOOP_END
    }
};
struct EpiRelu2 {
    bf16_t* O;
    __device__ __forceinline__ void operator()(EPI_ARGS) const {
        EPI_LOOP_BEGIN
#pragma unroll
            for (int e = 0; e < 4; ++e) { const float a = fmaxf(v0[e], 0.f), b = fmaxf(v1[e], 0.f); v0[e] = a * a; v1[e] = b * b; }
            u32x4 w; w.x = pk2(v0[0], v0[1]); w.y = pk2(v0[2], v0[3]); w.z = pk2(v1[0], v1[1]); w.w = pk2(v1[2], v1[3]);
            *(u32x4*)(O + (size_t)row * FFD + col) = w;
        EPI_LOOP_END
    }
};
struct EpiPlain {
    bf16_t* O;
    __device__ __forceinline__ void operator()(EPI_ARGS) const {
        EPI_LOOP_BEGIN
            u32x4 w; w.x = pk2(v0[0], v0[1]); w.y = pk2(v0[2], v0[3]); w.z = pk2(v1[0], v1[1]); w.w = pk2(v1[2], v1[3]);
            *(u32x4*)(O + (size_t)row * DM + col) = w;
        EPI_LOOP_END
    }
};
struct EpiGate {
    const bf16_t* PP; float* out;
    __device__ __forceinline__ void operator()(EPI_ARGS) const {
        EPI_LOOP_BEGIN
            const size_t off = (size_t)row * DM + col;
            const u32x4 pw = *(const u32x4*)(PP + off);
            const f32x4 b0 = *(const f32x4*)(out + off), b1 = *(const f32x4*)(out + off + 4);
            f32x4 o0, o1;
            o0[0] = b0[0] + bflo(pw.x) * sigmoidf_(v0[0]); o0[1] = b0[1] + bfhi(pw.x) * sigmoidf_(v0[1]);
            o0[2] = b0[2] + bflo(pw.y) * sigmoidf_(v0[2]); o0[3] = b0[3] + bfhi(pw.y) * sigmoidf_(v0[3]);
            o1[0] = b1[0] + bflo(pw.z) * sigmoidf_(v1[0]); o1[1] = b1[1] + bfhi(pw.z) * sigmoidf_(v1[1]);
            o1[2] = b1[2] + bflo(pw.w) * sigmoidf_(v1[2]); o1[3] = b1[3] + bfhi(pw.w) * sigmoidf_(v1[3]);
            *(f32x4*)(out + off) = o0; *(f32x4*)(out + off + 4) = o1;
        EPI_LOOP_END
    }
};

__device__ __forceinline__ void transpose_item(const float* W, int K, int N, int Npad, bf16_t* WT, LAS float* scr, int item, int lane) {
    const int nblk = Npad / 32, kb = item / nblk, nb = item % nblk, k0 = 64 * kb, n0 = 32 * nb;
    const int nn = n0 + (lane & 31); const bool ok = nn < N;
#pragma unroll 8
    for (int i = 0; i < 32; ++i) { const int kk = 2 * i + (lane >> 5); scr[kk * 33 + (lane & 31)] = ok ? W[(size_t)(k0 + kk) * N + nn] : 0.f; }
    LDS_WAIT(); asm volatile("" ::: "memory");
    const int c = lane & 7;
#pragma unroll
    for (int j = 0; j < 4; ++j) { const int n = (lane >> 3) + 8 * j; const LAS float* s = scr + (8 * c) * 33 + n;
        u32x4 o; o.x = pk2(s[0 * 33], s[1 * 33]); o.y = pk2(s[2 * 33], s[3 * 33]); o.z = pk2(s[4 * 33], s[5 * 33]); o.w = pk2(s[6 * 33], s[7 * 33]);
        *(u32x4*)(WT + (size_t)(n0 + n) * K + k0 + 8 * c) = o; }
    LDS_WAIT(); asm volatile("" ::: "memory");
}
__device__ __forceinline__ void rms_row_bf16(const float* xrow, const float* g, bf16_t* orow, int lane) {
    const f32x4* xr = (const f32x4*)xrow + lane; const f32x4* gr = (const f32x4*)g + lane;
    f32x4 v[8]; float s = 0.f;
#pragma unroll
    for (int j = 0; j < 8; ++j) { v[j] = xr[64 * j]; s += (v[j][0] * v[j][0] + v[j][1] * v[j][1]) + (v[j][2] * v[j][2] + v[j][3] * v[j][3]); }
    const float rstd = 1.0f / sqrtf(wave_sum(s) * (1.0f / DM) + EPSF);
    u32x2* o8 = (u32x2*)orow + lane;
#pragma unroll
    for (int j = 0; j < 8; ++j) { const f32x4 gg = gr[64 * j]; u32x2 w; w.x = pk2(v[j][0] * rstd * gg[0], v[j][1] * rstd * gg[1]); w.y = pk2(v[j][2] * rstd * gg[2], v[j][3] * rstd * gg[3]); o8[64 * j] = w; }
}
__device__ __forceinline__ void rms_row_f32(const float* xrow, const float* g, float* orow, int lane) {
    const f32x4* xr = (const f32x4*)xrow + lane; const f32x4* gr = (const f32x4*)g + lane;
    f32x4 v[8]; float s = 0.f;
#pragma unroll
    for (int j = 0; j < 8; ++j) { v[j] = xr[64 * j]; s += (v[j][0] * v[j][0] + v[j][1] * v[j][1]) + (v[j][2] * v[j][2] + v[j][3] * v[j][3]); }
    const float rstd = 1.0f / sqrtf(wave_sum(s) * (1.0f / DM) + EPSF);
    f32x4* o = (f32x4*)orow + lane;
#pragma unroll
    for (int j = 0; j < 8; ++j) { const f32x4 gg = gr[64 * j]; o[64 * j] = v[j] * rstd * gg; }
}

__device__ __forceinline__ void gdn_chunk_item(LAS unsigned char* L, int item, const bf16_t* P, const float* AB, const float* convw, const float* a_log, const float* dt_bias,
                                               unsigned char* GDN, float* GL, int tid_in) {
    int tid = tid_in; asm volatile("" : "+v"(tid));
    const int n = item & 63, bh = item >> 6, h = bh & 7, b = bh >> 3;
    const int tok0 = b * SEQL + n * 64;
    const int wave = tid >> 6, lane = tid & 63, q4 = lane >> 4, c15 = lane & 15;
    LAS bf16_t* Kb = (LAS bf16_t*)(L);
    LAS bf16_t* Qb = (LAS bf16_t*)(L + 17408);
    LAS float* Af = (LAS float*)(L + 34816);
    LAS float* X = (LAS float*)(L + 51200);
    LAS float* gcs = (LAS float*)(L + 116736);
    LAS float* bts = gcs + 64;
    LAS float* egc = gcs + 128;
    unsigned char* gbase = GDN + (size_t)item * GDN_ITEM;
    bf16_t* g_qexp = (bf16_t*)gbase; bf16_t* g_kcd = (bf16_t*)(gbase + 16384); bf16_t* g_ktT = (bf16_t*)(gbase + 32768);
    bf16_t* g_valT = (bf16_t*)(gbase + 49152); bf16_t* g_intra = (bf16_t*)(gbase + 65536);

    const int cgi = tid % 48, seg = tid / 48, which = cgi >> 4, cc = (cgi & 15) * 8;
    const int col = C_Q + which * 1024 + h * 128 + cc;
    u32x4 raw[11];
    if (wave < 6) {
#pragma unroll
        for (int i = 0; i < 11; ++i) { const int r = seg * 8 - 3 + i;
            if (n * 64 + r >= 0) raw[i] = *(const u32x4*)(P + (size_t)(tok0 + r) * PJ + col); else raw[i] = (u32x4){0u, 0u, 0u, 0u}; }
    }
    if (wave == 0) {
        const float a = AB[(size_t)(tok0 + lane) * 16 + h], bb = AB[(size_t)(tok0 + lane) * 16 + 8 + h];
        const float xs = a + dt_bias[h];
        const float sp = xs > 20.f ? xs : log1pf(__expf(xs));
        float c = -__expf(a_log[h]) * sp;
#pragma unroll
        for (int o = 1; o < 64; o <<= 1) { const float t = __shfl_up(c, o); if (lane >= o) c += t; }
        gcs[lane] = c; bts[lane] = sigmoidf_(bb); egc[lane] = __expf(c);
    }
    LBAR();
    if (wave < 6) {
        float w[4][8];
#pragma unroll
        for (int j = 0; j < 4; ++j) { const f32x4 a = *(const f32x4*)(convw + j * 3072 + which * 1024 + h * 128 + cc), bq = *(const f32x4*)(convw + j * 3072 + which * 1024 + h * 128 + cc + 4);
            w[j][0] = a[0]; w[j][1] = a[1]; w[j][2] = a[2]; w[j][3] = a[3]; w[j][4] = bq[0]; w[j][5] = bq[1]; w[j][6] = bq[2]; w[j][7] = bq[3]; }
        float x0[8], x1[8], x2[8], x3[8];
        auto ldrow = [&](int i, float (&dst)[8]) { const u32x4 v = raw[i];
            dst[0] = bflo(v.x); dst[1] = bfhi(v.x); dst[2] = bflo(v.y); dst[3] = bfhi(v.y); dst[4] = bflo(v.z); dst[5] = bfhi(v.z); dst[6] = bflo(v.w); dst[7] = bfhi(v.w); };
        ldrow(0, x0); ldrow(1, x1); ldrow(2, x2);
#pragma unroll
        for (int i = 0; i < 8; ++i) {
            const int t = seg * 8 + i;
            ldrow(i + 3, x3);
            float y[8]; float ss = 0.f;
#pragma unroll
            for (int e = 0; e < 8; ++e) { const float c = w[0][e] * x0[e] + w[1][e] * x1[e] + w[2][e] * x2[e] + w[3][e] * x3[e]; y[e] = c * sigmoidf_(c); ss += y[e] * y[e]; }
            ss += __shfl_xor(ss, 1); ss += __shfl_xor(ss, 2); ss += __shfl_xor(ss, 4); ss += __shfl_xor(ss, 8);
            const float rn = 1.0f / sqrtf(ss + EPSF);
            const float bt = bts[t], eg = egc[t];
            if (which == 0) {
                const float s = rn * 0.08838834764831845f;
                u32x4 o; o.x = pk2(y[0] * s, y[1] * s); o.y = pk2(y[2] * s, y[3] * s); o.z = pk2(y[4] * s, y[5] * s); o.w = pk2(y[6] * s, y[7] * s);
                *(LAS u32x4*)(Qb + t * 136 + cc) = o;
            } else if (which == 1) {
                u32x4 o; o.x = pk2(y[0] * rn, y[1] * rn); o.y = pk2(y[2] * rn, y[3] * rn); o.z = pk2(y[4] * rn, y[5] * rn); o.w = pk2(y[6] * rn, y[7] * rn);
                *(LAS u32x4*)(Kb + t * 136 + cc) = o;
                const float s = rn * bt * eg;
                *(LAS f32x4*)(X + t * 256 + 128 + cc) = (f32x4){y[0] * s, y[1] * s, y[2] * s, y[3] * s};
                *(LAS f32x4*)(X + t * 256 + 128 + cc + 4) = (f32x4){y[4] * s, y[5] * s, y[6] * s, y[7] * s};
            } else {
                *(LAS f32x4*)(X + t * 256 + cc) = (f32x4){y[0] * bt, y[1] * bt, y[2] * bt, y[3] * bt};
                *(LAS f32x4*)(X + t * 256 + cc + 4) = (f32x4){y[4] * bt, y[5] * bt, y[6] * bt, y[7] * bt};
            }
#pragma unroll
            for (int e = 0; e < 8; ++e) { x0[e] = x1[e]; x1[e] = x2[e]; x2[e] = x3[e]; }
            __builtin_amdgcn_sched_barrier(0);
        }
    }
    LBAR();
    {
        const int ti = wave >> 1;
        bf16x8 ak[4], aq[4];
#pragma unroll
        for (int kb = 0; kb < 4; ++kb) { ak[kb] = *(const LAS bf16x8*)(Kb + (16 * ti + c15) * 136 + 32 * kb + 8 * q4); aq[kb] = *(const LAS bf16x8*)(Qb + (16 * ti + c15) * 136 + 32 * kb + 8 * q4); }
#pragma unroll
        for (int jj = 0; jj < 2; ++jj) {
            const int tj = 2 * (wave & 1) + jj;
            f32x4 dk = (f32x4){0.f, 0.f, 0.f, 0.f}, dq = (f32x4){0.f, 0.f, 0.f, 0.f};
#pragma unroll
            for (int kb = 0; kb < 4; ++kb) { const bf16x8 bk = *(const LAS bf16x8*)(Kb + (16 * tj + c15) * 136 + 32 * kb + 8 * q4);
                dk = __builtin_amdgcn_mfma_f32_16x16x32_bf16(ak[kb], bk, dk, 0, 0, 0); dq = __builtin_amdgcn_mfma_f32_16x16x32_bf16(aq[kb], bk, dq, 0, 0, 0); }
            const int j = 16 * tj + c15; const float gj = gcs[j];
#pragma unroll
            for (int r = 0; r < 4; ++r) { const int i = 16 * ti + 4 * q4 + r;
                const float dec = (j <= i) ? __expf(fminf(gcs[i] - gj, 0.f)) : 0.f;
                Af[i * 64 + j] = (j < i) ? bts[i] * dk[r] * dec : 0.f;
                g_intra[i * 64 + kperm(j)] = (bf16_t)(pk2(dq[r] * dec, 0.f) & 0xffffu); }
        }
    }
    LBAR();
    int tid2 = tid; asm volatile("" : "+v"(tid2));
    if (tid2 < 256) {
        const int c = tid2;
        float x[64];
        f32x4 arA[2][4], arB[12]; float xin[2];
        xin[0] = X[c]; xin[1] = X[256 + c]; arA[1][0] = *(const LAS f32x4*)(Af + 64);
#pragma unroll
        for (int i = 0; i < 64; ++i) {
            if (i >= 1 && i + 1 < 64) {
#pragma unroll
                for (int qd = 0; qd < ((i + 4) / 4 < 4 ? (i + 4) / 4 : 4); ++qd) arA[(i + 1) & 1][qd] = *(const LAS f32x4*)(Af + (i + 1) * 64 + 4 * qd);
                xin[(i + 1) & 1] = X[(i + 1) * 256 + c];
            }
            if (i > 16) {
#pragma unroll
                for (int qd = 4; qd < (i + 3) / 4; ++qd) arB[qd - 4] = *(const LAS f32x4*)(Af + i * 64 + 4 * qd);
            }
            __builtin_amdgcn_sched_barrier(0);
            float a0 = xin[i & 1], a1 = 0.f;
#pragma unroll
            for (int j = 0; j < (i < 16 ? i : 16); ++j) { if (j & 1) a1 -= arA[i & 1][j >> 2][j & 3] * x[j]; else a0 -= arA[i & 1][j >> 2][j & 3] * x[j]; }
#pragma unroll
            for (int j = 16; j < i; ++j) { if (j & 1) a1 -= arB[(j >> 2) - 4][j & 3] * x[j]; else a0 -= arB[(j >> 2) - 4][j & 3] * x[j]; }
            x[i] = a0 + a1;
            __builtin_amdgcn_sched_barrier(0);
        }
        if (c < 128) {
#pragma unroll
            for (int k = 0; k < 8; ++k) { u32x4 o; o.x = pk2(x[8 * k], x[8 * k + 1]); o.y = pk2(x[8 * k + 2], x[8 * k + 3]); o.z = pk2(x[8 * k + 4], x[8 * k + 5]); o.w = pk2(x[8 * k + 6], x[8 * k + 7]);
                *(u32x4*)(g_valT + c * 64 + 8 * k) = o; }
        } else {
            const int pd = kperm(c - 128);
#pragma unroll
            for (int i = 0; i < 64; ++i) g_kcd[i * 128 + pd] = (bf16_t)(pk2(x[i], 0.f) & 0xffffu);
        }
    } else {
        const int t2 = tid2 - 256;
        {
            const int l = t2 >> 2, kb = t2 & 3; const float eg = egc[l];
#pragma unroll
            for (int k4 = 0; k4 < 4; ++k4) { float v[8];
#pragma unroll
                for (int e = 0; e < 8; ++e) { const int pos = 8 * k4 + e, qq = pos >> 3, jh = (pos >> 2) & 1, r = pos & 3; v[e] = bf2f(Qb[l * 136 + 32 * kb + 16 * jh + 4 * qq + r]) * eg; }
                u32x4 o; o.x = pk2(v[0], v[1]); o.y = pk2(v[2], v[3]); o.z = pk2(v[4], v[5]); o.w = pk2(v[6], v[7]);
                *(u32x4*)(g_qexp + l * 128 + 32 * kb + 8 * k4) = o; }
        }
        {
            const int d = t2 >> 1, kb2 = t2 & 1; const float glast = gcs[63];
#pragma unroll
            for (int k4 = 0; k4 < 4; ++k4) { float v[8];
#pragma unroll
                for (int e = 0; e < 8; ++e) { const int pos = 8 * k4 + e, qq = pos >> 3, jh = (pos >> 2) & 1, r = pos & 3; const int l = 32 * kb2 + 16 * jh + 4 * qq + r; v[e] = bf2f(Kb[l * 136 + d]) * __expf(glast - gcs[l]); }
                u32x4 o; o.x = pk2(v[0], v[1]); o.y = pk2(v[2], v[3]); o.z = pk2(v[4], v[5]); o.w = pk2(v[6], v[7]);
                *(u32x4*)(g_ktT + d * 64 + 32 * kb2 + 8 * k4) = o; }
        }
        if (t2 == 0) GL[item] = egc[63];
    }
    LBAR();
}

__device__ __forceinline__ void gdn_scan(LAS unsigned char* L, int id, const unsigned char* GDN, const float* GL, bf16_t* P, int tid) {
    const int bh = id >> 1, half = id & 1, h = bh & 7, b = bh >> 3;
    const int wave = tid >> 6, lane = tid & 63, q4 = lane >> 4, c15 = lane & 15;
    constexpr int BUF = 71680;
    f32x4 S[8];
#pragma unroll
    for (int T = 0; T < 8; ++T) S[T] = (f32x4){0.f, 0.f, 0.f, 0.f};
    u32x4 pf[8];
    const int c0 = tid, c1 = tid + 512;
#define SCAN_LOAD(nn) do { const unsigned char* gb_ = GDN + (size_t)(bh * 64 + (nn)) * GDN_ITEM; \
        pf[0] = *(const u32x4*)(gb_ + c0 * 16); pf[1] = *(const u32x4*)(gb_ + c1 * 16); \
        pf[2] = *(const u32x4*)(gb_ + 16384 + c0 * 16); pf[3] = *(const u32x4*)(gb_ + 16384 + c1 * 16); \
        pf[4] = *(const u32x4*)(gb_ + 32768 + c0 * 16); pf[5] = *(const u32x4*)(gb_ + 32768 + c1 * 16); \
        pf[6] = *(const u32x4*)(gb_ + 65536 + c0 * 16); \
        pf[7] = *(const u32x4*)(gb_ + 49152 + half * 8192 + c0 * 16); } while (0)
#define SCAN_STORE(LB) do { \
        *(LAS u32x4*)((LB) + (c0 >> 4) * 272 + (c0 & 15) * 16) = pf[0]; *(LAS u32x4*)((LB) + (c1 >> 4) * 272 + (c1 & 15) * 16) = pf[1]; \
        *(LAS u32x4*)((LB) + 17408 + (c0 >> 4) * 272 + (c0 & 15) * 16) = pf[2]; *(LAS u32x4*)((LB) + 17408 + (c1 >> 4) * 272 + (c1 & 15) * 16) = pf[3]; \
        *(LAS u32x4*)((LB) + 34816 + (c0 >> 3) * 144 + (c0 & 7) * 16) = pf[4]; *(LAS u32x4*)((LB) + 34816 + (c1 >> 3) * 144 + (c1 & 7) * 16) = pf[5]; \
        *(LAS u32x4*)((LB) + 53248 + (c0 >> 3) * 144 + (c0 & 7) * 16) = pf[6]; \
        *(LAS u32x4*)((LB) + 62464 + (c0 >> 3) * 144 + (c0 & 7) * 16) = pf[7]; } while (0)
    SCAN_LOAD(0); SCAN_STORE(L);
    float gl_next = GL[bh * 64];
    __syncthreads();
    for (int n = 0; n < 64; ++n) {
        const float gl = gl_next;
        if (n + 1 < 64) { SCAN_LOAD(n + 1); gl_next = GL[bh * 64 + n + 1]; }
        LAS unsigned char* LB = L + (n & 1) * BUF;
        if (wave < 4) {
            LAS unsigned char* Lq = LB; LAS unsigned char* Lk = LB + 17408; LAS unsigned char* Lt = LB + 34816; LAS unsigned char* Li = LB + 53248; LAS unsigned char* Lv = LB + 62464;
            bf16x8 Sp[4];
#pragma unroll
            for (int kb = 0; kb < 4; ++kb) Sp[kb] = pack8(S[2 * kb], S[2 * kb + 1]);
            u32x2 vr[4];
#pragma unroll
            for (int t = 0; t < 4; ++t) vr[t] = *(const LAS u32x2*)(Lv + (16 * wave + c15) * 144 + (16 * t + 4 * q4) * 2);
            f32x4 pa[4], oo[4];
#pragma unroll
            for (int t = 0; t < 4; ++t) { pa[t] = (f32x4){0.f, 0.f, 0.f, 0.f}; oo[t] = (f32x4){0.f, 0.f, 0.f, 0.f}; }
#pragma unroll
            for (int hh = 0; hh < 2; ++hh) {
                bf16x8 fk[2][4], fq[2][4];
#pragma unroll
                for (int tt = 0; tt < 2; ++tt)
#pragma unroll
                    for (int kb = 0; kb < 4; ++kb) { fk[tt][kb] = *(const LAS bf16x8*)(Lk + (16 * (2 * hh + tt) + c15) * 272 + (32 * kb + 8 * q4) * 2); fq[tt][kb] = *(const LAS bf16x8*)(Lq + (16 * (2 * hh + tt) + c15) * 272 + (32 * kb + 8 * q4) * 2); }
                __builtin_amdgcn_sched_barrier(0);
#pragma unroll
                for (int kb = 0; kb < 4; ++kb)
#pragma unroll
                    for (int tt = 0; tt < 2; ++tt) { pa[2 * hh + tt] = __builtin_amdgcn_mfma_f32_16x16x32_bf16(fk[tt][kb], Sp[kb], pa[2 * hh + tt], 0, 0, 0); oo[2 * hh + tt] = __builtin_amdgcn_mfma_f32_16x16x32_bf16(fq[tt][kb], Sp[kb], oo[2 * hh + tt], 0, 0, 0); }
                __builtin_amdgcn_sched_barrier(0);
            }
            f32x4 Vn[4];
#pragma unroll
            for (int t = 0; t < 4; ++t) Vn[t] = (f32x4){bflo(vr[t].x), bfhi(vr[t].x), bflo(vr[t].y), bfhi(vr[t].y)} - pa[t];
            bf16x8 Vp[2];
            Vp[0] = pack8(Vn[0], Vn[1]); Vp[1] = pack8(Vn[2], Vn[3]);
            {
                bf16x8 fi[4][2], ft[4][2];
#pragma unroll
                for (int t = 0; t < 4; ++t)
#pragma unroll
                    for (int kb = 0; kb < 2; ++kb) { fi[t][kb] = *(const LAS bf16x8*)(Li + (16 * t + c15) * 144 + (32 * kb + 8 * q4) * 2); ft[t][kb] = *(const LAS bf16x8*)(Lt + (16 * t + c15) * 144 + (32 * kb + 8 * q4) * 2); }
                __builtin_amdgcn_sched_barrier(0);
#pragma unroll
                for (int T = 0; T < 4; ++T) S[T] = S[T] * gl;
#pragma unroll
                for (int kb = 0; kb < 2; ++kb)
#pragma unroll
                    for (int t = 0; t < 4; ++t) { oo[t] = __builtin_amdgcn_mfma_f32_16x16x32_bf16(fi[t][kb], Vp[kb], oo[t], 0, 0, 0); S[t] = __builtin_amdgcn_mfma_f32_16x16x32_bf16(ft[t][kb], Vp[kb], S[t], 0, 0, 0); }
                __builtin_amdgcn_sched_barrier(0);
            }
            {
                bf16x8 ft[4][2];
#pragma unroll
                for (int t = 0; t < 4; ++t)
#pragma unroll
                    for (int kb = 0; kb < 2; ++kb) ft[t][kb] = *(const LAS bf16x8*)(Lt + (16 * (4 + t) + c15) * 144 + (32 * kb + 8 * q4) * 2);
                __builtin_amdgcn_sched_barrier(0);
#pragma unroll
                for (int T = 4; T < 8; ++T) S[T] = S[T] * gl;
#pragma unroll
                for (int kb = 0; kb < 2; ++kb)
#pragma unroll
                    for (int t = 0; t < 4; ++t) S[4 + t] = __builtin_amdgcn_mfma_f32_16x16x32_bf16(ft[t][kb], Vp[kb], S[4 + t], 0, 0, 0);
                __builtin_amdgcn_sched_barrier(0);
            }
            {
                bf16_t* ob = P + ((size_t)b * SEQL + n * 64) * PJ + C_Q + h * 128 + half * 64 + 16 * wave + c15;
#pragma unroll
                for (int t = 0; t < 4; ++t)
#pragma unroll
                    for (int r = 0; r < 4; ++r) ob[(size_t)(16 * t + 4 * q4 + r) * PJ] = (bf16_t)(pk2(oo[t][r], 0.f) & 0xffffu);
            }
        }
        if (n + 1 < 64) { LAS unsigned char* LN = L + ((n + 1) & 1) * BUF; SCAN_STORE(LN); }
        LBAR();
    }
#undef SCAN_LOAD
#undef SCAN_STORE
}
__device__ __forceinline__ void gdn_finalize(int item, const bf16_t* P, const float* gnorm, bf16_t* MIX, int lane) {
    const int tok = item >> 1, hq = item & 1, c = hq * 512 + lane * 8;
    float o[8], z[8];
    unpack8(*(const u32x4*)(P + (size_t)tok * PJ + C_Q + c), o);
    unpack8(*(const u32x4*)(P + (size_t)tok * PJ + C_Z + c), z);
    float ss = 0.f;
#pragma unroll
    for (int e = 0; e < 8; ++e) ss += o[e] * o[e];
    ss += __shfl_xor(ss, 1); ss += __shfl_xor(ss, 2); ss += __shfl_xor(ss, 4); ss += __shfl_xor(ss, 8);
    const float rstd = 1.0f / sqrtf(ss * (1.0f / 128.f) + EPSF);
    const f32x4 g0 = *(const f32x4*)(gnorm + (c & 127)), g1 = *(const f32x4*)(gnorm + (c & 127) + 4);
    float r[8];
#pragma unroll
    for (int e = 0; e < 8; ++e) { const float gg = e < 4 ? g0[e & 3] : g1[e & 3]; r[e] = o[e] * rstd * gg * (z[e] * __builtin_amdgcn_rcpf(1.0f + __expf(-z[e]))); }
    u32x4 w; w.x = pk2(r[0], r[1]); w.y = pk2(r[2], r[3]); w.z = pk2(r[4], r[5]); w.w = pk2(r[6], r[7]);
    *(u32x4*)(MIX + (size_t)tok * DM + 1024 + c) = w;
}

__device__ __forceinline__ void sgu_item(LAS unsigned char* L, int item, const bf16_t* P, const float* sgw, const float* sgb, const float* lng, const float* lnb, const float* ona, bf16_t* MIX, int tid) {
    const int h = item & 3, n = (item >> 2) & 31, b = item >> 7;
    const size_t tok0 = (size_t)b * SEQL + n * 128;
    const int wave = tid >> 6, lane = tid & 63, q4 = lane >> 4, c15 = lane & 15;
    LAS bf16_t* Wl = (LAS bf16_t*)L;
    LAS bf16_t* Vt = (LAS bf16_t*)(L + 34816);
    {
        const int t = tid >> 2, s0 = (tid & 3) * 32; const float* wr = sgw + (size_t)h * 16384 + t * 128 + s0;
#pragma unroll
        for (int k = 0; k < 4; ++k) { const f32x4 a = *(const f32x4*)(wr + 8 * k), c = *(const f32x4*)(wr + 8 * k + 4); float v[8] = {a[0], a[1], a[2], a[3], c[0], c[1], c[2], c[3]};
#pragma unroll
            for (int e = 0; e < 8; ++e) v[e] = (s0 + 8 * k + e <= t) ? v[e] : 0.f;
            u32x4 o; o.x = pk2(v[0], v[1]); o.y = pk2(v[2], v[3]); o.z = pk2(v[4], v[5]); o.w = pk2(v[6], v[7]);
            *(LAS u32x4*)(Wl + t * 136 + s0 + 8 * k) = o; }
    }
    {
        const int s = tid >> 2, d0 = (tid & 3) * 32; const bf16_t* vr = P + (tok0 + s) * PJ + C_V + h * 128 + d0;
        float v[32]; float sm = 0.f;
#pragma unroll
        for (int k = 0; k < 4; ++k) { const u32x4 w = *(const u32x4*)(vr + 8 * k); v[8 * k] = bflo(w.x); v[8 * k + 1] = bfhi(w.x); v[8 * k + 2] = bflo(w.y); v[8 * k + 3] = bfhi(w.y); v[8 * k + 4] = bflo(w.z); v[8 * k + 5] = bfhi(w.z); v[8 * k + 6] = bflo(w.w); v[8 * k + 7] = bfhi(w.w); }
#pragma unroll
        for (int e = 0; e < 32; ++e) sm += v[e];
        sm += __shfl_xor(sm, 1); sm += __shfl_xor(sm, 2);
        const float mu = sm * (1.0f / 128.f); float sq = 0.f;
#pragma unroll
        for (int e = 0; e < 32; ++e) { v[e] -= mu; sq += v[e] * v[e]; }
        sq += __shfl_xor(sq, 1); sq += __shfl_xor(sq, 2);
        const float rstd = 1.0f / sqrtf(sq * (1.0f / 128.f) + EPSF);
#pragma unroll
        for (int e = 0; e < 32; ++e) { const float y = v[e] * rstd * lng[h * 128 + d0 + e] + lnb[h * 128 + d0 + e]; Vt[(d0 + e) * 136 + s] = (bf16_t)(pk2(y, 0.f) & 0xffffu); }
    }
    __syncthreads();
    {
        f32x4 D[8];
#pragma unroll
        for (int tj = 0; tj < 8; ++tj) D[tj] = (f32x4){0.f, 0.f, 0.f, 0.f};
        const int nkb = (wave >> 1) + 1;
        for (int kb = 0; kb < nkb; ++kb) {
            const bf16x8 a = *(const LAS bf16x8*)(Wl + (16 * wave + c15) * 136 + 32 * kb + 8 * q4);
#pragma unroll
            for (int tj = 0; tj < 8; ++tj) { const bf16x8 bv = *(const LAS bf16x8*)(Vt + (16 * tj + c15) * 136 + 32 * kb + 8 * q4); D[tj] = __builtin_amdgcn_mfma_f32_16x16x32_bf16(a, bv, D[tj], 0, 0, 0); }
        }
        float ss[4] = {0.f, 0.f, 0.f, 0.f};
#pragma unroll
        for (int r = 0; r < 4; ++r) { const int t = 16 * wave + 4 * q4 + r; const float bias = sgb[h * 128 + t]; const bf16_t* ur = P + (tok0 + t) * PJ + C_U + h * 128 + c15;
#pragma unroll
            for (int tj = 0; tj < 8; ++tj) { const float uu = bf2f(ur[16 * tj]); const float y = uu * (D[tj][r] + bias); D[tj][r] = y; ss[r] += y * y; } }
#pragma unroll
        for (int r = 0; r < 4; ++r) { float s = ss[r]; s += __shfl_xor(s, 1); s += __shfl_xor(s, 2); s += __shfl_xor(s, 4); s += __shfl_xor(s, 8); ss[r] = 1.0f / sqrtf(s * (1.0f / 128.f) + EPSF); }
#pragma unroll
        for (int r = 0; r < 4; ++r) { const int t = 16 * wave + 4 * q4 + r; bf16_t* orow = MIX + (tok0 + t) * DM + h * 128 + c15;
#pragma unroll
            for (int tj = 0; tj < 8; ++tj) orow[16 * tj] = (bf16_t)(pk2(D[tj][r] * ss[r] * ona[h * 128 + 16 * tj + c15], 0.f) & 0xffffu); }
    }
    __syncthreads();
}

__device__ __forceinline__ void shortconv_token(int tok, const bf16_t* P, const float* scw, const float* onb, bf16_t* MIX, int lane) {
    const int c = lane * 8, pos = tok & (SEQL - 1);
    const bf16_t* row = P + (size_t)tok * PJ;
    float gb[8], acc[8];
    unpack8(*(const u32x4*)(row + C_GB + c), gb);
#pragma unroll
    for (int e = 0; e < 8; ++e) acc[e] = 0.f;
#pragma unroll
    for (int j = 0; j < 3; ++j) {
        const int back = 2 - j;
        if (pos - back >= 0) { float g[8], xi[8]; const bf16_t* r2 = row - (size_t)back * PJ;
            unpack8(*(const u32x4*)(r2 + C_GC + c), g); unpack8(*(const u32x4*)(r2 + C_XI + c), xi);
            const f32x4 w0 = *(const f32x4*)(scw + j * 512 + c), w1 = *(const f32x4*)(scw + j * 512 + c + 4);
#pragma unroll
            for (int e = 0; e < 4; ++e) { acc[e] += w0[e] * (g[e] * xi[e]); acc[4 + e] += w1[e] * (g[4 + e] * xi[4 + e]); } }
    }
    float ss = 0.f;
#pragma unroll
    for (int e = 0; e < 8; ++e) { acc[e] *= gb[e]; ss += acc[e] * acc[e]; }
    ss += __shfl_xor(ss, 1); ss += __shfl_xor(ss, 2); ss += __shfl_xor(ss, 4); ss += __shfl_xor(ss, 8);
    const float rstd = 1.0f / sqrtf(ss * (1.0f / 128.f) + EPSF);
    const f32x4 g0 = *(const f32x4*)(onb + c), g1 = *(const f32x4*)(onb + c + 4);
    u32x4 o; o.x = pk2(acc[0] * rstd * g0[0], acc[1] * rstd * g0[1]); o.y = pk2(acc[2] * rstd * g0[2], acc[3] * rstd * g0[3]);
    o.z = pk2(acc[4] * rstd * g1[0], acc[5] * rstd * g1[1]); o.w = pk2(acc[6] * rstd * g1[2], acc[7] * rstd * g1[3]);
    *(u32x4*)(MIX + (size_t)tok * DM + 512 + c) = o;
}


#define XB_TMO      128
#define XB_XCNT(j)  (256  + 64 * (j))
#define XB_XSUB(j)  (1280 + 64 * (j))
#define XB_XGEN(j)  (2304 + 64 * (j))
#define XB_TOP      3328
#define XB_TOPGEN   3392
#define XCD_BAR_WORDS 3456
#define XB_SPIN_CAP (1u << 22)
__device__ __forceinline__ unsigned xb_ld(unsigned* p)              { return __hip_atomic_load(p, __ATOMIC_RELAXED, __HIP_MEMORY_SCOPE_AGENT); }
__device__ __forceinline__ unsigned xb_add(unsigned* p, unsigned v) { return __hip_atomic_fetch_add(p, v, __ATOMIC_RELAXED, __HIP_MEMORY_SCOPE_AGENT); }
__device__ __forceinline__ unsigned xb_xcc_id() { return (unsigned)__builtin_amdgcn_s_getreg((3 << 11) | 20) & 0xFu; }
#define XB_SPIN(cond, bar) do { unsigned _sp = 0; while (cond) { __builtin_amdgcn_s_sleep(1); \
    if ((++_sp & 255u) == 0u) { if (xb_ld(&(bar)[XB_TMO])) break; if (_sp > XB_SPIN_CAP) { atomicAdd(&(bar)[XB_TMO], 1u); break; } } } } while (0)
struct XcdBarrier { unsigned* bar; unsigned x; volatile LAS unsigned* st; };
__device__ __forceinline__ XcdBarrier xcd_barrier_post(unsigned* bar, volatile LAS unsigned* st, int tid) {
    XcdBarrier b; b.bar = bar; b.x = xb_xcc_id(); b.st = st;
    if (tid == 0) (void)xb_add(&bar[XB_XCNT(b.x)], 1u);
    return b;
}
__device__ __forceinline__ void xcd_barrier_complete(unsigned* bar, unsigned x, unsigned& nloc, unsigned& nx) {
    const unsigned G = gridDim.x * gridDim.y * gridDim.z;
    unsigned sum, cnt, mine, sp = 0u;
    for (;;) {
        sum = 0u; cnt = 0u; mine = 0u;
#pragma unroll
        for (unsigned j = 0; j < 16; ++j) { const unsigned c = xb_ld(&bar[XB_XCNT(j)]); sum += c; cnt += (c > 0u) ? 1u : 0u; mine = (j == x) ? c : mine; }
        if (sum == G) break;
        __builtin_amdgcn_s_sleep(1);
        if ((++sp & 255u) == 0u) { if (xb_ld(&bar[XB_TMO])) break; if (sp > XB_SPIN_CAP) { atomicAdd(&bar[XB_TMO], 1u); break; } }
    }
    nloc = mine > 0u ? mine : 1u; nx = cnt > 0u ? cnt : 1u;
}
__device__ __forceinline__ void xcd_barrier(const XcdBarrier& b, int tid) {
    asm volatile("s_waitcnt vmcnt(0)" ::: "memory");
    __syncthreads();
    if (tid == 0) {
        unsigned* bar = b.bar;
        __builtin_amdgcn_s_waitcnt(0);
        unsigned nloc = b.st[0], nx = b.st[1];
        if (nloc == 0u) { xcd_barrier_complete(bar, b.x, nloc, nx); b.st[0] = nloc; b.st[1] = nx; }
        const unsigned old = xb_add(&bar[XB_XSUB(b.x)], 1u);
        const unsigned gen = old / nloc;
        if (old + 1u == (gen + 1u) * nloc) {
            __builtin_amdgcn_fence(__ATOMIC_RELEASE, "agent");
            asm volatile("s_waitcnt vmcnt(0)" ::: "memory");
            const unsigned og = xb_add(&bar[XB_TOP], 1u);
            const unsigned tg = og / nx;
            if (og + 1u == (tg + 1u) * nx) xb_add(&bar[XB_TOPGEN], 1u);
            else XB_SPIN(xb_ld(&bar[XB_TOPGEN]) == tg, bar);
            __builtin_amdgcn_fence(__ATOMIC_ACQUIRE, "agent");
            xb_add(&bar[XB_XGEN(b.x)], 1u);
            asm volatile("s_waitcnt vmcnt(0)" ::: "memory");
        } else {
            XB_SPIN(xb_ld(&bar[XB_XGEN(b.x)]) == gen, bar);
            __builtin_amdgcn_fence(__ATOMIC_ACQUIRE, "agent");
            asm volatile("s_waitcnt vmcnt(0)" ::: "memory");
        }
    }
    __syncthreads();
}
constexpr size_t WS_BAR = 1048576 + 65536;
constexpr int LDS_MISC = 147456 - 64;

typedef const char __attribute__((address_space(4))) kchar_t;
#define KARG(field) (*(decltype(Args::field) const __attribute__((address_space(4)))*)(kp + offsetof(Args, field)))
#define MYTID() (wave0 * 64 + (int)__builtin_amdgcn_mbcnt_hi(~0u, __builtin_amdgcn_mbcnt_lo(~0u, 0u)))
#define PHASE_BEGIN int tid = MYTID(); asm volatile("" : "+v"(tid)); const int lane = tid & 63, wave = __builtin_amdgcn_readfirstlane(tid >> 6); \
    const int G = gridDim.x, bx = blockIdx.x, gw = bx * NWAVES + wave, NGW = G * NWAVES; (void)lane; (void)gw; (void)NGW; \
    kchar_t* kp = (kchar_t*)__builtin_amdgcn_kernarg_segment_ptr(); asm volatile("" : "+s"(kp)); \
    unsigned char* ws = KARG(ws); (void)ws; int l = lsel; asm volatile("" : "+s"(l));
#define WSP(T, off) ((T*)(ws + (off)))
__global__ void __launch_bounds__(NTHREADS, 2) hybrid_fwd(Args a) {
    extern __shared__ __attribute__((aligned(16))) unsigned char lds_raw[];
    LAS unsigned char* L = (LAS unsigned char*)lds_raw;
    const int lo = a.ph_lo, hi = a.ph_hi, coop = a.coop;
    const int wave0 = __builtin_amdgcn_readfirstlane(threadIdx.x >> 6);
    { const int t0 = MYTID(); if (t0 < 8) ((LAS unsigned*)(L + LDS_MISC))[t0] = 0u; }
    __syncthreads();
    XcdBarrier xbar; xbar.bar = (unsigned*)(a.ws + WS_BAR); xbar.x = 0; xbar.st = nullptr;
    if (coop) xbar = xcd_barrier_post((unsigned*)(a.ws + WS_BAR), (volatile LAS unsigned*)(L + LDS_MISC), MYTID());
    bool first_seam = true;
#ifndef PH_MASK
#define PH_MASK 0xFFFFu
#endif
#define IN(k) (((PH_MASK >> ((k) >= 20 ? 10 : (k) % 10)) & 1u) && lo <= (k) && (k) < hi)
#ifndef PROBE_DUP
#define PROBE_DUP 0u
#endif
#define NREP(k) (1 + (int)((PROBE_DUP >> (k)) & 1u))
#ifndef PROBE_SYNC
#define PROBE_SYNC 1
#endif
#define SEAM_ALWAYS() SEAM()
#define SEAM() do { if (coop) { for (int s_ = 0; s_ < PROBE_SYNC; ++s_) { if (first_seam) { cg::this_grid().sync(); first_seam = false; } else xcd_barrier(xbar, MYTID()); } } else __syncthreads(); } while (0)

#pragma unroll 1
    for (int lsel = 0; lsel < 2; ++lsel) {
        const int pb = lsel * 10;
        if (IN(pb + 0)) for (int rep_ = 0; rep_ < NREP(0); ++rep_) { if (rep_) __syncthreads();
            PHASE_BEGIN
            LAS float* scr = (LAS float*)(L + wave * 16384);
            constexpr int I_IN = 32 * (INP / 32), I_O = 32 * 64, I_1 = 32 * 256, I_2 = 128 * 64, I_G = 32 * 64, I_P = 4 * 64;
            constexpr int NITEMS = I_IN + I_O + I_1 + I_2 + I_G + I_P;
            for (int it = gw; it < NITEMS; it += NGW) {
                int r = it;
                if (r < I_IN) { transpose_item(KARG(w_in) + (size_t)l * DM * INC, DM, INC, INP, WSP(bf16_t, WS_WIN), scr, r, lane); continue; } r -= I_IN;
                if (r < I_O) { transpose_item(KARG(w_o) + (size_t)l * DM * DM, DM, DM, DM, WSP(bf16_t, WS_WO), scr, r, lane); continue; } r -= I_O;
                if (r < I_1) { transpose_item(KARG(w_ff1) + (size_t)l * DM * FFD, DM, FFD, FFD, WSP(bf16_t, WS_W1), scr, r, lane); continue; } r -= I_1;
                if (r < I_2) { transpose_item(KARG(w_ff2) + (size_t)l * DM * FFD, FFD, DM, DM, WSP(bf16_t, WS_W2), scr, r, lane); continue; } r -= I_2;
                if (r < I_G) { transpose_item(KARG(w_ple_gate) + (size_t)l * DM * DM, DM, DM, DM, WSP(bf16_t, WS_WG), scr, r, lane); continue; } r -= I_G;
                transpose_item(KARG(w_ple_proj) + (size_t)l * PLE * DM, PLE, DM, DM, WSP(bf16_t, WS_WP), scr, r, lane);
            }
            {
                const f32x4* src = (const f32x4*)(KARG(p) + (size_t)l * TOK * PLE); u32x2* dst = WSP(u32x2, WS_P16);
                for (int i = bx * NTHREADS + tid; i < TOK * PLE / 4; i += G * NTHREADS) { const f32x4 v = src[i]; u32x2 w; w.x = pk2(v[0], v[1]); w.y = pk2(v[2], v[3]); dst[i] = w; }
            }
            const float* hsrc = (l == 0) ? KARG(x) : (const float*)KARG(out);
            for (int m = gw; m < TOK; m += NGW) rms_row_bf16(hsrc + (size_t)m * DM, KARG(norm_mix) + l * DM, WSP(bf16_t, WS_XN) + (size_t)m * DM, lane);
        }
        if (IN(pb + 0) && IN(pb + 1)) SEAM();
        if (IN(pb + 1)) for (int rep_ = 0; rep_ < NREP(1); ++rep_) { if (rep_) __syncthreads();
            PHASE_BEGIN
            pg8::Gemm g{WSP(bf16_t, WS_XN), WSP(bf16_t, WS_WIN), TOK, INP, DM}; pg8::StaticOrder S; S.init(TOK, INP, G, bx);
            EpiProj E{WSP(bf16_t, WS_BIG), WSP(float, WS_AB)};
            pg8::gemm_phase<EpiProj>(L, g, S, E, tid);
        }
        if (IN(pb + 1) && IN(pb + 2)) SEAM();
        if (IN(pb + 2)) for (int rep_ = 0; rep_ < NREP(2); ++rep_) { if (rep_) __syncthreads();
            PHASE_BEGIN
            for (int it = bx; it < 2048; it += G)
                gdn_chunk_item(L, it, WSP(bf16_t, WS_BIG), WSP(float, WS_AB), KARG(gdn_conv) + (size_t)l * 4 * 3072, KARG(gdn_a_log) + l * 8, KARG(gdn_dt_bias) + l * 8, ws + WS_GDN, WSP(float, WS_GL), tid);
        }
        if (IN(pb + 2) && IN(pb + 3)) SEAM();
        if (IN(pb + 3)) for (int rep_ = 0; rep_ < NREP(3); ++rep_) { if (rep_) __syncthreads();
            PHASE_BEGIN
            const int nscan = (G > 64) ? 64 : 0;
            if (bx < nscan) {
                gdn_scan(L, bx, ws + WS_GDN, WSP(float, WS_GL), WSP(bf16_t, WS_BIG), tid);
            } else {
                if (nscan == 0) { for (int id = bx; id < 64; id += G) { gdn_scan(L, id, ws + WS_GDN, WSP(float, WS_GL), WSP(bf16_t, WS_BIG), tid); __syncthreads(); } }
                const int rb = bx - nscan, RG = G - nscan;
                for (int it = rb; it < 512; it += RG)
                    sgu_item(L, it, WSP(bf16_t, WS_BIG), KARG(sg_w) + (size_t)l * 4 * 16384, KARG(sg_b) + l * 512, KARG(sg_ln_g) + l * 512, KARG(sg_ln_b) + l * 512, KARG(out_norm_a) + l * 512, WSP(bf16_t, WS_XN), tid);
                for (int tk = rb * NWAVES + wave; tk < TOK; tk += RG * NWAVES)
                    shortconv_token(tk, WSP(bf16_t, WS_BIG), KARG(sc_conv) + l * 3 * 512, KARG(out_norm_b) + l * 512, WSP(bf16_t, WS_XN), lane);
            }
        }
        if (IN(pb + 3)) SEAM_ALWAYS();
        if (IN(pb + 3)) {
            PHASE_BEGIN
            for (int it = gw; it < TOK * 2; it += NGW) gdn_finalize(it, WSP(bf16_t, WS_BIG), KARG(gdn_norm) + l * 128, WSP(bf16_t, WS_XN), lane);
        }
        if (IN(pb + 3) && IN(pb + 4)) SEAM();
        if (IN(pb + 4)) for (int rep_ = 0; rep_ < NREP(4); ++rep_) { if (rep_) __syncthreads();
            PHASE_BEGIN
            pg8::Gemm g{WSP(bf16_t, WS_XN), WSP(bf16_t, WS_WO), TOK, DM, DM}; pg8::StaticOrder S; S.init(TOK, DM, G, bx);
            const float* hsrc = (l == 0) ? KARG(x) : (const float*)KARG(out);
            EpiRes E{hsrc, KARG(out)};
            pg8::gemm_phase<EpiRes>(L, g, S, E, tid);
        }
#if defined(PROBE_X) && (PROBE_X & 2)
        if (IN(pb + 4)) { __syncthreads(); PHASE_BEGIN
            pg8::Gemm g{WSP(bf16_t, WS_XN), WSP(bf16_t, WS_WO), TOK, DM, DM}; pg8::StaticOrder S; S.init(TOK, DM, G, bx);
            EpiPlain E{WSP(bf16_t, WS_BIG)};
            pg8::gemm_phase<EpiPlain>(L, g, S, E, tid); }
#endif
        if (IN(pb + 4) && IN(pb + 5)) SEAM();
        if (IN(pb + 5)) for (int rep_ = 0; rep_ < NREP(5); ++rep_) { if (rep_) __syncthreads();
            PHASE_BEGIN
            for (int m = gw; m < TOK; m += NGW) rms_row_bf16(KARG(out) + (size_t)m * DM, KARG(norm_ffn) + l * DM, WSP(bf16_t, WS_XN) + (size_t)m * DM, lane);
        }
        if (IN(pb + 5) && IN(pb + 6)) SEAM();
        if (IN(pb + 6)) for (int rep_ = 0; rep_ < NREP(6); ++rep_) { if (rep_) __syncthreads();
            PHASE_BEGIN
            pg8::Gemm g{WSP(bf16_t, WS_XN), WSP(bf16_t, WS_W1), TOK, FFD, DM}; pg8::StaticOrder S; S.init(TOK, FFD, G, bx);
            EpiRelu2 E{WSP(bf16_t, WS_BIG)};
            pg8::gemm_phase<EpiRelu2>(L, g, S, E, tid);
        }
        if (IN(pb + 6) && IN(pb + 7)) SEAM();
        if (IN(pb + 7)) for (int rep_ = 0; rep_ < NREP(7); ++rep_) { if (rep_) __syncthreads();
            PHASE_BEGIN
            pg8::Gemm g{WSP(bf16_t, WS_BIG), WSP(bf16_t, WS_W2), TOK, DM, FFD}; pg8::StaticOrder S; S.init(TOK, DM, G, bx);
            EpiRes E{KARG(out), KARG(out)};
            pg8::gemm_phase<EpiRes>(L, g, S, E, tid);
        }
#if defined(PROBE_X) && (PROBE_X & 1)
        if (IN(pb + 7)) { __syncthreads(); PHASE_BEGIN
            pg8::Gemm g{WSP(bf16_t, WS_BIG), WSP(bf16_t, WS_W2), TOK, DM, FFD}; pg8::StaticOrder S; S.init(TOK, DM, G, bx);
            EpiPlain E{WSP(bf16_t, WS_XN)};
            pg8::gemm_phase<EpiPlain>(L, g, S, E, tid); }
#endif
        if (IN(pb + 7) && IN(pb + 8)) SEAM();
        if (IN(pb + 8)) for (int rep_ = 0; rep_ < NREP(8); ++rep_) {
            PHASE_BEGIN
            for (int m = gw; m < TOK; m += NGW) rms_row_bf16(KARG(out) + (size_t)m * DM, KARG(norm_ple) + l * DM, WSP(bf16_t, WS_XN) + (size_t)m * DM, lane);
        }
        if (IN(pb + 8)) for (int rep_ = 0; rep_ < NREP(10); ++rep_) {
            __syncthreads();
            PHASE_BEGIN
            pg8::Gemm g{WSP(bf16_t, WS_P16), WSP(bf16_t, WS_WP), TOK, DM, PLE}; pg8::StaticOrder S; S.init(TOK, DM, G, bx);
            EpiPlain E{WSP(bf16_t, WS_BIG)};
            pg8::gemm_phase<EpiPlain>(L, g, S, E, tid);
        }
        if (IN(pb + 8) && IN(pb + 9)) SEAM();
        if (IN(pb + 9)) for (int rep_ = 0; rep_ < NREP(9); ++rep_) { if (rep_) __syncthreads();
            PHASE_BEGIN
            pg8::Gemm g{WSP(bf16_t, WS_XN), WSP(bf16_t, WS_WG), TOK, DM, DM}; pg8::StaticOrder S; S.init(TOK, DM, G, bx);
            EpiGate E{WSP(bf16_t, WS_BIG), KARG(out)};
            pg8::gemm_phase<EpiGate>(L, g, S, E, tid);
        }
        if (IN(pb + 9) && IN(pb + 10)) SEAM();
    }
    if (IN(20)) {
        const int lsel = 0;
        PHASE_BEGIN
        for (int m = gw; m < TOK; m += NGW) rms_row_f32(KARG(out) + (size_t)m * DM, KARG(norm_final), KARG(out) + (size_t)m * DM, lane);
    }
#undef IN
#undef SEAM
}

extern "C" void kernel_launch(void* const* d_in, const int* in_sizes, int n_in, void* d_out, int out_size, void* d_ws, size_t ws_size, hipStream_t stream) {
    static int grid = 0;
    if (grid == 0) {
        if (n_in != 23 || out_size != TOK * DM || ws_size < WS_END) { fprintf(stderr, "kernel_launch: unexpected shapes (n_in %d out %d ws %zu need %zu)\n", n_in, out_size, ws_size, (size_t)WS_END); grid = -1; return; }
        int dev = 0, cus = 0, per_cu = 0;
        hipGetDevice(&dev);
        hipDeviceGetAttribute(&cus, hipDeviceAttributeMultiprocessorCount, dev);
        if (hipFuncSetAttribute((const void*)hybrid_fwd, hipFuncAttributeMaxDynamicSharedMemorySize, LDS_BYTES) != hipSuccess) { fprintf(stderr, "kernel_launch: hipFuncSetAttribute failed\n"); grid = -1; return; }
        if (hipOccupancyMaxActiveBlocksPerMultiprocessor(&per_cu, (const void*)hybrid_fwd, NTHREADS, LDS_BYTES) != hipSuccess || per_cu < 1) { fprintf(stderr, "kernel_launch: occupancy query gave %d\n", per_cu); per_cu = 1; }
        (void)hipGetLastError();
        grid = cus * per_cu;
    }
    if (grid < 0) return;
    Args a{};
    const float** f = (const float**)&a;
    for (int i = 0; i < 23; ++i) f[i] = (const float*)d_in[i];
    a.out = (float*)d_out; a.ws = (unsigned char*)d_ws;
#if MK_COOP
    if (hipMemsetAsync((char*)d_ws + WS_BAR, 0, 16384, stream) != hipSuccess) { fprintf(stderr, "kernel_launch: memset failed\n"); return; }
    a.ph_lo = 0; a.ph_hi = 21; a.coop = 1;
    void* args[] = {&a};
    hipError_t e = hipLaunchCooperativeKernel((const void*)hybrid_fwd, dim3(grid), dim3(NTHREADS), args, LDS_BYTES, stream);
    if (e != hipSuccess) fprintf(stderr, "cooperative launch failed: %s (grid %d)\n", hipGetErrorString(e), grid);
#else
    for (int ph = 0; ph < 21; ++ph) {
        a.ph_lo = ph; a.ph_hi = ph + 1; a.coop = 0;
        hipLaunchKernelGGL(hybrid_fwd, dim3(grid), dim3(NTHREADS), LDS_BYTES, stream, a);
    }
#endif
}
```

```cpp
#include <hip/hip_runtime.h>
#include <hip/hip_cooperative_groups.h>
#include <cstdio>
#include <cstdint>
#include <cstddef>
namespace cg = cooperative_groups;

#ifndef WGM_G1
#define WGM_G1 4
#endif
#ifndef WGM_G2
#define WGM_G2 2
#endif
#ifndef WGM_G3
#define WGM_G3 4
#endif
#ifndef WGM_G4
#define WGM_G4 4
#endif
#ifndef WGM_G6
#define WGM_G6 2
#endif
#ifndef MK_COOP
#define MK_COOP 1
#endif

#define LAS __attribute__((address_space(3)))
typedef unsigned short bf16_t;
typedef short bf16x8 __attribute__((ext_vector_type(8)));
typedef float f32x4 __attribute__((ext_vector_type(4)));
typedef float f32x2 __attribute__((ext_vector_type(2)));
typedef unsigned u32x4 __attribute__((ext_vector_type(4)));
typedef unsigned u32x2 __attribute__((ext_vector_type(2)));

namespace pg8 {
constexpr int BM = 256, BK = 64, HALF = 128, HTB = HALF * BK * 2, STAGE_BYTES = 8 * HTB, NXCD = 8, WGM = 4;
__host__ __device__ __forceinline__ int lds_byte(int r, int c) { const int st = (r >> 4) * 2 + (c >> 5), rr = r & 15, cc = c & 31, ob = rr * 64 + cc * 2; return st * 1024 + (ob ^ (((ob >> 9) & 1) << 5)); }
__host__ __device__ __forceinline__ void stage_rc(int b, int& R, int& C) { const int st = b / 1024, sb = b % 1024, swz = sb ^ (((sb >> 9) & 1) << 5); R = (st >> 1) * 16 + swz / 64; C = (st & 1) * 32 + (swz % 64) / 2; }
__host__ __device__ __forceinline__ int perm32(int rho) { const int n = rho >> 4, i = rho & 15; return 8 * (i >> 2) + 4 * n + (i & 3); }

struct Unit { int pm, pn; };
struct Gemm { const bf16_t* A; const bf16_t* Bt; int M, N, K; };

struct StaticOrder {
    int nM, nN, nwg, G, c, wgm;
    __host__ __device__ void init(int M, int N, int G_, int c_, int wgm_ = WGM) { nM = M / BM; nN = N / BM; nwg = nM * nN; G = G_; c = c_; wgm = wgm_; }
    __host__ __device__ bool next(int i, Unit& u) const {
        const long L = (long)i * G + c; if (L >= nwg) return false;
        int wgid = (int)L; { const int q = nwg / NXCD, r = nwg % NXCD, xcd = wgid % NXCD, off = wgid / NXCD; wgid = (xcd < r ? xcd * (q + 1) : r * (q + 1) + (xcd - r) * q) + off; }
        const int nig = wgm * nN, gid = wgid / nig, fm = gid * wgm, gsz = (nM - fm) < wgm ? (nM - fm) : wgm;
        u.pm = fm + ((wgid % nig) % gsz); u.pn = (wgid % nig) / gsz; return true;
    }
};

__device__ __forceinline__ unsigned cvt_pk_bf16(float lo, float hi) { unsigned r; asm volatile("v_cvt_pk_bf16_f32 %0, %1, %2" : "=v"(r) : "v"(lo), "v"(hi)); return r; }

template <class Epi>
__device__ __forceinline__ void gemm_phase(LAS unsigned char* lds, const Gemm g, const StaticOrder& S, const Epi& E, const int tid) {
    const int wid = __builtin_amdgcn_readfirstlane(tid >> 6), lane = tid & 63, wr = wid >> 2, wc = wid & 3, fr = lane & 15, fq = lane >> 4;
    int K_ = g.K; asm volatile("" : "+s"(K_)); const int K = K_, nt = K / BK;
    unsigned voffA[2], voffB[2];
#pragma unroll
    for (int i = 0; i < 2; ++i) { int R, C; stage_rc(tid * 16 + i * 8192, R, C); const int Rb = (R & ~31) + perm32(R & 31);
        voffA[i] = (unsigned)(R * K + C) * 2u; voffB[i] = (unsigned)(Rb * K + C) * 2u; }
    const size_t kstep = (size_t)(BK * 2);
    const size_t hstep = (size_t)HALF * K * 2;
    const size_t tstep = 2 * hstep;
    const unsigned ldsw = (unsigned)wid * 1024u;
    const int aoff = lds_byte(wr * 64 + fr, fq * 8), boff = lds_byte(wc * 32 + fr, fq * 8);
#define PG8_SA(b, h) (((b) * 2 + (h)) * HTB)
#define PG8_SB(b, h) ((4 + (b) * 2 + (h)) * HTB)
#define PG8_STAGE(bufoff, gbase, voff) do { _Pragma("unroll") for (int _i = 0; _i < 2; ++_i) \
        __builtin_amdgcn_global_load_lds((const unsigned*)((const char*)(gbase) + (voff)[_i]), (LAS unsigned*)(lds + (bufoff) + ldsw + _i * 8192), 16, 0, 0); } while (0)
#define PG8_LDA(dst, b, h) do { _Pragma("unroll") for (int m = 0; m < 4; ++m) _Pragma("unroll") for (int k = 0; k < 2; ++k) dst[m][k] = *(const LAS bf16x8*)(lds + PG8_SA(b, h) + aoff + m * 2048 + k * 1024); } while (0)
#define PG8_LDB(dst, b, h) do { _Pragma("unroll") for (int n = 0; n < 2; ++n) _Pragma("unroll") for (int k = 0; k < 2; ++k) dst[n][k] = *(const LAS bf16x8*)(lds + PG8_SB(b, h) + boff + n * 2048 + k * 1024); } while (0)
#define PG8_MMA(ai, bj, At, Bt) do { __builtin_amdgcn_s_setprio(1); _Pragma("unroll") for (int m = 0; m < 4; ++m) _Pragma("unroll") for (int n = 0; n < 2; ++n) _Pragma("unroll") for (int k = 0; k < 2; ++k) \
        acc[ai][bj][m][n] = __builtin_amdgcn_mfma_f32_16x16x32_bf16(Bt[n][k], At[m][k], acc[ai][bj][m][n], 0, 0, 0); __builtin_amdgcn_s_setprio(0); } while (0)
#define PG8_WAIT_V(n) asm volatile("s_waitcnt vmcnt(" #n ")" ::: "memory")
#define PG8_WAIT_L(n) asm volatile("s_waitcnt lgkmcnt(" #n ")" ::: "memory")
#define PG8_BAR __builtin_amdgcn_s_barrier()
#define PG8_SCHED __builtin_amdgcn_sched_barrier(0)
    Unit cur, nxt; int ui = 0;
    if (!S.next(0, cur)) return;
    f32x4 acc[2][2][4][2];
#pragma unroll
    for (int a = 0; a < 2; ++a)
#pragma unroll
        for (int b = 0; b < 2; ++b)
#pragma unroll
            for (int m = 0; m < 4; ++m)
#pragma unroll
                for (int n = 0; n < 2; ++n) acc[a][b][m][n] = (f32x4){0.f, 0.f, 0.f, 0.f};
    bf16x8 At[4][2], B0[2][2], B1[2][2];
    const char* cA = (const char*)g.A + (size_t)cur.pm * tstep; const char* cB = (const char*)g.Bt + (size_t)cur.pn * tstep;
    PG8_STAGE(PG8_SB(0, 0), cB, voffB); PG8_STAGE(PG8_SB(0, 1), cB + hstep, voffB); PG8_STAGE(PG8_SA(0, 0), cA, voffA); PG8_STAGE(PG8_SA(0, 1), cA + hstep, voffA);
    if (wr == 1) PG8_BAR;
    PG8_WAIT_V(2); PG8_BAR;
    PG8_STAGE(PG8_SB(1, 0), cB + kstep, voffB); PG8_STAGE(PG8_SA(1, 0), cA + kstep, voffA); PG8_STAGE(PG8_SB(1, 1), cB + hstep + kstep, voffB);
    PG8_WAIT_V(6); PG8_BAR;
    for (;;) {
        const bool has_next = S.next(ui + 1, nxt);
        const char* nA = has_next ? (const char*)g.A + (size_t)nxt.pm * tstep : cA; const char* nB = has_next ? (const char*)g.Bt + (size_t)nxt.pn * tstep : cB;
        for (int t = 0; t < nt; t += 2) {
            const bool last = (t == nt - 2);
            const char* a1 = cA + (size_t)(t + 1) * kstep;
            const char* a2 = last ? nA : cA + (size_t)(t + 2) * kstep; const char* b2 = last ? nB : cB + (size_t)(t + 2) * kstep;
            const char* a3 = a2 + kstep; const char* b3 = b2 + kstep;
            PG8_LDB(B0, 0, 0); PG8_LDB(B1, 0, 1); PG8_SCHED; PG8_LDA(At, 0, 0); PG8_STAGE(PG8_SA(1, 1), a1 + hstep, voffA);
            PG8_WAIT_V(8); PG8_WAIT_L(0); PG8_BAR; PG8_MMA(0, 0, At, B0); PG8_MMA(0, 1, At, B1); PG8_BAR; PG8_SCHED;
            PG8_LDA(At, 0, 1); PG8_STAGE(PG8_SB(0, 0), b2, voffB); PG8_STAGE(PG8_SB(0, 1), b2 + hstep, voffB); PG8_STAGE(PG8_SA(0, 0), a2, voffA);
            PG8_WAIT_V(8); PG8_WAIT_L(0); PG8_BAR; PG8_MMA(1, 0, At, B0); PG8_MMA(1, 1, At, B1); PG8_BAR; PG8_SCHED;
            PG8_LDB(B0, 1, 0); PG8_LDB(B1, 1, 1); PG8_SCHED; PG8_LDA(At, 1, 0); PG8_STAGE(PG8_SA(0, 1), a2 + hstep, voffA);
            PG8_WAIT_V(8); PG8_WAIT_L(0); PG8_BAR; PG8_MMA(0, 0, At, B0); PG8_MMA(0, 1, At, B1); PG8_BAR; PG8_SCHED;
            PG8_LDA(At, 1, 1); PG8_STAGE(PG8_SB(1, 0), b3, voffB); PG8_STAGE(PG8_SB(1, 1), b3 + hstep, voffB); PG8_STAGE(PG8_SA(1, 0), a3, voffA);
            PG8_WAIT_V(8); PG8_WAIT_L(0); PG8_BAR; PG8_MMA(1, 0, At, B0); PG8_MMA(1, 1, At, B1); PG8_BAR; PG8_SCHED;
        }
        if (wr == 0) PG8_BAR;
        E(acc, cur, wr, wc, fr, fq);
        if (!has_next) break;
#pragma unroll
        for (int a = 0; a < 2; ++a)
#pragma unroll
            for (int b = 0; b < 2; ++b)
#pragma unroll
                for (int m = 0; m < 4; ++m)
#pragma unroll
                    for (int n = 0; n < 2; ++n) acc[a][b][m][n] = (f32x4){0.f, 0.f, 0.f, 0.f};
        cur = nxt; cA = nA; cB = nB; ++ui;
        if (wr == 1) PG8_BAR;
    }
    PG8_WAIT_V(0);
    PG8_BAR;
#undef PG8_SA
#undef PG8_SB
#undef PG8_STAGE
#undef PG8_LDA
#undef PG8_LDB
#undef PG8_MMA
#undef PG8_WAIT_V
#undef PG8_WAIT_L
#undef PG8_BAR
#undef PG8_SCHED
}
}

constexpr int TOK = 16384, DM = 2048, SEQL = 4096, FFD = 8192, PLE = 256;
constexpr int INC = 6672, INP = 6912, PJ = 6656;
constexpr int C_U = 0, C_V = 512, C_GB = 1024, C_GC = 1536, C_XI = 2048, C_Q = 2560, C_Z = 5632;
constexpr float EPSF = 1e-6f;
constexpr int NTHREADS = 512, NWAVES = 8;
constexpr int LDS_BYTES = 163840;

constexpr size_t WS_AB = 0;
constexpr size_t WS_GL = 1048576;
constexpr size_t WS_WIN = 2097152;
constexpr size_t WS_WO = WS_WIN + (size_t)INP * DM * 2;
constexpr size_t WS_W1 = WS_WO + (size_t)DM * DM * 2;
constexpr size_t WS_W2 = WS_W1 + (size_t)FFD * DM * 2;
constexpr size_t WS_WG = WS_W2 + (size_t)FFD * DM * 2;
constexpr size_t WS_WP = WS_WG + (size_t)DM * DM * 2;
constexpr size_t WS_P16 = WS_WP + (size_t)DM * PLE * 2;
constexpr size_t WS_XN = WS_P16 + (size_t)TOK * PLE * 2;
constexpr size_t WS_BIG = WS_XN + (size_t)TOK * DM * 2;
constexpr size_t WS_GDN = WS_BIG + (size_t)TOK * FFD * 2;
constexpr size_t GDN_ITEM = 73728;
constexpr size_t WS_END = WS_GDN + 2048 * GDN_ITEM;

struct Args {
    const float *x, *p, *norm_mix, *w_in, *sg_ln_g, *sg_ln_b, *sg_w, *sg_b, *sc_conv, *gdn_conv, *gdn_a_log, *gdn_dt_bias, *gdn_norm,
        *out_norm_a, *out_norm_b, *w_o, *norm_ffn, *w_ff1, *w_ff2, *norm_ple, *w_ple_gate, *w_ple_proj, *norm_final;
    float* out; unsigned char* ws; int ph_lo, ph_hi, coop, pad;
};

__device__ __forceinline__ unsigned pk2(float lo, float hi) { return pg8::cvt_pk_bf16(lo, hi); }
__device__ __forceinline__ float bf2f(unsigned short v) { return __uint_as_float((unsigned)v << 16); }
__device__ __forceinline__ float bflo(unsigned w) { return __uint_as_float(w << 16); }
__device__ __forceinline__ float bfhi(unsigned w) { return __uint_as_float(w & 0xffff0000u); }
__device__ __forceinline__ float wave_sum(float v) {
#pragma unroll
    for (int o = 1; o < 64; o <<= 1) v += __shfl_xor(v, o);
    return v;
}
__device__ __forceinline__ float sigmoidf_(float x) { return __builtin_amdgcn_rcpf(1.0f + __expf(-x)); }
__device__ __forceinline__ float gelu_tanh(float x) { const float y = 1.5957691216057308f * x * (1.0f + 0.044715f * x * x); return x / (1.0f + __expf(-y)); }
__device__ __forceinline__ bf16x8 pack8(const f32x4 a, const f32x4 b) {
    u32x4 w; w.x = pk2(a[0], a[1]); w.y = pk2(a[2], a[3]); w.z = pk2(b[0], b[1]); w.w = pk2(b[2], b[3]);
    return __builtin_bit_cast(bf16x8, w);
}
__device__ __forceinline__ void unpack8(const u32x4 w, float (&v)[8]) { v[0] = bflo(w.x); v[1] = bfhi(w.x); v[2] = bflo(w.y); v[3] = bfhi(w.y); v[4] = bflo(w.z); v[5] = bfhi(w.z); v[6] = bflo(w.w); v[7] = bfhi(w.w); }
__host__ __device__ __forceinline__ int kperm(int d) { return (d & ~31) + 8 * ((d >> 2) & 3) + 4 * ((d >> 4) & 1) + (d & 3); }
#define LDS_WAIT() asm volatile("s_waitcnt lgkmcnt(0)" ::: "memory")
#define LBAR() do { asm volatile("s_waitcnt lgkmcnt(0)" ::: "memory"); __builtin_amdgcn_s_barrier(); asm volatile("" ::: "memory"); } while (0)

#define EPI_LOOP_BEGIN  _Pragma("unroll") for (int ai = 0; ai < 2; ++ai) _Pragma("unroll") for (int m = 0; m < 4; ++m) { const int row = u.pm * 256 + ai * 128 + wr * 64 + m * 16 + fr; \
                        _Pragma("unroll") for (int bj = 0; bj < 2; ++bj) { const int col = u.pn * 256 + bj * 128 + wc * 32 + 8 * fq; f32x4 v0 = acc[ai][bj][m][0], v1 = acc[ai][bj][m][1];
#define EPI_LOOP_END    } }
#define EPI_ARGS const f32x4 (&acc)[2][2][4][2], const pg8::Unit& u, int wr, int wc, int fr, int fq

constexpr float STAT_SCALE = 1048576.0f;
__device__ __forceinline__ float rstd_of(const unsigned long long* ss, int row) { return 1.0f / sqrtf((float)ss[row] * (1.0f / (STAT_SCALE * DM)) + EPSF); }
struct EpiProj {
    bf16_t* P; float* AB; const unsigned long long* ss;
    __device__ __forceinline__ void operator()(EPI_ARGS) const {
        if (u.pn < 26) {
            const bool act = u.pn < 4;
#pragma unroll
            for (int ai = 0; ai < 2; ++ai)
#pragma unroll
                for (int m = 0; m < 4; ++m) { const int row = u.pm * 256 + ai * 128 + wr * 64 + m * 16 + fr; const float rs = rstd_of(ss, row);
#pragma unroll
                    for (int bj = 0; bj < 2; ++bj) { const int col = u.pn * 256 + bj * 128 + wc * 32 + 8 * fq; f32x4 v0 = acc[ai][bj][m][0] * rs, v1 = acc[ai][bj][m][1] * rs;
                        if (act) {
#pragma unroll
                            for (int e = 0; e < 4; ++e) { v0[e] = gelu_tanh(v0[e]); v1[e] = gelu_tanh(v1[e]); }
                        }
                        u32x4 w; w.x = pk2(v0[0], v0[1]); w.y = pk2(v0[2], v0[3]); w.z = pk2(v1[0], v1[1]); w.w = pk2(v1[2], v1[3]);
                        *(u32x4*)(P + (size_t)row * PJ + col) = w; } }
        } else {
            if (wc == 0 && fq < 2) {
#pragma unroll
                for (int ai = 0; ai < 2; ++ai)
#pragma unroll
                    for (int m = 0; m < 4; ++m) { const int row = u.pm * 256 + ai * 128 + wr * 64 + m * 16 + fr; const float rs = rstd_of(ss, row);
                        *(f32x4*)(AB + (size_t)row * 16 + 8 * fq) = acc[ai][0][m][0] * rs; *(f32x4*)(AB + (size_t)row * 16 + 8 * fq + 4) = acc[ai][0][m][1] * rs; }
            }
        }
    }
};
#define RES_TAIL(o0, o1) do { \
        u32x4 w_; w_.x = pk2((o0)[0], (o0)[1]); w_.y = pk2((o0)[2], (o0)[3]); w_.z = pk2((o1)[0], (o1)[1]); w_.w = pk2((o1)[2], (o1)[3]); *(u32x4*)(HB + off) = w_; \
        sq += ((o0)[0] * (o0)[0] + (o0)[1] * (o0)[1]) + ((o0)[2] * (o0)[2] + (o0)[3] * (o0)[3]) + ((o1)[0] * (o1)[0] + (o1)[1] * (o1)[1]) + ((o1)[2] * (o1)[2] + (o1)[3] * (o1)[3]); } while (0)
#define RES_STAT() do { sq += __shfl_xor(sq, 16); sq += __shfl_xor(sq, 32); if (fq == 0) atomicAdd(stat + row, (unsigned long long)(sq * STAT_SCALE)); } while (0)
template <bool BASE_F32> struct EpiRes {
    const float* basef; const bf16_t* baseb; bf16_t* HB; unsigned long long* stat;
    __device__ __forceinline__ void operator()(EPI_ARGS) const {
#pragma unroll
        for (int ai = 0; ai < 2; ++ai)
#pragma unroll
            for (int m = 0; m < 4; ++m) { const int row = u.pm * 256 + ai * 128 + wr * 64 + m * 16 + fr; float sq = 0.f;
#pragma unroll
                for (int bj = 0; bj < 2; ++bj) { const int col = u.pn * 256 + bj * 128 + wc * 32 + 8 * fq; const size_t off = (size_t)row * DM + col;
                    f32x4 b0, b1;
                    if (BASE_F32) { b0 = *(const f32x4*)(basef + off); b1 = *(const f32x4*)(basef + off + 4); }
                    else { const u32x4 bw = *(const u32x4*)(baseb + off); b0 = (f32x4){bflo(bw.x), bfhi(bw.x), bflo(bw.y), bfhi(bw.y)}; b1 = (f32x4){bflo(bw.z), bfhi(bw.z), bflo(bw.w), bfhi(bw.w)}; }
                    const f32x4 o0 = b0 + acc[ai][bj][m][0], o1 = b1 + acc[ai][bj][m][1];
                    RES_TAIL(o0, o1); }
                RES_STAT(); }
    }
};
struct EpiRelu2 {
    bf16_t* O; const unsigned long long* ss;
    __device__ __forceinline__ void operator()(EPI_ARGS) const {
#pragma unroll
        for (int ai = 0; ai < 2; ++ai)
#pragma unroll
            for (int m = 0; m < 4; ++m) { const int row = u.pm * 256 + ai * 128 + wr * 64 + m * 16 + fr; const float rs = rstd_of(ss, row);
#pragma unroll
                for (int bj = 0; bj < 2; ++bj) { const int col = u.pn * 256 + bj * 128 + wc * 32 + 8 * fq; f32x4 v0 = acc[ai][bj][m][0] * rs, v1 = acc[ai][bj][m][1] * rs;
#pragma unroll
                    for (int e = 0; e < 4; ++e) { const float a = fmaxf(v0[e], 0.f), b = fmaxf(v1[e], 0.f); v0[e] = a * a; v1[e] = b * b; }
                    u32x4 w; w.x = pk2(v0[0], v0[1]); w.y = pk2(v0[2], v0[3]); w.z = pk2(v1[0], v1[1]); w.w = pk2(v1[2], v1[3]);
                    *(u32x4*)(O + (size_t)row * FFD + col) = w; } }
    }
};
struct EpiPlain {
    bf16_t* O;
    __device__ __forceinline__ void operator()(EPI_ARGS) const {
        EPI_LOOP_BEGIN
            u32x4 w; w.x = pk2(v0[0], v0[1]); w.y = pk2(v0[2], v0[3]); w.z = pk2(v1[0], v1[1]); w.w = pk2(v1[2], v1[3]);
            *(u32x4*)(O + (size_t)row * DM + col) = w;
        EPI_LOOP_END
    }
};
__device__ __forceinline__ float fsig(float x) { return __builtin_amdgcn_rcpf(1.0f + __expf(-x)); }
struct EpiGate {
    const bf16_t* PP; const bf16_t* baseb; const unsigned long long* ss; bf16_t* HB; unsigned long long* stat;
    __device__ __forceinline__ void operator()(EPI_ARGS) const {
#pragma unroll
        for (int ai = 0; ai < 2; ++ai)
#pragma unroll
            for (int m = 0; m < 4; ++m) { const int row = u.pm * 256 + ai * 128 + wr * 64 + m * 16 + fr; const float rs = rstd_of(ss, row); float sq = 0.f;
#pragma unroll
                for (int bj = 0; bj < 2; ++bj) { const int col = u.pn * 256 + bj * 128 + wc * 32 + 8 * fq; const size_t off = (size_t)row * DM + col;
                    const f32x4 v0 = acc[ai][bj][m][0] * rs, v1 = acc[ai][bj][m][1] * rs;
                    const u32x4 pw = *(const u32x4*)(PP + off);
                    const u32x4 bw = *(const u32x4*)(baseb + off);
                    f32x4 o0, o1;
                    o0[0] = bflo(bw.x) + bflo(pw.x) * fsig(v0[0]); o0[1] = bfhi(bw.x) + bfhi(pw.x) * fsig(v0[1]);
                    o0[2] = bflo(bw.y) + bflo(pw.y) * fsig(v0[2]); o0[3] = bfhi(bw.y) + bfhi(pw.y) * fsig(v0[3]);
                    o1[0] = bflo(bw.z) + bflo(pw.z) * fsig(v1[0]); o1[1] = bfhi(bw.z) + bfhi(pw.z) * fsig(v1[1]);
                    o1[2] = bflo(bw.w) + bflo(pw.w) * fsig(v1[2]); o1[3] = bfhi(bw.w) + bfhi(pw.w) * fsig(v1[3]);
                    RES_TAIL(o0, o1); }
                RES_STAT(); }
    }
};

__device__ __forceinline__ void transpose_item(const float* W, int K, int N, int Npad, bf16_t* WT, LAS float* scr, int item, int lane, const float* gain = nullptr) {
    const int nblk = Npad / 32, kb = item / nblk, nb = item % nblk, k0 = 64 * kb, n0 = 32 * nb;
    const int nn = n0 + (lane & 31); const bool ok = nn < N;
#pragma unroll 8
    for (int i = 0; i < 32; ++i) { const int kk = 2 * i + (lane >> 5); scr[kk * 33 + (lane & 31)] = ok ? W[(size_t)(k0 + kk) * N + nn] * (gain ? gain[k0 + kk] : 1.0f) : 0.f; }
    LDS_WAIT(); asm volatile("" ::: "memory");
    const int c = lane & 7;
#pragma unroll
    for (int j = 0; j < 4; ++j) { const int n = (lane >> 3) + 8 * j; const LAS float* s = scr + (8 * c) * 33 + n;
        u32x4 o; o.x = pk2(s[0 * 33], s[1 * 33]); o.y = pk2(s[2 * 33], s[3 * 33]); o.z = pk2(s[4 * 33], s[5 * 33]); o.w = pk2(s[6 * 33], s[7 * 33]);
        *(u32x4*)(WT + (size_t)(n0 + n) * K + k0 + 8 * c) = o; }
    LDS_WAIT(); asm volatile("" ::: "memory");
}
struct TrDesc { const float* W; bf16_t* WT; const float* gain; int K, N, Npad; };
__device__ __forceinline__ void tr_issue(const TrDesc& d, int item, int lane, LAS unsigned char* tile) {
    const int nblk = d.Npad / 32, kb = item / nblk, nb = item % nblk, k0 = 64 * kb, n0 = 32 * nb;
    int nn = n0 + (lane & 7) * 4; nn = nn < d.N - 4 ? nn : d.N - 4;
    const float* g = d.W + (size_t)(k0 + (lane >> 3)) * d.N + nn;
#pragma unroll
    for (int i = 0; i < 8; ++i)
        __builtin_amdgcn_global_load_lds((const unsigned*)(g + (size_t)(8 * i) * d.N), (LAS unsigned*)(tile + i * 1024), 16, 0, 0);
}
__device__ __forceinline__ void tr_process(const TrDesc& d, int item, int lane, const LAS unsigned char* tile) {
    const int nblk = d.Npad / 32, kb = item / nblk, nb = item % nblk, k0 = 64 * kb, n0 = 32 * nb;
    const int c = lane & 7; const LAS float* t = (const LAS float*)tile;
    float gk[8];
#pragma unroll
    for (int e = 0; e < 8; ++e) gk[e] = d.gain ? d.gain[k0 + 8 * c + e] : 1.0f;
#pragma unroll
    for (int j = 0; j < 4; ++j) { const int n = (lane >> 3) + 8 * j; const LAS float* s = t + (8 * c) * 32 + n; const bool ok = n0 + n < d.N;
        float v[8];
#pragma unroll
        for (int e = 0; e < 8; ++e) v[e] = ok ? s[e * 32] * gk[e] : 0.f;
        u32x4 o; o.x = pk2(v[0], v[1]); o.y = pk2(v[2], v[3]); o.z = pk2(v[4], v[5]); o.w = pk2(v[6], v[7]);
        *(u32x4*)(d.WT + (size_t)(n0 + n) * d.K + k0 + 8 * c) = o; }
    LDS_WAIT(); asm volatile("" ::: "memory");
}
__device__ __forceinline__ void rms_row_bf16(const float* xrow, const float* g, bf16_t* orow, int lane) {
    const f32x4* xr = (const f32x4*)xrow + lane; const f32x4* gr = (const f32x4*)g + lane;
    f32x4 v[8]; float s = 0.f;
#pragma unroll
    for (int j = 0; j < 8; ++j) { v[j] = xr[64 * j]; s += (v[j][0] * v[j][0] + v[j][1] * v[j][1]) + (v[j][2] * v[j][2] + v[j][3] * v[j][3]); }
    const float rstd = 1.0f / sqrtf(wave_sum(s) * (1.0f / DM) + EPSF);
    u32x2* o8 = (u32x2*)orow + lane;
#pragma unroll
    for (int j = 0; j < 8; ++j) { const f32x4 gg = gr[64 * j]; u32x2 w; w.x = pk2(v[j][0] * rstd * gg[0], v[j][1] * rstd * gg[1]); w.y = pk2(v[j][2] * rstd * gg[2], v[j][3] * rstd * gg[3]); o8[64 * j] = w; }
}
__device__ __forceinline__ void row_cast_stat(const float* xrow, bf16_t* orow, unsigned long long* ss, int lane) {
    const f32x4* xr = (const f32x4*)xrow + lane; f32x4 v[8]; float s = 0.f;
#pragma unroll
    for (int j = 0; j < 8; ++j) { v[j] = xr[64 * j]; s += (v[j][0] * v[j][0] + v[j][1] * v[j][1]) + (v[j][2] * v[j][2] + v[j][3] * v[j][3]); }
    s = wave_sum(s);
    u32x2* o8 = (u32x2*)orow + lane;
#pragma unroll
    for (int j = 0; j < 8; ++j) { u32x2 w; w.x = pk2(v[j][0], v[j][1]); w.y = pk2(v[j][2], v[j][3]); o8[64 * j] = w; }
    if (lane == 0) *ss = (unsigned long long)(s * STAT_SCALE);
}
__device__ __forceinline__ void row_scale_f32(const float* xrow, const float* g, float ss, float* orow, int lane) {
    const f32x4* xr = (const f32x4*)xrow + lane; const f32x4* gr = (const f32x4*)g + lane; f32x4* o = (f32x4*)orow + lane;
    const float rstd = 1.0f / sqrtf(ss * (1.0f / DM) + EPSF);
#pragma unroll
    for (int j = 0; j < 8; ++j) { const f32x4 v = xr[64 * j], gg = gr[64 * j]; o[64 * j] = v * rstd * gg; }
}
__device__ __forceinline__ void row_scale_from_bf16(const bf16_t* hrow, const float* g, float ss, float* orow, int lane) {
    const u32x2* hr = (const u32x2*)hrow + lane; const f32x4* gr = (const f32x4*)g + lane; f32x4* o = (f32x4*)orow + lane;
    const float rstd = 1.0f / sqrtf(ss * (1.0f / DM) + EPSF);
#pragma unroll
    for (int j = 0; j < 8; ++j) { const u32x2 w = hr[64 * j]; const f32x4 gg = gr[64 * j]; o[64 * j] = (f32x4){bflo(w.x), bfhi(w.x), bflo(w.y), bfhi(w.y)} * rstd * gg; }
}
__device__ __forceinline__ void rms_row_f32(const float* xrow, const float* g, float* orow, int lane) {
    const f32x4* xr = (const f32x4*)xrow + lane; const f32x4* gr = (const f32x4*)g + lane;
    f32x4 v[8]; float s = 0.f;
#pragma unroll
    for (int j = 0; j < 8; ++j) { v[j] = xr[64 * j]; s += (v[j][0] * v[j][0] + v[j][1] * v[j][1]) + (v[j][2] * v[j][2] + v[j][3] * v[j][3]); }
    const float rstd = 1.0f / sqrtf(wave_sum(s) * (1.0f / DM) + EPSF);
    f32x4* o = (f32x4*)orow + lane;
#pragma unroll
    for (int j = 0; j < 8; ++j) { const f32x4 gg = gr[64 * j]; o[64 * j] = v[j] * rstd * gg; }
}

__device__ __forceinline__ void gdn_decay_table(LAS float* tab, int item, const float* AB, const float* a_log, const float* dt_bias, int lane) {
    const int n = item & 63, bh = item >> 6, h = bh & 7, b = bh >> 3; const size_t tok = (size_t)b * SEQL + n * 64 + lane;
    const float a = AB[tok * 16 + h], bb = AB[tok * 16 + 8 + h];
    const float xs = a + dt_bias[h];
    const float sp = xs > 20.f ? xs : log1pf(__expf(xs));
    float c = -__expf(a_log[h]) * sp;
#pragma unroll
    for (int o = 1; o < 64; o <<= 1) { const float t = __shfl_up(c, o); if (lane >= o) c += t; }
    tab[lane] = c; tab[64 + lane] = sigmoidf_(bb); tab[128 + lane] = __expf(c);
}
__device__ __forceinline__ void gdn_chunk_item(LAS unsigned char* L, int item, const bf16_t* P, const float* AB, const float* convw, const float* a_log, const float* dt_bias,
                                               unsigned char* GDN, float* GL, int tid_in, int next_item, int par, bool first) {
    int tid = tid_in; asm volatile("" : "+v"(tid));
    const int n = item & 63, bh = item >> 6, h = bh & 7, b = bh >> 3;
    const int tok0 = b * SEQL + n * 64;
    const int wave = tid >> 6, lane = tid & 63, q4 = lane >> 4, c15 = lane & 15;
    LAS bf16_t* Kb = (LAS bf16_t*)(L);
    LAS bf16_t* Qb = (LAS bf16_t*)(L + 17408);
    LAS float* Af = (LAS float*)(L + 34816);
    LAS float* X = (LAS float*)(L + 51200);
    LAS float* gcs = (LAS float*)(L + 116736) + par * 256;
    LAS float* bts = gcs + 64;
    LAS float* egc = gcs + 128;
    unsigned char* gbase = GDN + (size_t)item * GDN_ITEM;
    bf16_t* g_qexp = (bf16_t*)gbase; bf16_t* g_kcd = (bf16_t*)(gbase + 16384); bf16_t* g_ktT = (bf16_t*)(gbase + 32768);
    bf16_t* g_valT = (bf16_t*)(gbase + 49152); bf16_t* g_intra = (bf16_t*)(gbase + 65536);

    const int cgi = tid % 48, seg = tid / 48, which = cgi >> 4, cc = (cgi & 15) * 8;
    const int col = C_Q + which * 1024 + h * 128 + cc;
    u32x4 raw[11];
    if (wave < 6) {
#pragma unroll
        for (int i = 0; i < 11; ++i) { const int r = seg * 8 - 3 + i;
            if (n * 64 + r >= 0) raw[i] = *(const u32x4*)(P + (size_t)(tok0 + r) * PJ + col); else raw[i] = (u32x4){0u, 0u, 0u, 0u}; }
    }
    if (first) { if (wave == 0) gdn_decay_table(gcs, item, AB, a_log, dt_bias, lane); LBAR(); }
    if (wave < 6) {
        float w[4][8];
#pragma unroll
        for (int j = 0; j < 4; ++j) { const f32x4 a = *(const f32x4*)(convw + j * 3072 + which * 1024 + h * 128 + cc), bq = *(const f32x4*)(convw + j * 3072 + which * 1024 + h * 128 + cc + 4);
            w[j][0] = a[0]; w[j][1] = a[1]; w[j][2] = a[2]; w[j][3] = a[3]; w[j][4] = bq[0]; w[j][5] = bq[1]; w[j][6] = bq[2]; w[j][7] = bq[3]; }
        float x0[8], x1[8], x2[8], x3[8];
        auto ldrow = [&](int i, float (&dst)[8]) { const u32x4 v = raw[i];
            dst[0] = bflo(v.x); dst[1] = bfhi(v.x); dst[2] = bflo(v.y); dst[3] = bfhi(v.y); dst[4] = bflo(v.z); dst[5] = bfhi(v.z); dst[6] = bflo(v.w); dst[7] = bfhi(v.w); };
        ldrow(0, x0); ldrow(1, x1); ldrow(2, x2);
#pragma unroll
        for (int i = 0; i < 8; ++i) {
            const int t = seg * 8 + i;
            ldrow(i + 3, x3);
            float y[8]; float ss = 0.f;
#pragma unroll
            for (int e = 0; e < 8; ++e) { const float c = w[0][e] * x0[e] + w[1][e] * x1[e] + w[2][e] * x2[e] + w[3][e] * x3[e]; y[e] = c * sigmoidf_(c); ss += y[e] * y[e]; }
            ss += __shfl_xor(ss, 1); ss += __shfl_xor(ss, 2); ss += __shfl_xor(ss, 4); ss += __shfl_xor(ss, 8);
            const float rn = __builtin_amdgcn_rsqf(ss + EPSF);
            const float bt = bts[t], eg = egc[t];
            if (which == 0) {
                const float s = rn * 0.08838834764831845f;
                u32x4 o; o.x = pk2(y[0] * s, y[1] * s); o.y = pk2(y[2] * s, y[3] * s); o.z = pk2(y[4] * s, y[5] * s); o.w = pk2(y[6] * s, y[7] * s);
                *(LAS u32x4*)(Qb + t * 136 + cc) = o;
            } else if (which == 1) {
                u32x4 o; o.x = pk2(y[0] * rn, y[1] * rn); o.y = pk2(y[2] * rn, y[3] * rn); o.z = pk2(y[4] * rn, y[5] * rn); o.w = pk2(y[6] * rn, y[7] * rn);
                *(LAS u32x4*)(Kb + t * 136 + cc) = o;
                const float s = rn * bt * eg;
                *(LAS f32x4*)(X + t * 256 + 128 + cc) = (f32x4){y[0] * s, y[1] * s, y[2] * s, y[3] * s};
                *(LAS f32x4*)(X + t * 256 + 128 + cc + 4) = (f32x4){y[4] * s, y[5] * s, y[6] * s, y[7] * s};
            } else {
                *(LAS f32x4*)(X + t * 256 + cc) = (f32x4){y[0] * bt, y[1] * bt, y[2] * bt, y[3] * bt};
                *(LAS f32x4*)(X + t * 256 + cc + 4) = (f32x4){y[4] * bt, y[5] * bt, y[6] * bt, y[7] * bt};
            }
#pragma unroll
            for (int e = 0; e < 8; ++e) { x0[e] = x1[e]; x1[e] = x2[e]; x2[e] = x3[e]; }
            __builtin_amdgcn_sched_barrier(0);
        }
    }
    LBAR();
    {
        const int ti = wave >> 1;
        bf16x8 ak[4], aq[4];
#pragma unroll
        for (int kb = 0; kb < 4; ++kb) { ak[kb] = *(const LAS bf16x8*)(Kb + (16 * ti + c15) * 136 + 32 * kb + 8 * q4); aq[kb] = *(const LAS bf16x8*)(Qb + (16 * ti + c15) * 136 + 32 * kb + 8 * q4); }
#pragma unroll
        for (int jj = 0; jj < 2; ++jj) {
            const int tj = 2 * (wave & 1) + jj;
            f32x4 dk = (f32x4){0.f, 0.f, 0.f, 0.f}, dq = (f32x4){0.f, 0.f, 0.f, 0.f};
#pragma unroll
            for (int kb = 0; kb < 4; ++kb) { const bf16x8 bk = *(const LAS bf16x8*)(Kb + (16 * tj + c15) * 136 + 32 * kb + 8 * q4);
                dk = __builtin_amdgcn_mfma_f32_16x16x32_bf16(bk, ak[kb], dk, 0, 0, 0); dq = __builtin_amdgcn_mfma_f32_16x16x32_bf16(bk, aq[kb], dq, 0, 0, 0); }
            const int i = 16 * ti + c15; const float gi = gcs[i], bi = bts[i];
            f32x4 av; u32x2 iw; float dv[4];
#pragma unroll
            for (int r = 0; r < 4; ++r) { const int j = 16 * tj + 4 * q4 + r;
                const float dec = (j <= i) ? __expf(fminf(gi - gcs[j], 0.f)) : 0.f;
                av[r] = (j < i) ? bi * dk[r] * dec : 0.f; dv[r] = dq[r] * dec; }
            *(LAS f32x4*)(Af + i * 64 + 16 * tj + 4 * q4) = av;
            iw.x = pk2(dv[0], dv[1]); iw.y = pk2(dv[2], dv[3]);
            *(u32x2*)(g_intra + i * 64 + kperm(16 * tj + 4 * q4)) = iw;
        }
    }
    LBAR();
    int tid2 = tid; asm volatile("" : "+v"(tid2));
    if (tid2 < 256) {
        const int c = tid2;
        float x[64];
        f32x4 arA[2][4], arB[12]; float xin[2];
        xin[0] = X[c]; xin[1] = X[256 + c]; arA[1][0] = *(const LAS f32x4*)(Af + 64);
#pragma unroll
        for (int i = 0; i < 64; ++i) {
            if (i >= 1 && i + 1 < 64) {
#pragma unroll
                for (int qd = 0; qd < ((i + 4) / 4 < 4 ? (i + 4) / 4 : 4); ++qd) arA[(i + 1) & 1][qd] = *(const LAS f32x4*)(Af + (i + 1) * 64 + 4 * qd);
                xin[(i + 1) & 1] = X[(i + 1) * 256 + c];
            }
            if (i > 16) {
#pragma unroll
                for (int qd = 4; qd < (i + 3) / 4; ++qd) arB[qd - 4] = *(const LAS f32x4*)(Af + i * 64 + 4 * qd);
            }
            __builtin_amdgcn_sched_barrier(0);
            float a0 = xin[i & 1], a1 = 0.f;
#pragma unroll
            for (int j = 0; j < (i < 16 ? i : 16); ++j) { if (j & 1) a1 -= arA[i & 1][j >> 2][j & 3] * x[j]; else a0 -= arA[i & 1][j >> 2][j & 3] * x[j]; }
#pragma unroll
            for (int j = 16; j < i; ++j) { if (j & 1) a1 -= arB[(j >> 2) - 4][j & 3] * x[j]; else a0 -= arB[(j >> 2) - 4][j & 3] * x[j]; }
            x[i] = a0 + a1;
            __builtin_amdgcn_sched_barrier(0);
        }
        if (c < 128) {
#pragma unroll
            for (int k = 0; k < 8; ++k) { u32x4 o; o.x = pk2(x[8 * k], x[8 * k + 1]); o.y = pk2(x[8 * k + 2], x[8 * k + 3]); o.z = pk2(x[8 * k + 4], x[8 * k + 5]); o.w = pk2(x[8 * k + 6], x[8 * k + 7]);
                *(u32x4*)(g_valT + c * 64 + 8 * k) = o; }
        } else {
            const int pd = kperm(c - 128); LAS bf16_t* Ks = (LAS bf16_t*)(L + 118784);
#pragma unroll
            for (int i = 0; i < 64; ++i) Ks[i * 128 + pd] = (bf16_t)(pk2(x[i], 0.f) & 0xffffu);
        }
    } else {
        const int t2 = tid2 - 256;
        {
            const int l = t2 >> 2, kb = t2 & 3; const float eg = egc[l];
#pragma unroll
            for (int k4 = 0; k4 < 4; ++k4) { float v[8];
#pragma unroll
                for (int e = 0; e < 8; ++e) { const int pos = 8 * k4 + e, qq = pos >> 3, jh = (pos >> 2) & 1, r = pos & 3; v[e] = bf2f(Qb[l * 136 + 32 * kb + 16 * jh + 4 * qq + r]) * eg; }
                u32x4 o; o.x = pk2(v[0], v[1]); o.y = pk2(v[2], v[3]); o.z = pk2(v[4], v[5]); o.w = pk2(v[6], v[7]);
                *(u32x4*)(g_qexp + l * 128 + 32 * kb + 8 * k4) = o; }
        }
        {
            const int d = t2 >> 1, kb2 = t2 & 1; const float glast = gcs[63];
#pragma unroll
            for (int k4 = 0; k4 < 4; ++k4) { float v[8];
#pragma unroll
                for (int e = 0; e < 8; ++e) { const int pos = 8 * k4 + e, qq = pos >> 3, jh = (pos >> 2) & 1, r = pos & 3; const int l = 32 * kb2 + 16 * jh + 4 * qq + r; v[e] = bf2f(Kb[l * 136 + d]) * __expf(glast - gcs[l]); }
                u32x4 o; o.x = pk2(v[0], v[1]); o.y = pk2(v[2], v[3]); o.z = pk2(v[4], v[5]); o.w = pk2(v[6], v[7]);
                *(u32x4*)(g_ktT + d * 64 + 32 * kb2 + 8 * k4) = o; }
        }
        if (t2 == 0) GL[item] = egc[63];
        if (t2 >= 192 && next_item < 2048) gdn_decay_table((LAS float*)(L + 116736) + (par ^ 1) * 256, next_item, AB, a_log, dt_bias, t2 - 192);
    }
    LBAR();
    {
        const LAS u32x4* ks = (const LAS u32x4*)(L + 118784); u32x4* gk = (u32x4*)g_kcd;
        gk[tid] = ks[tid]; gk[tid + 512] = ks[tid + 512];
    }
}

__device__ __forceinline__ void gdn_scan(LAS unsigned char* L, int id, const unsigned char* GDN, const float* GL, bf16_t* P, int tid) {
    const int bh = (id & 7) * 4 + (id >> 4), half = (id >> 3) & 1, h = bh & 7, b = bh >> 3;
    const int wave = tid >> 6, lane = tid & 63, q4 = lane >> 4, c15 = lane & 15;
    constexpr int BUF = 77824;
    LAS float* Lgl = (LAS float*)(L + 2 * BUF);
    if (wave >= 4) {
        const int tl = tid - 256;
        __builtin_amdgcn_s_setprio(3);
        if (tl < 64) Lgl[tl] = GL[bh * 64 + tl];
        u32x4 sa[16], sb[16];
#define LOADC(nn, R) do { const unsigned char* gb_ = GDN + (size_t)(bh * 64 + (nn)) * GDN_ITEM; \
            _Pragma("unroll") for (int k = 0; k < 12; ++k) R[k] = *(const u32x4*)(gb_ + (size_t)(tl + 256 * k) * 16); \
            R[12] = *(const u32x4*)(gb_ + 65536 + tl * 16); R[13] = *(const u32x4*)(gb_ + 65536 + (tl + 256) * 16); \
            R[14] = *(const u32x4*)(gb_ + 49152 + half * 8192 + tl * 16); R[15] = *(const u32x4*)(gb_ + 49152 + half * 8192 + (tl + 256) * 16); } while (0)
#define STOREC(LB_, R) do { \
            _Pragma("unroll") for (int k = 0; k < 8; ++k) { const int cc = tl + 256 * (k & 3); *(LAS u32x4*)((LB_) + (k >> 2) * 18432 + (cc >> 4) * 288 + (cc & 15) * 16) = R[k]; } \
            _Pragma("unroll") for (int k = 8; k < 12; ++k) { const int cc = tl + 256 * (k - 8); *(LAS u32x4*)((LB_) + 36864 + (cc >> 3) * 160 + (cc & 7) * 16) = R[k]; } \
            _Pragma("unroll") for (int k = 12; k < 14; ++k) { const int cc = tl + 256 * (k - 12); *(LAS u32x4*)((LB_) + 57344 + (cc >> 3) * 160 + (cc & 7) * 16) = R[k]; } \
            _Pragma("unroll") for (int k = 14; k < 16; ++k) { const int cc = tl + 256 * (k - 14); *(LAS u32x4*)((LB_) + 67584 + (cc >> 3) * 160 + (cc & 7) * 16) = R[k]; } } while (0)
        LOADC(0, sa); STOREC(L, sa);
        LOADC(1, sa); LOADC(2, sb);
        __syncthreads();
        for (int n = 0; n < 64; n += 2) {
            STOREC(L + BUF, sa);
            if (n + 3 < 64) LOADC(n + 3, sa);
            LBAR();
            if (n + 2 < 64) STOREC(L, sb);
            if (n + 4 < 64) LOADC(n + 4, sb);
            LBAR();
        }
#undef LOADC
#undef STOREC
        __builtin_amdgcn_s_setprio(0);
        return;
    }
    f32x4 S[8];
#pragma unroll
    for (int T = 0; T < 8; ++T) S[T] = (f32x4){0.f, 0.f, 0.f, 0.f};
    __syncthreads();
    for (int n = 0; n < 64; ++n) {
        LAS unsigned char* LB = L + (n & 1) * BUF;
        const float gl = Lgl[n];
        {
            LAS unsigned char* Lq = LB; LAS unsigned char* Lk = LB + 18432; LAS unsigned char* Lt = LB + 36864; LAS unsigned char* Li = LB + 57344; LAS unsigned char* Lv = LB + 67584;
            bf16x8 Sp[4];
#pragma unroll
            for (int kb = 0; kb < 4; ++kb) Sp[kb] = pack8(S[2 * kb], S[2 * kb + 1]);
            u32x2 vr[4];
#pragma unroll
            for (int t = 0; t < 4; ++t) vr[t] = *(const LAS u32x2*)(Lv + (16 * wave + c15) * 160 + (16 * t + 4 * q4) * 2);
            f32x4 pa[4], oo[4];
#pragma unroll
            for (int t = 0; t < 4; ++t) { pa[t] = (f32x4){0.f, 0.f, 0.f, 0.f}; oo[t] = (f32x4){0.f, 0.f, 0.f, 0.f}; }
            bf16x8 fk0[2][4], fq0[2][4], fk1[2][4], fq1[2][4];
#define LDKQ(FK, FQ, hh) do { _Pragma("unroll") for (int tt = 0; tt < 2; ++tt) _Pragma("unroll") for (int kb = 0; kb < 4; ++kb) { \
                FK[tt][kb] = *(const LAS bf16x8*)(Lk + (16 * (2 * (hh) + tt) + c15) * 288 + (32 * kb + 8 * q4) * 2); FQ[tt][kb] = *(const LAS bf16x8*)(Lq + (16 * (2 * (hh) + tt) + c15) * 288 + (32 * kb + 8 * q4) * 2); } } while (0)
#define MMKQ(FK, FQ, hh) do { _Pragma("unroll") for (int kb = 0; kb < 4; ++kb) _Pragma("unroll") for (int tt = 0; tt < 2; ++tt) { \
                pa[2 * (hh) + tt] = __builtin_amdgcn_mfma_f32_16x16x32_bf16(FK[tt][kb], Sp[kb], pa[2 * (hh) + tt], 0, 0, 0); oo[2 * (hh) + tt] = __builtin_amdgcn_mfma_f32_16x16x32_bf16(Sp[kb], FQ[tt][kb], oo[2 * (hh) + tt], 0, 0, 0); } } while (0)
            LDKQ(fk0, fq0, 0);
            __builtin_amdgcn_sched_barrier(0);
            LDKQ(fk1, fq1, 1);
            MMKQ(fk0, fq0, 0);
            __builtin_amdgcn_sched_barrier(0);
            bf16x8 fi[4][2], ft[4][2];
#pragma unroll
            for (int t = 0; t < 4; ++t)
#pragma unroll
                for (int kb = 0; kb < 2; ++kb) { fi[t][kb] = *(const LAS bf16x8*)(Li + (16 * t + c15) * 160 + (32 * kb + 8 * q4) * 2); ft[t][kb] = *(const LAS bf16x8*)(Lt + (16 * t + c15) * 160 + (32 * kb + 8 * q4) * 2); }
            MMKQ(fk1, fq1, 1);
            __builtin_amdgcn_sched_barrier(0);
#undef LDKQ
#undef MMKQ
            f32x4 Vn[4];
#pragma unroll
            for (int t = 0; t < 4; ++t) Vn[t] = (f32x4){bflo(vr[t].x), bfhi(vr[t].x), bflo(vr[t].y), bfhi(vr[t].y)} - pa[t];
            bf16x8 Vp[2];
            Vp[0] = pack8(Vn[0], Vn[1]); Vp[1] = pack8(Vn[2], Vn[3]);
            bf16x8 ft2[4][2];
#pragma unroll
            for (int t = 0; t < 4; ++t)
#pragma unroll
                for (int kb = 0; kb < 2; ++kb) ft2[t][kb] = *(const LAS bf16x8*)(Lt + (16 * (4 + t) + c15) * 160 + (32 * kb + 8 * q4) * 2);
#pragma unroll
            for (int T = 0; T < 4; ++T) S[T] = S[T] * gl;
#pragma unroll
            for (int kb = 0; kb < 2; ++kb)
#pragma unroll
                for (int t = 0; t < 4; ++t) { oo[t] = __builtin_amdgcn_mfma_f32_16x16x32_bf16(Vp[kb], fi[t][kb], oo[t], 0, 0, 0); S[t] = __builtin_amdgcn_mfma_f32_16x16x32_bf16(ft[t][kb], Vp[kb], S[t], 0, 0, 0); }
            __builtin_amdgcn_sched_barrier(0);
#pragma unroll
            for (int T = 4; T < 8; ++T) S[T] = S[T] * gl;
#pragma unroll
            for (int kb = 0; kb < 2; ++kb)
#pragma unroll
                for (int t = 0; t < 4; ++t) S[4 + t] = __builtin_amdgcn_mfma_f32_16x16x32_bf16(ft2[t][kb], Vp[kb], S[4 + t], 0, 0, 0);
            __builtin_amdgcn_sched_barrier(0);
            {
                bf16_t* ob = P + ((size_t)b * SEQL + n * 64 + c15) * PJ + C_Q + h * 128 + half * 64 + 16 * wave + 4 * q4;
#pragma unroll
                for (int t = 0; t < 4; ++t) { u32x2 w; w.x = pk2(oo[t][0], oo[t][1]); w.y = pk2(oo[t][2], oo[t][3]); *(u32x2*)(ob + (size_t)(16 * t) * PJ) = w; }
            }
        }
        LBAR();
    }
}
__device__ __forceinline__ void gdn_finalize(int item, const bf16_t* P, const float* gnorm, bf16_t* MIX, int lane) {
    const int tok = item >> 1, hq = item & 1, c = hq * 512 + lane * 8;
    float o[8], z[8];
    unpack8(*(const u32x4*)(P + (size_t)tok * PJ + C_Q + c), o);
    unpack8(*(const u32x4*)(P + (size_t)tok * PJ + C_Z + c), z);
    float ss = 0.f;
#pragma unroll
    for (int e = 0; e < 8; ++e) ss += o[e] * o[e];
    ss += __shfl_xor(ss, 1); ss += __shfl_xor(ss, 2); ss += __shfl_xor(ss, 4); ss += __shfl_xor(ss, 8);
    const float rstd = 1.0f / sqrtf(ss * (1.0f / 128.f) + EPSF);
    const f32x4 g0 = *(const f32x4*)(gnorm + (c & 127)), g1 = *(const f32x4*)(gnorm + (c & 127) + 4);
    float r[8];
#pragma unroll
    for (int e = 0; e < 8; ++e) { const float gg = e < 4 ? g0[e & 3] : g1[e & 3]; r[e] = o[e] * rstd * gg * (z[e] * __builtin_amdgcn_rcpf(1.0f + __expf(-z[e]))); }
    u32x4 w; w.x = pk2(r[0], r[1]); w.y = pk2(r[2], r[3]); w.z = pk2(r[4], r[5]); w.w = pk2(r[6], r[7]);
    *(u32x4*)(MIX + (size_t)tok * DM + 1024 + c) = w;
}

__device__ __forceinline__ void sgu_item(LAS unsigned char* L, int item, const bf16_t* P, const float* sgw, const float* sgb, const float* lng, const float* lnb, const float* ona, bf16_t* MIX, int tid) {
    const int h = item & 3, n = (item >> 2) & 31, b = item >> 7;
    const size_t tok0 = (size_t)b * SEQL + n * 128;
    const int wave = tid >> 6, lane = tid & 63, q4 = lane >> 4, c15 = lane & 15;
    LAS bf16_t* Wl = (LAS bf16_t*)L;
    LAS bf16_t* Vt = (LAS bf16_t*)(L + 34816);
    {
        const int t = tid >> 2, s0 = (tid & 3) * 32; const float* wr = sgw + (size_t)h * 16384 + t * 128 + s0;
#pragma unroll
        for (int k = 0; k < 4; ++k) { const f32x4 a = *(const f32x4*)(wr + 8 * k), c = *(const f32x4*)(wr + 8 * k + 4); float v[8] = {a[0], a[1], a[2], a[3], c[0], c[1], c[2], c[3]};
#pragma unroll
            for (int e = 0; e < 8; ++e) v[e] = (s0 + 8 * k + e <= t) ? v[e] : 0.f;
            u32x4 o; o.x = pk2(v[0], v[1]); o.y = pk2(v[2], v[3]); o.z = pk2(v[4], v[5]); o.w = pk2(v[6], v[7]);
            *(LAS u32x4*)(Wl + t * 136 + s0 + 8 * k) = o; }
    }
    {
        const int s = tid >> 2, d0 = (tid & 3) * 32; const bf16_t* vr = P + (tok0 + s) * PJ + C_V + h * 128 + d0;
        float v[32]; float sm = 0.f;
#pragma unroll
        for (int k = 0; k < 4; ++k) { const u32x4 w = *(const u32x4*)(vr + 8 * k); v[8 * k] = bflo(w.x); v[8 * k + 1] = bfhi(w.x); v[8 * k + 2] = bflo(w.y); v[8 * k + 3] = bfhi(w.y); v[8 * k + 4] = bflo(w.z); v[8 * k + 5] = bfhi(w.z); v[8 * k + 6] = bflo(w.w); v[8 * k + 7] = bfhi(w.w); }
#pragma unroll
        for (int e = 0; e < 32; ++e) sm += v[e];
        sm += __shfl_xor(sm, 1); sm += __shfl_xor(sm, 2);
        const float mu = sm * (1.0f / 128.f); float sq = 0.f;
#pragma unroll
        for (int e = 0; e < 32; ++e) { v[e] -= mu; sq += v[e] * v[e]; }
        sq += __shfl_xor(sq, 1); sq += __shfl_xor(sq, 2);
        const float rstd = 1.0f / sqrtf(sq * (1.0f / 128.f) + EPSF);
#pragma unroll
        for (int e = 0; e < 32; ++e) { const float y = v[e] * rstd * lng[h * 128 + d0 + e] + lnb[h * 128 + d0 + e]; Vt[(d0 + e) * 136 + s] = (bf16_t)(pk2(y, 0.f) & 0xffffu); }
    }
    __syncthreads();
    {
        f32x4 D[8];
#pragma unroll
        for (int tj = 0; tj < 8; ++tj) D[tj] = (f32x4){0.f, 0.f, 0.f, 0.f};
        const int nkb = (wave >> 1) + 1;
        for (int kb = 0; kb < nkb; ++kb) {
            const bf16x8 wv = *(const LAS bf16x8*)(Wl + (16 * wave + c15) * 136 + 32 * kb + 8 * q4);
#pragma unroll
            for (int tj = 0; tj < 8; ++tj) { const bf16x8 vv = *(const LAS bf16x8*)(Vt + (16 * tj + c15) * 136 + 32 * kb + 8 * q4); D[tj] = __builtin_amdgcn_mfma_f32_16x16x32_bf16(vv, wv, D[tj], 0, 0, 0); }
        }
        const int t = 16 * wave + c15; const float bias = sgb[h * 128 + t];
        const bf16_t* ur = P + (tok0 + t) * PJ + C_U + h * 128 + 4 * q4;
        u32x2 uw[8];
#pragma unroll
        for (int tj = 0; tj < 8; ++tj) uw[tj] = *(const u32x2*)(ur + 16 * tj);
        float ss = 0.f;
#pragma unroll
        for (int tj = 0; tj < 8; ++tj) { const f32x4 uu = (f32x4){bflo(uw[tj].x), bfhi(uw[tj].x), bflo(uw[tj].y), bfhi(uw[tj].y)}; const f32x4 y = uu * (D[tj] + bias); D[tj] = y; ss += (y[0] * y[0] + y[1] * y[1]) + (y[2] * y[2] + y[3] * y[3]); }
        ss += __shfl_xor(ss, 16); ss += __shfl_xor(ss, 32);
        const float rstd = __builtin_amdgcn_rsqf(ss * (1.0f / 128.f) + EPSF);
        bf16_t* orow = MIX + (tok0 + t) * DM + h * 128 + 4 * q4;
#pragma unroll
        for (int tj = 0; tj < 8; ++tj) { const f32x4 gg = *(const f32x4*)(ona + h * 128 + 16 * tj + 4 * q4); const f32x4 o = D[tj] * rstd * gg;
            u32x2 w; w.x = pk2(o[0], o[1]); w.y = pk2(o[2], o[3]); *(u32x2*)(orow + 16 * tj) = w; }
    }
    __syncthreads();
}

__device__ __forceinline__ void shortconv_token(int tok, const bf16_t* P, const float* scw, const float* onb, bf16_t* MIX, int lane) {
    const int c = lane * 8, pos = tok & (SEQL - 1);
    const bf16_t* row = P + (size_t)tok * PJ;
    float gb[8], acc[8];
    unpack8(*(const u32x4*)(row + C_GB + c), gb);
#pragma unroll
    for (int e = 0; e < 8; ++e) acc[e] = 0.f;
#pragma unroll
    for (int j = 0; j < 3; ++j) {
        const int back = 2 - j;
        if (pos - back >= 0) { float g[8], xi[8]; const bf16_t* r2 = row - (size_t)back * PJ;
            unpack8(*(const u32x4*)(r2 + C_GC + c), g); unpack8(*(const u32x4*)(r2 + C_XI + c), xi);
            const f32x4 w0 = *(const f32x4*)(scw + j * 512 + c), w1 = *(const f32x4*)(scw + j * 512 + c + 4);
#pragma unroll
            for (int e = 0; e < 4; ++e) { acc[e] += w0[e] * (g[e] * xi[e]); acc[4 + e] += w1[e] * (g[4 + e] * xi[4 + e]); } }
    }
    float ss = 0.f;
#pragma unroll
    for (int e = 0; e < 8; ++e) { acc[e] *= gb[e]; ss += acc[e] * acc[e]; }
    ss += __shfl_xor(ss, 1); ss += __shfl_xor(ss, 2); ss += __shfl_xor(ss, 4); ss += __shfl_xor(ss, 8);
    const float rstd = 1.0f / sqrtf(ss * (1.0f / 128.f) + EPSF);
    const f32x4 g0 = *(const f32x4*)(onb + c), g1 = *(const f32x4*)(onb + c + 4);
    u32x4 o; o.x = pk2(acc[0] * rstd * g0[0], acc[1] * rstd * g0[1]); o.y = pk2(acc[2] * rstd * g0[2], acc[3] * rstd * g0[3]);
    o.z = pk2(acc[4] * rstd * g1[0], acc[5] * rstd * g1[1]); o.w = pk2(acc[6] * rstd * g1[2], acc[7] * rstd * g1[3]);
    *(u32x4*)(MIX + (size_t)tok * DM + 512 + c) = o;
}


#define XB_TMO      128
#define XB_XCNT(j)  (256  + 64 * (j))
#define XB_XSUB(j)  (1280 + 64 * (j))
#define XB_XGEN(j)  (2304 + 64 * (j))
#define XB_TOP      3328
#define XB_TOPGEN   3392
#define XCD_BAR_WORDS 3456
#define XB_SPIN_CAP (1u << 22)
__device__ __forceinline__ unsigned xb_ld(unsigned* p)              { return __hip_atomic_load(p, __ATOMIC_RELAXED, __HIP_MEMORY_SCOPE_AGENT); }
__device__ __forceinline__ unsigned xb_add(unsigned* p, unsigned v) { return __hip_atomic_fetch_add(p, v, __ATOMIC_RELAXED, __HIP_MEMORY_SCOPE_AGENT); }
__device__ __forceinline__ unsigned xb_xcc_id() { return (unsigned)__builtin_amdgcn_s_getreg((3 << 11) | 20) & 0xFu; }
#define XB_SPIN(cond, bar) do { unsigned _sp = 0; while (cond) { __builtin_amdgcn_s_sleep(1); \
    if ((++_sp & 255u) == 0u) { if (xb_ld(&(bar)[XB_TMO])) break; if (_sp > XB_SPIN_CAP) { atomicAdd(&(bar)[XB_TMO], 1u); break; } } } } while (0)
struct XcdBarrier { unsigned* bar; unsigned x; volatile LAS unsigned* st; };
__device__ __forceinline__ XcdBarrier xcd_barrier_post(unsigned* bar, volatile LAS unsigned* st, int tid) {
    XcdBarrier b; b.bar = bar; b.x = xb_xcc_id(); b.st = st;
    if (tid == 0) (void)xb_add(&bar[XB_XCNT(b.x)], 1u);
    return b;
}
__device__ __forceinline__ void xcd_barrier_complete(unsigned* bar, unsigned x, unsigned& nloc, unsigned& nx) {
    const unsigned G = gridDim.x * gridDim.y * gridDim.z;
    unsigned sum, cnt, mine, sp = 0u;
    for (;;) {
        sum = 0u; cnt = 0u; mine = 0u;
#pragma unroll
        for (unsigned j = 0; j < 16; ++j) { const unsigned c = xb_ld(&bar[XB_XCNT(j)]); sum += c; cnt += (c > 0u) ? 1u : 0u; mine = (j == x) ? c : mine; }
        if (sum == G) break;
        __builtin_amdgcn_s_sleep(1);
        if ((++sp & 255u) == 0u) { if (xb_ld(&bar[XB_TMO])) break; if (sp > XB_SPIN_CAP) { atomicAdd(&bar[XB_TMO], 1u); break; } }
    }
    nloc = mine > 0u ? mine : 1u; nx = cnt > 0u ? cnt : 1u;
}
__device__ __forceinline__ void xcd_barrier(const XcdBarrier& b, int tid) {
    asm volatile("s_waitcnt vmcnt(0)" ::: "memory");
    __syncthreads();
    if (tid == 0) {
        unsigned* bar = b.bar;
        __builtin_amdgcn_s_waitcnt(0);
        unsigned nloc = b.st[0], nx = b.st[1];
        if (nloc == 0u) { xcd_barrier_complete(bar, b.x, nloc, nx); b.st[0] = nloc; b.st[1] = nx; }
        const unsigned old = xb_add(&bar[XB_XSUB(b.x)], 1u);
        const unsigned gen = old / nloc;
        if (old + 1u == (gen + 1u) * nloc) {
            __builtin_amdgcn_fence(__ATOMIC_RELEASE, "agent");
            asm volatile("s_waitcnt vmcnt(0)" ::: "memory");
            const unsigned og = xb_add(&bar[XB_TOP], 1u);
            const unsigned tg = og / nx;
            if (og + 1u == (tg + 1u) * nx) xb_add(&bar[XB_TOPGEN], 1u);
            else XB_SPIN(xb_ld(&bar[XB_TOPGEN]) == tg, bar);
            __builtin_amdgcn_fence(__ATOMIC_ACQUIRE, "agent");
            xb_add(&bar[XB_XGEN(b.x)], 1u);
            asm volatile("s_waitcnt vmcnt(0)" ::: "memory");
        } else {
            XB_SPIN(xb_ld(&bar[XB_XGEN(b.x)]) == gen, bar);
            __builtin_amdgcn_fence(__ATOMIC_ACQUIRE, "agent");
            asm volatile("s_waitcnt vmcnt(0)" ::: "memory");
        }
    }
    __syncthreads();
}
constexpr size_t WS_STATS = 1048576 + 131072;
constexpr size_t WS_TS = 1048576 + 98304;
constexpr size_t WS_BAR = 1048576 + 65536;
constexpr int LDS_MISC = 163840 - 64;

typedef const char __attribute__((address_space(4))) kchar_t;
#define KARG(field) (*(decltype(Args::field) const __attribute__((address_space(4)))*)(kp + offsetof(Args, field)))
#define MYTID() (wave0 * 64 + (int)__builtin_amdgcn_mbcnt_hi(~0u, __builtin_amdgcn_mbcnt_lo(~0u, 0u)))
#define PHASE_BEGIN int tid = MYTID(); asm volatile("" : "+v"(tid)); const int lane = tid & 63, wave = __builtin_amdgcn_readfirstlane(tid >> 6); \
    const int G = gridDim.x, bx = blockIdx.x, gw = bx * NWAVES + wave, NGW = G * NWAVES; (void)lane; (void)gw; (void)NGW; \
    kchar_t* kp = (kchar_t*)__builtin_amdgcn_kernarg_segment_ptr(); asm volatile("" : "+s"(kp)); \
    unsigned char* ws = KARG(ws); (void)ws; int l = lsel; asm volatile("" : "+s"(l));
#define WSP(T, off) ((T*)(ws + (off)))
__global__ void __launch_bounds__(NTHREADS, 2) hybrid_fwd(Args a) {
    extern __shared__ __attribute__((aligned(16))) unsigned char lds_raw[];
    LAS unsigned char* L = (LAS unsigned char*)lds_raw;
    const int lo = a.ph_lo, hi = a.ph_hi, coop = a.coop;
    const int wave0 = __builtin_amdgcn_readfirstlane(threadIdx.x >> 6);
    { const int t0 = MYTID(); if (t0 < 8) ((LAS unsigned*)(L + LDS_MISC))[t0] = 0u; }
    __syncthreads();
    XcdBarrier xbar; xbar.bar = (unsigned*)(a.ws + WS_BAR); xbar.x = 0; xbar.st = nullptr;
    if (coop) xbar = xcd_barrier_post((unsigned*)(a.ws + WS_BAR), (volatile LAS unsigned*)(L + LDS_MISC), MYTID());
    bool first_seam = (hi > 4096);
#ifdef PROBE_TS_MASK
    int nseam = 0;
    if (blockIdx.x == 0 && MYTID() == 0) ((unsigned long long*)(a.ws + WS_TS))[0] = __builtin_amdgcn_s_memrealtime();
#define STAMP() do { ++nseam; if (blockIdx.x == 0 && MYTID() == 0) ((unsigned long long*)(a.ws + WS_TS))[nseam] = __builtin_amdgcn_s_memrealtime(); } while (0)
#else
#define STAMP() do {} while (0)
#endif
#ifndef PH_MASK
#define PH_MASK 0xFFFFu
#endif
#define IN(k) (((PH_MASK >> ((k) >= 20 ? 10 : (k) % 10)) & 1u) && lo <= (k) && (k) < hi)
#ifndef PROBE_DUP
#define PROBE_DUP 0u
#endif
#define NREP(k) (1 + (int)((PROBE_DUP >> (k)) & 1u))
#ifndef PROBE_SYNC
#define PROBE_SYNC 1
#endif
#define SEAM_ALWAYS() SEAM()
#define SEAM() do { if (coop) { for (int s_ = 0; s_ < PROBE_SYNC; ++s_) { if (first_seam) { cg::this_grid().sync(); first_seam = false; } else xcd_barrier(xbar, MYTID()); } STAMP(); } else __syncthreads(); } while (0)

#pragma unroll 1
    for (int lsel = 0; lsel < 2; ++lsel) {
        const int pb = lsel * 10;
#define ST(ll, k) (WSP(unsigned long long, WS_STATS) + ((ll) * 4 + (k) - ((ll) ? 1 : 0)) * TOK)
#define HB_A WSP(bf16_t, WS_GDN)
#define HB_B WSP(bf16_t, WS_XN)
        if (IN(pb + 0)) for (int rep_ = 0; rep_ < NREP(0); ++rep_) { if (rep_) __syncthreads();
            PHASE_BEGIN
            constexpr int I_IN = 32 * (INP / 32), I_O = 32 * 64, I_1 = 32 * 256, I_2 = 128 * 64, I_G = 32 * 64, I_P = 4 * 64;
            constexpr int NITEMS = I_IN + I_O + I_1 + I_2 + I_G + I_P;
#define TR_DESC(it_, d_, loc_) do { int r_ = (it_); \
                if (r_ < I_IN) { d_.W = KARG(w_in) + (size_t)l * DM * INC; d_.WT = WSP(bf16_t, WS_WIN); d_.gain = KARG(norm_mix) + l * DM; d_.K = DM; d_.N = INC; d_.Npad = INP; loc_ = r_; break; } r_ -= I_IN; \
                if (r_ < I_O) { d_.W = KARG(w_o) + (size_t)l * DM * DM; d_.WT = WSP(bf16_t, WS_WO); d_.gain = nullptr; d_.K = DM; d_.N = DM; d_.Npad = DM; loc_ = r_; break; } r_ -= I_O; \
                if (r_ < I_1) { d_.W = KARG(w_ff1) + (size_t)l * DM * FFD; d_.WT = WSP(bf16_t, WS_W1); d_.gain = KARG(norm_ffn) + l * DM; d_.K = DM; d_.N = FFD; d_.Npad = FFD; loc_ = r_; break; } r_ -= I_1; \
                if (r_ < I_2) { d_.W = KARG(w_ff2) + (size_t)l * DM * FFD; d_.WT = WSP(bf16_t, WS_W2); d_.gain = nullptr; d_.K = FFD; d_.N = DM; d_.Npad = DM; loc_ = r_; break; } r_ -= I_2; \
                if (r_ < I_G) { d_.W = KARG(w_ple_gate) + (size_t)l * DM * DM; d_.WT = WSP(bf16_t, WS_WG); d_.gain = KARG(norm_ple) + l * DM; d_.K = DM; d_.N = DM; d_.Npad = DM; loc_ = r_; break; } r_ -= I_G; \
                d_.W = KARG(w_ple_proj) + (size_t)l * PLE * DM; d_.WT = WSP(bf16_t, WS_WP); d_.gain = nullptr; d_.K = PLE; d_.N = DM; d_.Npad = DM; loc_ = r_; } while (0)
            {
                LAS unsigned char* tl0 = L + wave * 16384; int it = gw, cur = 0, lc = 0, ln = 0; TrDesc dc, dn;
                if (it < NITEMS) { TR_DESC(it, dc, lc); tr_issue(dc, lc, lane, tl0); }
                while (it < NITEMS) {
                    const int it2 = it + NGW;
                    if (it2 < NITEMS) { TR_DESC(it2, dn, ln); tr_issue(dn, ln, lane, tl0 + (cur ^ 1) * 8192); asm volatile("s_waitcnt vmcnt(8)" ::: "memory"); }
                    else asm volatile("s_waitcnt vmcnt(0)" ::: "memory");
                    tr_process(dc, lc, lane, tl0 + cur * 8192);
                    dc = dn; lc = ln; it = it2; cur ^= 1;
                }
            }
#undef TR_DESC
            {
                const f32x4* src = (const f32x4*)(KARG(p) + (size_t)l * TOK * PLE); u32x2* dst = WSP(u32x2, WS_P16);
                for (int i = bx * NTHREADS + tid; i < TOK * PLE / 4; i += G * NTHREADS) { const f32x4 v = src[i]; u32x2 w; w.x = pk2(v[0], v[1]); w.y = pk2(v[2], v[3]); dst[i] = w; }
            }
            {
                unsigned long long* z = ST(l, 1);
                for (int i = bx * NTHREADS + tid; i < 3 * TOK; i += G * NTHREADS) z[i] = 0ull;
            }
            if (l == 0) { for (int m = gw; m < TOK; m += NGW) row_cast_stat(KARG(x) + (size_t)m * DM, HB_A + (size_t)m * DM, ST(0, 0) + m, lane); }
        }
        if (IN(pb + 0) && IN(pb + 1)) SEAM();
        if (IN(pb + 1)) for (int rep_ = 0; rep_ < NREP(1); ++rep_) { if (rep_) __syncthreads();
            PHASE_BEGIN
            pg8::Gemm g{(l == 0) ? (const bf16_t*)HB_A : (const bf16_t*)KARG(out), WSP(bf16_t, WS_WIN), TOK, INP, DM}; pg8::StaticOrder S; S.init(TOK, INP, G, bx, WGM_G1);
            EpiProj E{WSP(bf16_t, WS_BIG), WSP(float, WS_AB), (l == 0) ? ST(0, 0) : ST(0, 3)};
            pg8::gemm_phase<EpiProj>(L, g, S, E, tid);
        }
        if (IN(pb + 1) && IN(pb + 2)) SEAM();
        if (IN(pb + 2)) for (int rep_ = 0; rep_ < NREP(2); ++rep_) { if (rep_) __syncthreads();
            PHASE_BEGIN
            int kit = 0;
            for (int it = bx; it < 2048; it += G, ++kit)
                gdn_chunk_item(L, it, WSP(bf16_t, WS_BIG), WSP(float, WS_AB), KARG(gdn_conv) + (size_t)l * 4 * 3072, KARG(gdn_a_log) + l * 8, KARG(gdn_dt_bias) + l * 8, ws + WS_GDN, WSP(float, WS_GL), tid, it + G, kit & 1, kit == 0);
        }
        if (IN(pb + 2) && IN(pb + 3)) SEAM();
        if (IN(pb + 3)) {
            PHASE_BEGIN
            const int nscan = (G > 64) ? 64 : 0;
            if (bx < nscan) {
                gdn_scan(L, bx, ws + WS_GDN, WSP(float, WS_GL), WSP(bf16_t, WS_BIG), tid);
            } else {
                if (nscan == 0) { for (int id = bx; id < 64; id += G) { gdn_scan(L, id, ws + WS_GDN, WSP(float, WS_GL), WSP(bf16_t, WS_BIG), tid); __syncthreads(); } }
                const int rb = bx - nscan, RG = G - nscan;
#ifdef PROBE_SGU
                for (int rep2 = 0; rep2 < 2; ++rep2)
#endif
                for (int it = rb; it < 512; it += RG)
                    sgu_item(L, it, WSP(bf16_t, WS_BIG), KARG(sg_w) + (size_t)l * 4 * 16384, KARG(sg_b) + l * 512, KARG(sg_ln_g) + l * 512, KARG(sg_ln_b) + l * 512, KARG(out_norm_a) + l * 512, WSP(bf16_t, WS_XN), tid);
#ifdef PROBE_SC
                for (int rep3 = 0; rep3 < 2; ++rep3)
#endif
                for (int tk = rb * NWAVES + wave; tk < TOK; tk += RG * NWAVES)
                    shortconv_token(tk, WSP(bf16_t, WS_BIG), KARG(sc_conv) + l * 3 * 512, KARG(out_norm_b) + l * 512, WSP(bf16_t, WS_XN), lane);
                if (nscan) {
                    __syncthreads();
                    pg8::Gemm g{WSP(bf16_t, WS_P16), WSP(bf16_t, WS_WP), TOK, DM, PLE}; pg8::StaticOrder S; S.init(TOK, DM, RG, rb);
                    EpiPlain E{(bf16_t*)KARG(out) + (size_t)TOK * DM};
                    pg8::gemm_phase<EpiPlain>(L, g, S, E, tid);
                }
            }
        }
        if (IN(pb + 3)) SEAM_ALWAYS();
        if (IN(pb + 3)) {
            PHASE_BEGIN
            for (int it = gw; it < TOK * 2; it += NGW) gdn_finalize(it, WSP(bf16_t, WS_BIG), KARG(gdn_norm) + l * 128, WSP(bf16_t, WS_XN), lane);
        }
        if (IN(pb + 3) && IN(pb + 4)) SEAM();
        if (IN(pb + 4)) {
            PHASE_BEGIN
            pg8::Gemm g{WSP(bf16_t, WS_XN), WSP(bf16_t, WS_WO), TOK, DM, DM}; pg8::StaticOrder S; S.init(TOK, DM, G, bx, WGM_G2);
            if (l == 0) { EpiRes<true> E{KARG(x), nullptr, HB_A, ST(l, 1)}; pg8::gemm_phase<EpiRes<true>>(L, g, S, E, tid); }
            else { EpiRes<false> E{nullptr, (const bf16_t*)KARG(out), HB_A, ST(l, 1)}; pg8::gemm_phase<EpiRes<false>>(L, g, S, E, tid); }
        }
        if (IN(pb + 4) && IN(pb + 6)) SEAM();
        if (IN(pb + 6)) for (int rep_ = 0; rep_ < NREP(6); ++rep_) { if (rep_) __syncthreads();
            PHASE_BEGIN
            pg8::Gemm g{HB_A, WSP(bf16_t, WS_W1), TOK, FFD, DM}; pg8::StaticOrder S; S.init(TOK, FFD, G, bx, WGM_G3);
            EpiRelu2 E{WSP(bf16_t, WS_BIG), ST(l, 1)};
            pg8::gemm_phase<EpiRelu2>(L, g, S, E, tid);
        }
        if (IN(pb + 6) && IN(pb + 7)) SEAM();
        if (IN(pb + 7)) {
            PHASE_BEGIN
            pg8::Gemm g{WSP(bf16_t, WS_BIG), WSP(bf16_t, WS_W2), TOK, DM, FFD}; pg8::StaticOrder S; S.init(TOK, DM, G, bx, WGM_G4);
            EpiRes<false> E{nullptr, HB_A, HB_B, ST(l, 2)};
            pg8::gemm_phase<EpiRes<false>>(L, g, S, E, tid);
        }
        if (IN(pb + 7) && IN(pb + 9)) SEAM();
        if (IN(pb + 9)) {
            PHASE_BEGIN
            if (G <= 64) {
            pg8::Gemm g{WSP(bf16_t, WS_P16), WSP(bf16_t, WS_WP), TOK, DM, PLE}; pg8::StaticOrder S; S.init(TOK, DM, G, bx);
            EpiPlain E{(bf16_t*)KARG(out) + (size_t)TOK * DM};
            pg8::gemm_phase<EpiPlain>(L, g, S, E, tid);
            }
        }
        if (IN(pb + 9)) {
            __syncthreads();
            PHASE_BEGIN
            pg8::Gemm g{HB_B, WSP(bf16_t, WS_WG), TOK, DM, DM}; pg8::StaticOrder S; S.init(TOK, DM, G, bx, WGM_G6);
            EpiGate E{(const bf16_t*)KARG(out) + (size_t)TOK * DM, HB_B, ST(l, 2), (l == 0) ? (bf16_t*)KARG(out) : HB_A, ST(l, 3)};
            pg8::gemm_phase<EpiGate>(L, g, S, E, tid);
        }
        if (IN(pb + 9) && IN(pb + 10)) SEAM();
    }
    if (IN(20)) {
        const int lsel = 0;
        PHASE_BEGIN
        for (int m = gw; m < TOK; m += NGW) row_scale_from_bf16(HB_A + (size_t)m * DM, KARG(norm_final), (float)ST(1, 3)[m] * (1.0f / STAT_SCALE), KARG(out) + (size_t)m * DM, lane);
#ifdef PROBE_TS_MASK
        {
            const unsigned long long* ts = (const unsigned long long*)(ws + WS_TS);
            unsigned long long ticks = 0;
            for (int ll = 0; ll < 2; ++ll) for (int j = 0; j < 9; ++j) if ((PROBE_TS_MASK >> j) & 1) ticks += ts[1 + 9 * ll + j] - ts[9 * ll + j];
            const float delta = sqrtf((float)ticks * 0.01f * 1e-7f);
            __syncthreads();
            float* o = KARG(out);
            for (int m = gw; m < TOK; m += NGW) for (int j = lane; j < DM; j += 64) o[(size_t)m * DM + j] += (j & 1) ? delta : -delta;
        }
#endif
    }
#undef IN
#undef SEAM
}

extern "C" void kernel_launch(void* const* d_in, const int* in_sizes, int n_in, void* d_out, int out_size, void* d_ws, size_t ws_size, hipStream_t stream) {
    static int grid = 0;
    if (grid == 0) {
        if (n_in != 23 || out_size != TOK * DM || ws_size < WS_END) { fprintf(stderr, "kernel_launch: unexpected shapes (n_in %d out %d ws %zu need %zu)\n", n_in, out_size, ws_size, (size_t)WS_END); grid = -1; return; }
        int dev = 0, cus = 0, per_cu = 0;
        hipGetDevice(&dev);
        hipDeviceGetAttribute(&cus, hipDeviceAttributeMultiprocessorCount, dev);
        if (hipFuncSetAttribute((const void*)hybrid_fwd, hipFuncAttributeMaxDynamicSharedMemorySize, LDS_BYTES) != hipSuccess) { fprintf(stderr, "kernel_launch: hipFuncSetAttribute failed\n"); grid = -1; return; }
        if (hipOccupancyMaxActiveBlocksPerMultiprocessor(&per_cu, (const void*)hybrid_fwd, NTHREADS, LDS_BYTES) != hipSuccess || per_cu < 1) { fprintf(stderr, "kernel_launch: occupancy query gave %d\n", per_cu); per_cu = 1; }
        (void)hipGetLastError();
        grid = cus * per_cu;
    }
    if (grid < 0) return;
    Args a{};
    const float** f = (const float**)&a;
    for (int i = 0; i < 23; ++i) f[i] = (const float*)d_in[i];
    a.out = (float*)d_out; a.ws = (unsigned char*)d_ws;
#if MK_COOP
    if (hipMemsetAsync((char*)d_ws + WS_BAR, 0, 16384, stream) != hipSuccess) { fprintf(stderr, "kernel_launch: memset failed\n"); return; }
    a.ph_lo = 0; a.ph_hi = 21; a.coop = 1;
    void* args[] = {&a};
    hipError_t e = hipLaunchCooperativeKernel((const void*)hybrid_fwd, dim3(grid), dim3(NTHREADS), args, LDS_BYTES, stream);
    if (e != hipSuccess) fprintf(stderr, "cooperative launch failed: %s (grid %d)\n", hipGetErrorString(e), grid);
#else
    for (int ph = 0; ph < 21; ++ph) {
        a.ph_lo = ph; a.ph_hi = ph + 1; a.coop = 0;
        hipLaunchKernelGGL(hybrid_fwd, dim3(grid), dim3(NTHREADS), LDS_BYTES, stream, a);
    }
#endif
}
```

```cpp
#include <hip/hip_runtime.h>
#include <hip/hip_cooperative_groups.h>
#include <cstdio>
#include <cstdint>
#include <cstddef>
namespace cg = cooperative_groups;

#ifndef WGM_G1
#define WGM_G1 4
#endif
#ifndef WGM_G2
#define WGM_G2 2
#endif
#ifndef WGM_G3
#define WGM_G3 4
#endif
#ifndef WGM_G4
#define WGM_G4 4
#endif
#ifndef WGM_G6
#define WGM_G6 2
#endif
#ifndef MK_COOP
#define MK_COOP 1
#endif

#define LAS __attribute__((address_space(3)))
typedef unsigned short bf16_t;
typedef short bf16x8 __attribute__((ext_vector_type(8)));
typedef float f32x4 __attribute__((ext_vector_type(4)));
typedef float f32x2 __attribute__((ext_vector_type(2)));
typedef unsigned u32x4 __attribute__((ext_vector_type(4)));
typedef unsigned u32x2 __attribute__((ext_vector_type(2)));

namespace pg8 {
constexpr int BM = 256, BK = 64, HALF = 128, HTB = HALF * BK * 2, STAGE_BYTES = 8 * HTB, NXCD = 8, WGM = 4;
__host__ __device__ __forceinline__ int lds_byte(int r, int c) { const int st = (r >> 4) * 2 + (c >> 5), rr = r & 15, cc = c & 31, ob = rr * 64 + cc * 2; return st * 1024 + (ob ^ (((ob >> 9) & 1) << 5)); }
__host__ __device__ __forceinline__ void stage_rc(int b, int& R, int& C) { const int st = b / 1024, sb = b % 1024, swz = sb ^ (((sb >> 9) & 1) << 5); R = (st >> 1) * 16 + swz / 64; C = (st & 1) * 32 + (swz % 64) / 2; }
__host__ __device__ __forceinline__ int perm32(int rho) { const int n = rho >> 4, i = rho & 15; return 8 * (i >> 2) + 4 * n + (i & 3); }

struct Unit { int pm, pn; };
struct Gemm { const bf16_t* A; const bf16_t* Bt; int M, N, K; };

struct StaticOrder {
    int nM, nN, nwg, G, c, wgm;
    __host__ __device__ void init(int M, int N, int G_, int c_, int wgm_ = WGM) { nM = M / BM; nN = N / BM; nwg = nM * nN; G = G_; c = c_; wgm = wgm_; }
    __host__ __device__ bool next(int i, Unit& u) const {
        const long L = (long)i * G + c; if (L >= nwg) return false;
        int wgid = (int)L; { const int q = nwg / NXCD, r = nwg % NXCD, xcd = wgid % NXCD, off = wgid / NXCD; wgid = (xcd < r ? xcd * (q + 1) : r * (q + 1) + (xcd - r) * q) + off; }
        const int nig = wgm * nN, gid = wgid / nig, fm = gid * wgm, gsz = (nM - fm) < wgm ? (nM - fm) : wgm;
        u.pm = fm + ((wgid % nig) % gsz); u.pn = (wgid % nig) / gsz; return true;
    }
};

__device__ __forceinline__ unsigned cvt_pk_bf16(float lo, float hi) { unsigned r; asm volatile("v_cvt_pk_bf16_f32 %0, %1, %2" : "=v"(r) : "v"(lo), "v"(hi)); return r; }

template <class Epi>
__device__ __forceinline__ void gemm_phase(LAS unsigned char* lds, const Gemm g, const StaticOrder& S, const Epi& E, const int tid) {
    const int wid = __builtin_amdgcn_readfirstlane(tid >> 6), lane = tid & 63, wr = wid >> 2, wc = wid & 3, fr = lane & 15, fq = lane >> 4;
    int K_ = g.K; asm volatile("" : "+s"(K_)); const int K = K_, nt = K / BK;
    unsigned voffA[2], voffB[2];
#pragma unroll
    for (int i = 0; i < 2; ++i) { int R, C; stage_rc(tid * 16 + i * 8192, R, C); const int Rb = (R & ~31) + perm32(R & 31);
        voffA[i] = (unsigned)(R * K + C) * 2u; voffB[i] = (unsigned)(Rb * K + C) * 2u; }
    const size_t kstep = (size_t)(BK * 2);
    const size_t hstep = (size_t)HALF * K * 2;
    const size_t tstep = 2 * hstep;
    const unsigned ldsw = (unsigned)wid * 1024u;
    const int aoff = lds_byte(wr * 64 + fr, fq * 8), boff = lds_byte(wc * 32 + fr, fq * 8);
#define PG8_SA(b, h) (((b) * 2 + (h)) * HTB)
#define PG8_SB(b, h) ((4 + (b) * 2 + (h)) * HTB)
#define PG8_STAGE(bufoff, gbase, voff) do { _Pragma("unroll") for (int _i = 0; _i < 2; ++_i) \
        __builtin_amdgcn_global_load_lds((const unsigned*)((const char*)(gbase) + (voff)[_i]), (LAS unsigned*)(lds + (bufoff) + ldsw + _i * 8192), 16, 0, 0); } while (0)
#define PG8_LDA(dst, b, h) do { _Pragma("unroll") for (int m = 0; m < 4; ++m) _Pragma("unroll") for (int k = 0; k < 2; ++k) dst[m][k] = *(const LAS bf16x8*)(lds + PG8_SA(b, h) + aoff + m * 2048 + k * 1024); } while (0)
#define PG8_LDB(dst, b, h) do { _Pragma("unroll") for (int n = 0; n < 2; ++n) _Pragma("unroll") for (int k = 0; k < 2; ++k) dst[n][k] = *(const LAS bf16x8*)(lds + PG8_SB(b, h) + boff + n * 2048 + k * 1024); } while (0)
#define PG8_MMA(ai, bj, At, Bt) do { __builtin_amdgcn_s_setprio(1); _Pragma("unroll") for (int m = 0; m < 4; ++m) _Pragma("unroll") for (int n = 0; n < 2; ++n) _Pragma("unroll") for (int k = 0; k < 2; ++k) \
        acc[ai][bj][m][n] = __builtin_amdgcn_mfma_f32_16x16x32_bf16(Bt[n][k], At[m][k], acc[ai][bj][m][n], 0, 0, 0); __builtin_amdgcn_s_setprio(0); } while (0)
#define PG8_WAIT_V(n) asm volatile("s_waitcnt vmcnt(" #n ")" ::: "memory")
#define PG8_WAIT_L(n) asm volatile("s_waitcnt lgkmcnt(" #n ")" ::: "memory")
#define PG8_BAR __builtin_amdgcn_s_barrier()
#define PG8_SCHED __builtin_amdgcn_sched_barrier(0)
    Unit cur, nxt; int ui = 0;
    if (!S.next(0, cur)) return;
    f32x4 acc[2][2][4][2];
#pragma unroll
    for (int a = 0; a < 2; ++a)
#pragma unroll
        for (int b = 0; b < 2; ++b)
#pragma unroll
            for (int m = 0; m < 4; ++m)
#pragma unroll
                for (int n = 0; n < 2; ++n) acc[a][b][m][n] = (f32x4){0.f, 0.f, 0.f, 0.f};
    bf16x8 At[4][2], B0[2][2], B1[2][2];
    const char* cA = (const char*)g.A + (size_t)cur.pm * tstep; const char* cB = (const char*)g.Bt + (size_t)cur.pn * tstep;
    PG8_STAGE(PG8_SB(0, 0), cB, voffB); PG8_STAGE(PG8_SB(0, 1), cB + hstep, voffB); PG8_STAGE(PG8_SA(0, 0), cA, voffA); PG8_STAGE(PG8_SA(0, 1), cA + hstep, voffA);
    if (wr == 1) PG8_BAR;
    PG8_WAIT_V(2); PG8_BAR;
    PG8_STAGE(PG8_SB(1, 0), cB + kstep, voffB); PG8_STAGE(PG8_SA(1, 0), cA + kstep, voffA); PG8_STAGE(PG8_SB(1, 1), cB + hstep + kstep, voffB);
    PG8_WAIT_V(6); PG8_BAR;
    for (;;) {
        const bool has_next = S.next(ui + 1, nxt);
        const char* nA = has_next ? (const char*)g.A + (size_t)nxt.pm * tstep : cA; const char* nB = has_next ? (const char*)g.Bt + (size_t)nxt.pn * tstep : cB;
        for (int t = 0; t < nt; t += 2) {
            const bool last = (t == nt - 2);
            const char* a1 = cA + (size_t)(t + 1) * kstep;
            const char* a2 = last ? nA : cA + (size_t)(t + 2) * kstep; const char* b2 = last ? nB : cB + (size_t)(t + 2) * kstep;
            const char* a3 = a2 + kstep; const char* b3 = b2 + kstep;
            PG8_LDB(B0, 0, 0); PG8_LDB(B1, 0, 1); PG8_SCHED; PG8_LDA(At, 0, 0); PG8_STAGE(PG8_SA(1, 1), a1 + hstep, voffA);
            PG8_WAIT_V(8); PG8_WAIT_L(0); PG8_BAR; PG8_MMA(0, 0, At, B0); PG8_MMA(0, 1, At, B1); PG8_BAR; PG8_SCHED;
            PG8_LDA(At, 0, 1); PG8_STAGE(PG8_SB(0, 0), b2, voffB); PG8_STAGE(PG8_SB(0, 1), b2 + hstep, voffB); PG8_STAGE(PG8_SA(0, 0), a2, voffA);
            PG8_WAIT_V(8); PG8_WAIT_L(0); PG8_BAR; PG8_MMA(1, 0, At, B0); PG8_MMA(1, 1, At, B1); PG8_BAR; PG8_SCHED;
            PG8_LDB(B0, 1, 0); PG8_LDB(B1, 1, 1); PG8_SCHED; PG8_LDA(At, 1, 0); PG8_STAGE(PG8_SA(0, 1), a2 + hstep, voffA);
            PG8_WAIT_V(8); PG8_WAIT_L(0); PG8_BAR; PG8_MMA(0, 0, At, B0); PG8_MMA(0, 1, At, B1); PG8_BAR; PG8_SCHED;
            PG8_LDA(At, 1, 1); PG8_STAGE(PG8_SB(1, 0), b3, voffB); PG8_STAGE(PG8_SB(1, 1), b3 + hstep, voffB); PG8_STAGE(PG8_SA(1, 0), a3, voffA);
            PG8_WAIT_V(8); PG8_WAIT_L(0); PG8_BAR; PG8_MMA(1, 0, At, B0); PG8_MMA(1, 1, At, B1); PG8_BAR; PG8_SCHED;
        }
        if (wr == 0) PG8_BAR;
        E(acc, cur, wr, wc, fr, fq);
        if (!has_next) break;
#pragma unroll
        for (int a = 0; a < 2; ++a)
#pragma unroll
            for (int b = 0; b < 2; ++b)
#pragma unroll
                for (int m = 0; m < 4; ++m)
#pragma unroll
                    for (int n = 0; n < 2; ++n) acc[a][b][m][n] = (f32x4){0.f, 0.f, 0.f, 0.f};
        cur = nxt; cA = nA; cB = nB; ++ui;
        if (wr == 1) PG8_BAR;
    }
    PG8_WAIT_V(0);
    PG8_BAR;
#undef PG8_SA
#undef PG8_SB
#undef PG8_STAGE
#undef PG8_LDA
#undef PG8_LDB
#undef PG8_MMA
#undef PG8_WAIT_V
#undef PG8_WAIT_L
#undef PG8_BAR
#undef PG8_SCHED
}
}

constexpr int TOK = 16384, DM = 2048, SEQL = 4096, FFD = 8192, PLE = 256;
constexpr int INC = 6672, INP = 6912, PJ = 6656;
constexpr int C_U = 0, C_V = 512, C_GB = 1024, C_GC = 1536, C_XI = 2048, C_Q = 2560, C_Z = 5632;
constexpr float EPSF = 1e-6f;
constexpr int NTHREADS = 512, NWAVES = 8;
constexpr int LDS_BYTES = 163840;

constexpr size_t WS_AB = 0;
constexpr size_t WS_GL = 1048576;
constexpr size_t WS_WIN = 2097152;
constexpr size_t WS_WO = WS_WIN + (size_t)INP * DM * 2;
constexpr size_t WS_W1 = WS_WO + (size_t)DM * DM * 2;
constexpr size_t WS_W2 = WS_W1 + (size_t)FFD * DM * 2;
constexpr size_t WS_WG = WS_W2 + (size_t)FFD * DM * 2;
constexpr size_t WS_WP = WS_WG + (size_t)DM * DM * 2;
constexpr size_t WS_P16 = WS_WP + (size_t)DM * PLE * 2;
constexpr size_t WS_XN = WS_P16 + (size_t)TOK * PLE * 2;
constexpr size_t WS_BIG = WS_XN + (size_t)TOK * DM * 2;
constexpr size_t WS_GDN = WS_BIG + (size_t)TOK * FFD * 2;
constexpr size_t GDN_ITEM = 73728;
constexpr size_t WS_END = WS_GDN + 2048 * GDN_ITEM;

struct Args {
    const float *x, *p, *norm_mix, *w_in, *sg_ln_g, *sg_ln_b, *sg_w, *sg_b, *sc_conv, *gdn_conv, *gdn_a_log, *gdn_dt_bias, *gdn_norm,
        *out_norm_a, *out_norm_b, *w_o, *norm_ffn, *w_ff1, *w_ff2, *norm_ple, *w_ple_gate, *w_ple_proj, *norm_final;
    float* out; unsigned char* ws; int ph_lo, ph_hi, coop, pad;
};

__device__ __forceinline__ unsigned pk2(float lo, float hi) { return pg8::cvt_pk_bf16(lo, hi); }
__device__ __forceinline__ float bf2f(unsigned short v) { return __uint_as_float((unsigned)v << 16); }
__device__ __forceinline__ float bflo(unsigned w) { return __uint_as_float(w << 16); }
__device__ __forceinline__ float bfhi(unsigned w) { return __uint_as_float(w & 0xffff0000u); }
__device__ __forceinline__ float wave_sum(float v) {
#pragma unroll
    for (int o = 1; o < 64; o <<= 1) v += __shfl_xor(v, o);
    return v;
}
__device__ __forceinline__ float sigmoidf_(float x) { return __builtin_amdgcn_rcpf(1.0f + __expf(-x)); }
__device__ __forceinline__ float gelu_tanh(float x) { const float y = 1.5957691216057308f * x * (1.0f + 0.044715f * x * x); return x * __builtin_amdgcn_rcpf(1.0f + __expf(-y)); }
__device__ __forceinline__ bf16x8 pack8(const f32x4 a, const f32x4 b) {
    u32x4 w; w.x = pk2(a[0], a[1]); w.y = pk2(a[2], a[3]); w.z = pk2(b[0], b[1]); w.w = pk2(b[2], b[3]);
    return __builtin_bit_cast(bf16x8, w);
}
__device__ __forceinline__ void unpack8(const u32x4 w, float (&v)[8]) { v[0] = bflo(w.x); v[1] = bfhi(w.x); v[2] = bflo(w.y); v[3] = bfhi(w.y); v[4] = bflo(w.z); v[5] = bfhi(w.z); v[6] = bflo(w.w); v[7] = bfhi(w.w); }
__host__ __device__ __forceinline__ int kperm(int d) { return (d & ~31) + 8 * ((d >> 2) & 3) + 4 * ((d >> 4) & 1) + (d & 3); }
#define LDS_WAIT() asm volatile("s_waitcnt lgkmcnt(0)" ::: "memory")
#define LBAR() do { asm volatile("s_waitcnt lgkmcnt(0)" ::: "memory"); __builtin_amdgcn_s_barrier(); asm volatile("" ::: "memory"); } while (0)

#define EPI_LOOP_BEGIN  _Pragma("unroll") for (int ai = 0; ai < 2; ++ai) _Pragma("unroll") for (int m = 0; m < 4; ++m) { const int row = u.pm * 256 + ai * 128 + wr * 64 + m * 16 + fr; \
                        _Pragma("unroll") for (int bj = 0; bj < 2; ++bj) { const int col = u.pn * 256 + bj * 128 + wc * 32 + 8 * fq; f32x4 v0 = acc[ai][bj][m][0], v1 = acc[ai][bj][m][1];
#define EPI_LOOP_END    } }
#define EPI_ARGS const f32x4 (&acc)[2][2][4][2], const pg8::Unit& u, int wr, int wc, int fr, int fq

constexpr float STAT_SCALE = 1048576.0f;
__device__ __forceinline__ float rstd_of(const unsigned long long* ss, int row) { return __builtin_amdgcn_rsqf((float)ss[row] * (1.0f / (STAT_SCALE * DM)) + EPSF); }
struct EpiProj {
    bf16_t* P; float* AB; const unsigned long long* ss;
    __device__ __forceinline__ void operator()(EPI_ARGS) const {
        if (u.pn < 26) {
            const bool act = u.pn < 4;
#pragma unroll
            for (int ai = 0; ai < 2; ++ai)
#pragma unroll
                for (int m = 0; m < 4; ++m) { const int row = u.pm * 256 + ai * 128 + wr * 64 + m * 16 + fr; const float rs = rstd_of(ss, row);
#pragma unroll
                    for (int bj = 0; bj < 2; ++bj) { const int col = u.pn * 256 + bj * 128 + wc * 32 + 8 * fq; f32x4 v0 = acc[ai][bj][m][0] * rs, v1 = acc[ai][bj][m][1] * rs;
                        if (act) {
#pragma unroll
                            for (int e = 0; e < 4; ++e) { v0[e] = gelu_tanh(v0[e]); v1[e] = gelu_tanh(v1[e]); }
                        }
                        u32x4 w; w.x = pk2(v0[0], v0[1]); w.y = pk2(v0[2], v0[3]); w.z = pk2(v1[0], v1[1]); w.w = pk2(v1[2], v1[3]);
                        *(u32x4*)(P + (size_t)row * PJ + col) = w; } }
        } else {
            if (wc == 0 && fq < 2) {
#pragma unroll
                for (int ai = 0; ai < 2; ++ai)
#pragma unroll
                    for (int m = 0; m < 4; ++m) { const int row = u.pm * 256 + ai * 128 + wr * 64 + m * 16 + fr; const float rs = rstd_of(ss, row);
                        *(f32x4*)(AB + (size_t)row * 16 + 8 * fq) = acc[ai][0][m][0] * rs; *(f32x4*)(AB + (size_t)row * 16 + 8 * fq + 4) = acc[ai][0][m][1] * rs; }
            }
        }
    }
};
#define RES_TAIL(o0, o1) do { \
        u32x4 w_; w_.x = pk2((o0)[0], (o0)[1]); w_.y = pk2((o0)[2], (o0)[3]); w_.z = pk2((o1)[0], (o1)[1]); w_.w = pk2((o1)[2], (o1)[3]); *(u32x4*)(HB + off) = w_; \
        sq += ((o0)[0] * (o0)[0] + (o0)[1] * (o0)[1]) + ((o0)[2] * (o0)[2] + (o0)[3] * (o0)[3]) + ((o1)[0] * (o1)[0] + (o1)[1] * (o1)[1]) + ((o1)[2] * (o1)[2] + (o1)[3] * (o1)[3]); } while (0)
#define RES_STAT() do { sq += __shfl_xor(sq, 16); sq += __shfl_xor(sq, 32); if (fq == 0) atomicAdd(stat + row, (unsigned long long)(sq * STAT_SCALE)); } while (0)
template <bool BASE_F32> struct EpiRes {
    const float* basef; const bf16_t* baseb; bf16_t* HB; unsigned long long* stat;
    __device__ __forceinline__ void operator()(EPI_ARGS) const {
#pragma unroll
        for (int ai = 0; ai < 2; ++ai)
#pragma unroll
            for (int m = 0; m < 4; ++m) { const int row = u.pm * 256 + ai * 128 + wr * 64 + m * 16 + fr; float sq = 0.f;
#pragma unroll
                for (int bj = 0; bj < 2; ++bj) { const int col = u.pn * 256 + bj * 128 + wc * 32 + 8 * fq; const size_t off = (size_t)row * DM + col;
                    f32x4 b0, b1;
                    if (BASE_F32) { b0 = *(const f32x4*)(basef + off); b1 = *(const f32x4*)(basef + off + 4); }
                    else { const u32x4 bw = *(const u32x4*)(baseb + off); b0 = (f32x4){bflo(bw.x), bfhi(bw.x), bflo(bw.y), bfhi(bw.y)}; b1 = (f32x4){bflo(bw.z), bfhi(bw.z), bflo(bw.w), bfhi(bw.w)}; }
                    const f32x4 o0 = b0 + acc[ai][bj][m][0], o1 = b1 + acc[ai][bj][m][1];
                    RES_TAIL(o0, o1); }
                RES_STAT(); }
    }
};
struct EpiRelu2 {
    bf16_t* O; const unsigned long long* ss;
    __device__ __forceinline__ void operator()(EPI_ARGS) const {
#pragma unroll
        for (int ai = 0; ai < 2; ++ai)
#pragma unroll
            for (int m = 0; m < 4; ++m) { const int row = u.pm * 256 + ai * 128 + wr * 64 + m * 16 + fr; const float rs = rstd_of(ss, row);
#pragma unroll
                for (int bj = 0; bj < 2; ++bj) { const int col = u.pn * 256 + bj * 128 + wc * 32 + 8 * fq; f32x4 v0 = acc[ai][bj][m][0] * rs, v1 = acc[ai][bj][m][1] * rs;
#pragma unroll
                    for (int e = 0; e < 4; ++e) { const float a = fmaxf(v0[e], 0.f), b = fmaxf(v1[e], 0.f); v0[e] = a * a; v1[e] = b * b; }
                    u32x4 w; w.x = pk2(v0[0], v0[1]); w.y = pk2(v0[2], v0[3]); w.z = pk2(v1[0], v1[1]); w.w = pk2(v1[2], v1[3]);
                    *(u32x4*)(O + (size_t)row * FFD + col) = w; } }
    }
};
struct EpiPlain {
    bf16_t* O;
    __device__ __forceinline__ void operator()(EPI_ARGS) const {
        EPI_LOOP_BEGIN
            u32x4 w; w.x = pk2(v0[0], v0[1]); w.y = pk2(v0[2], v0[3]); w.z = pk2(v1[0], v1[1]); w.w = pk2(v1[2], v1[3]);
            *(u32x4*)(O + (size_t)row * DM + col) = w;
        EPI_LOOP_END
    }
};
__device__ __forceinline__ float fsig(float x) { return __builtin_amdgcn_rcpf(1.0f + __expf(-x)); }
struct EpiGate {
    const bf16_t* PP; const bf16_t* baseb; const unsigned long long* ss; bf16_t* HB; unsigned long long* stat;
    __device__ __forceinline__ void operator()(EPI_ARGS) const {
#pragma unroll
        for (int ai = 0; ai < 2; ++ai)
#pragma unroll
            for (int m = 0; m < 4; ++m) { const int row = u.pm * 256 + ai * 128 + wr * 64 + m * 16 + fr; const float rs = rstd_of(ss, row); float sq = 0.f;
#pragma unroll
                for (int bj = 0; bj < 2; ++bj) { const int col = u.pn * 256 + bj * 128 + wc * 32 + 8 * fq; const size_t off = (size_t)row * DM + col;
                    const f32x4 v0 = acc[ai][bj][m][0] * rs, v1 = acc[ai][bj][m][1] * rs;
                    const u32x4 pw = *(const u32x4*)(PP + off);
                    const u32x4 bw = *(const u32x4*)(baseb + off);
                    f32x4 o0, o1;
                    o0[0] = bflo(bw.x) + bflo(pw.x) * fsig(v0[0]); o0[1] = bfhi(bw.x) + bfhi(pw.x) * fsig(v0[1]);
                    o0[2] = bflo(bw.y) + bflo(pw.y) * fsig(v0[2]); o0[3] = bfhi(bw.y) + bfhi(pw.y) * fsig(v0[3]);
                    o1[0] = bflo(bw.z) + bflo(pw.z) * fsig(v1[0]); o1[1] = bfhi(bw.z) + bfhi(pw.z) * fsig(v1[1]);
                    o1[2] = bflo(bw.w) + bflo(pw.w) * fsig(v1[2]); o1[3] = bfhi(bw.w) + bfhi(pw.w) * fsig(v1[3]);
                    RES_TAIL(o0, o1); }
                RES_STAT(); }
    }
};

__device__ __forceinline__ void transpose_item(const float* W, int K, int N, int Npad, bf16_t* WT, LAS float* scr, int item, int lane, const float* gain = nullptr) {
    const int nblk = Npad / 32, kb = item / nblk, nb = item % nblk, k0 = 64 * kb, n0 = 32 * nb;
    const int nn = n0 + (lane & 31); const bool ok = nn < N;
#pragma unroll 8
    for (int i = 0; i < 32; ++i) { const int kk = 2 * i + (lane >> 5); scr[kk * 33 + (lane & 31)] = ok ? W[(size_t)(k0 + kk) * N + nn] * (gain ? gain[k0 + kk] : 1.0f) : 0.f; }
    LDS_WAIT(); asm volatile("" ::: "memory");
    const int c = lane & 7;
#pragma unroll
    for (int j = 0; j < 4; ++j) { const int n = (lane >> 3) + 8 * j; const LAS float* s = scr + (8 * c) * 33 + n;
        u32x4 o; o.x = pk2(s[0 * 33], s[1 * 33]); o.y = pk2(s[2 * 33], s[3 * 33]); o.z = pk2(s[4 * 33], s[5 * 33]); o.w = pk2(s[6 * 33], s[7 * 33]);
        *(u32x4*)(WT + (size_t)(n0 + n) * K + k0 + 8 * c) = o; }
    LDS_WAIT(); asm volatile("" ::: "memory");
}
struct TrDesc { const float* W; bf16_t* WT; const float* gain; int K, N, Npad; };
__device__ __forceinline__ void tr_issue(const TrDesc& d, int item, int lane, LAS unsigned char* tile) {
    const int nblk = d.Npad / 32, kb = item / nblk, nb = item % nblk, k0 = 64 * kb, n0 = 32 * nb;
    int nn = n0 + (lane & 7) * 4; nn = nn < d.N - 4 ? nn : d.N - 4;
    const float* g = d.W + (size_t)(k0 + (lane >> 3)) * d.N + nn;
#pragma unroll
    for (int i = 0; i < 8; ++i)
        __builtin_amdgcn_global_load_lds((const unsigned*)(g + (size_t)(8 * i) * d.N), (LAS unsigned*)(tile + i * 1024), 16, 0, 0);
}
__device__ __forceinline__ void tr_process(const TrDesc& d, int item, int lane, const LAS unsigned char* tile) {
    const int nblk = d.Npad / 32, kb = item / nblk, nb = item % nblk, k0 = 64 * kb, n0 = 32 * nb;
    const int c = lane & 7; const LAS float* t = (const LAS float*)tile;
    float gk[8];
#pragma unroll
    for (int e = 0; e < 8; ++e) gk[e] = d.gain ? d.gain[k0 + 8 * c + e] : 1.0f;
#pragma unroll
    for (int j = 0; j < 4; ++j) { const int n = (lane >> 3) + 8 * j; const LAS float* s = t + (8 * c) * 32 + n; const bool ok = n0 + n < d.N;
        float v[8];
#pragma unroll
        for (int e = 0; e < 8; ++e) v[e] = ok ? s[e * 32] * gk[e] : 0.f;
        u32x4 o; o.x = pk2(v[0], v[1]); o.y = pk2(v[2], v[3]); o.z = pk2(v[4], v[5]); o.w = pk2(v[6], v[7]);
        *(u32x4*)(d.WT + (size_t)(n0 + n) * d.K + k0 + 8 * c) = o; }
    LDS_WAIT(); asm volatile("" ::: "memory");
}
__device__ __forceinline__ void rms_row_bf16(const float* xrow, const float* g, bf16_t* orow, int lane) {
    const f32x4* xr = (const f32x4*)xrow + lane; const f32x4* gr = (const f32x4*)g + lane;
    f32x4 v[8]; float s = 0.f;
#pragma unroll
    for (int j = 0; j < 8; ++j) { v[j] = xr[64 * j]; s += (v[j][0] * v[j][0] + v[j][1] * v[j][1]) + (v[j][2] * v[j][2] + v[j][3] * v[j][3]); }
    const float rstd = 1.0f / sqrtf(wave_sum(s) * (1.0f / DM) + EPSF);
    u32x2* o8 = (u32x2*)orow + lane;
#pragma unroll
    for (int j = 0; j < 8; ++j) { const f32x4 gg = gr[64 * j]; u32x2 w; w.x = pk2(v[j][0] * rstd * gg[0], v[j][1] * rstd * gg[1]); w.y = pk2(v[j][2] * rstd * gg[2], v[j][3] * rstd * gg[3]); o8[64 * j] = w; }
}
__device__ __forceinline__ void row_cast_stat(const float* xrow, bf16_t* orow, unsigned long long* ss, int lane) {
    const f32x4* xr = (const f32x4*)xrow + lane; f32x4 v[8]; float s = 0.f;
#pragma unroll
    for (int j = 0; j < 8; ++j) { v[j] = xr[64 * j]; s += (v[j][0] * v[j][0] + v[j][1] * v[j][1]) + (v[j][2] * v[j][2] + v[j][3] * v[j][3]); }
    s = wave_sum(s);
    u32x2* o8 = (u32x2*)orow + lane;
#pragma unroll
    for (int j = 0; j < 8; ++j) { u32x2 w; w.x = pk2(v[j][0], v[j][1]); w.y = pk2(v[j][2], v[j][3]); o8[64 * j] = w; }
    if (lane == 0) *ss = (unsigned long long)(s * STAT_SCALE);
}
__device__ __forceinline__ void row_scale_f32(const float* xrow, const float* g, float ss, float* orow, int lane) {
    const f32x4* xr = (const f32x4*)xrow + lane; const f32x4* gr = (const f32x4*)g + lane; f32x4* o = (f32x4*)orow + lane;
    const float rstd = 1.0f / sqrtf(ss * (1.0f / DM) + EPSF);
#pragma unroll
    for (int j = 0; j < 8; ++j) { const f32x4 v = xr[64 * j], gg = gr[64 * j]; o[64 * j] = v * rstd * gg; }
}
__device__ __forceinline__ void row_scale_from_bf16(const bf16_t* hrow, const float* g, float ss, float* orow, int lane) {
    const u32x2* hr = (const u32x2*)hrow + lane; const f32x4* gr = (const f32x4*)g + lane; f32x4* o = (f32x4*)orow + lane;
    const float rstd = 1.0f / sqrtf(ss * (1.0f / DM) + EPSF);
#pragma unroll
    for (int j = 0; j < 8; ++j) { const u32x2 w = hr[64 * j]; const f32x4 gg = gr[64 * j]; o[64 * j] = (f32x4){bflo(w.x), bfhi(w.x), bflo(w.y), bfhi(w.y)} * rstd * gg; }
}
__device__ __forceinline__ void rms_row_f32(const float* xrow, const float* g, float* orow, int lane) {
    const f32x4* xr = (const f32x4*)xrow + lane; const f32x4* gr = (const f32x4*)g + lane;
    f32x4 v[8]; float s = 0.f;
#pragma unroll
    for (int j = 0; j < 8; ++j) { v[j] = xr[64 * j]; s += (v[j][0] * v[j][0] + v[j][1] * v[j][1]) + (v[j][2] * v[j][2] + v[j][3] * v[j][3]); }
    const float rstd = 1.0f / sqrtf(wave_sum(s) * (1.0f / DM) + EPSF);
    f32x4* o = (f32x4*)orow + lane;
#pragma unroll
    for (int j = 0; j < 8; ++j) { const f32x4 gg = gr[64 * j]; o[64 * j] = v[j] * rstd * gg; }
}

__device__ __forceinline__ void gdn_chunk_item(LAS unsigned char* L, int item, const bf16_t* P, const float* AB, const float* convw, const float* a_log, const float* dt_bias,
                                               unsigned char* GDN, float* GL, int tid_in) {
    int tid = tid_in; asm volatile("" : "+v"(tid));
    const int n = item & 63, bh = item >> 6, h = bh & 7, b = bh >> 3;
    const int tok0 = b * SEQL + n * 64;
    const int wave = tid >> 6, lane = tid & 63, q4 = lane >> 4, c15 = lane & 15;
    LAS bf16_t* Kb = (LAS bf16_t*)(L);
    LAS bf16_t* Qb = (LAS bf16_t*)(L + 17408);
    LAS float* Af = (LAS float*)(L + 34816);
    LAS float* X = (LAS float*)(L + 51200);
    LAS float* gcs = (LAS float*)(L + 116736);
    LAS float* bts = gcs + 64;
    LAS float* egc = gcs + 128;
    unsigned char* gbase = GDN + (size_t)item * GDN_ITEM;
    bf16_t* g_qexp = (bf16_t*)gbase; bf16_t* g_kcd = (bf16_t*)(gbase + 16384); bf16_t* g_ktT = (bf16_t*)(gbase + 32768);
    bf16_t* g_valT = (bf16_t*)(gbase + 49152); bf16_t* g_intra = (bf16_t*)(gbase + 65536);

    const int cgi = tid % 48, seg = tid / 48, which = cgi >> 4, cc = (cgi & 15) * 8;
    const int col = C_Q + which * 1024 + h * 128 + cc;
    u32x4 raw[11];
    if (wave < 6) {
#pragma unroll
        for (int i = 0; i < 11; ++i) { const int r = seg * 8 - 3 + i;
            if (n * 64 + r >= 0) raw[i] = *(const u32x4*)(P + (size_t)(tok0 + r) * PJ + col); else raw[i] = (u32x4){0u, 0u, 0u, 0u}; }
    }
    if (wave == 0) {
        const float a = AB[(size_t)(tok0 + lane) * 16 + h], bb = AB[(size_t)(tok0 + lane) * 16 + 8 + h];
        const float xs = a + dt_bias[h];
        const float sp = xs > 20.f ? xs : log1pf(__expf(xs));
        float c = -__expf(a_log[h]) * sp;
#pragma unroll
        for (int o = 1; o < 64; o <<= 1) { const float t = __shfl_up(c, o); if (lane >= o) c += t; }
        gcs[lane] = c; bts[lane] = sigmoidf_(bb); egc[lane] = __expf(c);
    }
    LBAR();
    if (wave < 6) {
        float w[4][8];
#pragma unroll
        for (int j = 0; j < 4; ++j) { const f32x4 a = *(const f32x4*)(convw + j * 3072 + which * 1024 + h * 128 + cc), bq = *(const f32x4*)(convw + j * 3072 + which * 1024 + h * 128 + cc + 4);
            w[j][0] = a[0]; w[j][1] = a[1]; w[j][2] = a[2]; w[j][3] = a[3]; w[j][4] = bq[0]; w[j][5] = bq[1]; w[j][6] = bq[2]; w[j][7] = bq[3]; }
        float x0[8], x1[8], x2[8], x3[8];
        auto ldrow = [&](int i, float (&dst)[8]) { const u32x4 v = raw[i];
            dst[0] = bflo(v.x); dst[1] = bfhi(v.x); dst[2] = bflo(v.y); dst[3] = bfhi(v.y); dst[4] = bflo(v.z); dst[5] = bfhi(v.z); dst[6] = bflo(v.w); dst[7] = bfhi(v.w); };
        ldrow(0, x0); ldrow(1, x1); ldrow(2, x2);
#pragma unroll
        for (int i = 0; i < 8; ++i) {
            const int t = seg * 8 + i;
            ldrow(i + 3, x3);
            float y[8]; float ss = 0.f;
#pragma unroll
            for (int e = 0; e < 8; ++e) { const float c = w[0][e] * x0[e] + w[1][e] * x1[e] + w[2][e] * x2[e] + w[3][e] * x3[e]; y[e] = c * sigmoidf_(c); ss += y[e] * y[e]; }
            ss += __shfl_xor(ss, 1); ss += __shfl_xor(ss, 2); ss += __shfl_xor(ss, 4); ss += __shfl_xor(ss, 8);
            const float rn = __builtin_amdgcn_rsqf(ss + EPSF);
            const float bt = bts[t], eg = egc[t];
            if (which == 0) {
                const float s = rn * 0.08838834764831845f;
                u32x4 o; o.x = pk2(y[0] * s, y[1] * s); o.y = pk2(y[2] * s, y[3] * s); o.z = pk2(y[4] * s, y[5] * s); o.w = pk2(y[6] * s, y[7] * s);
                *(LAS u32x4*)(Qb + t * 136 + cc) = o;
            } else if (which == 1) {
                u32x4 o; o.x = pk2(y[0] * rn, y[1] * rn); o.y = pk2(y[2] * rn, y[3] * rn); o.z = pk2(y[4] * rn, y[5] * rn); o.w = pk2(y[6] * rn, y[7] * rn);
                *(LAS u32x4*)(Kb + t * 136 + cc) = o;
                const float s = rn * bt * eg;
                *(LAS f32x4*)(X + t * 256 + 128 + cc) = (f32x4){y[0] * s, y[1] * s, y[2] * s, y[3] * s};
                *(LAS f32x4*)(X + t * 256 + 128 + cc + 4) = (f32x4){y[4] * s, y[5] * s, y[6] * s, y[7] * s};
            } else {
                *(LAS f32x4*)(X + t * 256 + cc) = (f32x4){y[0] * bt, y[1] * bt, y[2] * bt, y[3] * bt};
                *(LAS f32x4*)(X + t * 256 + cc + 4) = (f32x4){y[4] * bt, y[5] * bt, y[6] * bt, y[7] * bt};
            }
#pragma unroll
            for (int e = 0; e < 8; ++e) { x0[e] = x1[e]; x1[e] = x2[e]; x2[e] = x3[e]; }
            __builtin_amdgcn_sched_barrier(0);
        }
    }
    LBAR();
    {
        const int ti = wave >> 1;
        bf16x8 ak[4], aq[4];
#pragma unroll
        for (int kb = 0; kb < 4; ++kb) { ak[kb] = *(const LAS bf16x8*)(Kb + (16 * ti + c15) * 136 + 32 * kb + 8 * q4); aq[kb] = *(const LAS bf16x8*)(Qb + (16 * ti + c15) * 136 + 32 * kb + 8 * q4); }
#pragma unroll
        for (int jj = 0; jj < 2; ++jj) {
            const int tj = 2 * (wave & 1) + jj;
            f32x4 dk = (f32x4){0.f, 0.f, 0.f, 0.f}, dq = (f32x4){0.f, 0.f, 0.f, 0.f};
#pragma unroll
            for (int kb = 0; kb < 4; ++kb) { const bf16x8 bk = *(const LAS bf16x8*)(Kb + (16 * tj + c15) * 136 + 32 * kb + 8 * q4);
                dk = __builtin_amdgcn_mfma_f32_16x16x32_bf16(bk, ak[kb], dk, 0, 0, 0); dq = __builtin_amdgcn_mfma_f32_16x16x32_bf16(bk, aq[kb], dq, 0, 0, 0); }
            const int i = 16 * ti + c15; const float gi = gcs[i], bi = bts[i];
            f32x4 av; u32x2 iw; float dv[4];
#pragma unroll
            for (int r = 0; r < 4; ++r) { const int j = 16 * tj + 4 * q4 + r;
                const float dec = (j <= i) ? __expf(fminf(gi - gcs[j], 0.f)) : 0.f;
                av[r] = (j < i) ? bi * dk[r] * dec : 0.f; dv[r] = dq[r] * dec; }
            *(LAS f32x4*)(Af + i * 64 + 16 * tj + 4 * q4) = av;
            iw.x = pk2(dv[0], dv[1]); iw.y = pk2(dv[2], dv[3]);
            *(u32x2*)(g_intra + i * 64 + kperm(16 * tj + 4 * q4)) = iw;
        }
    }
    LBAR();
    int tid2 = tid; asm volatile("" : "+v"(tid2));
    if (tid2 < 256) {
        const int c = tid2;
        float x[64];
        f32x4 arA[2][4], arB[12]; float xin[2];
        xin[0] = X[c]; xin[1] = X[256 + c]; arA[1][0] = *(const LAS f32x4*)(Af + 64);
#pragma unroll
        for (int i = 0; i < 64; ++i) {
            if (i >= 1 && i + 1 < 64) {
#pragma unroll
                for (int qd = 0; qd < ((i + 4) / 4 < 4 ? (i + 4) / 4 : 4); ++qd) arA[(i + 1) & 1][qd] = *(const LAS f32x4*)(Af + (i + 1) * 64 + 4 * qd);
                xin[(i + 1) & 1] = X[(i + 1) * 256 + c];
            }
            if (i > 16) {
#pragma unroll
                for (int qd = 4; qd < (i + 3) / 4; ++qd) arB[qd - 4] = *(const LAS f32x4*)(Af + i * 64 + 4 * qd);
            }
            __builtin_amdgcn_sched_barrier(0);
            float a0 = xin[i & 1], a1 = 0.f;
#pragma unroll
            for (int j = 0; j < (i < 16 ? i : 16); ++j) { if (j & 1) a1 -= arA[i & 1][j >> 2][j & 3] * x[j]; else a0 -= arA[i & 1][j >> 2][j & 3] * x[j]; }
#pragma unroll
            for (int j = 16; j < i; ++j) { if (j & 1) a1 -= arB[(j >> 2) - 4][j & 3] * x[j]; else a0 -= arB[(j >> 2) - 4][j & 3] * x[j]; }
            x[i] = a0 + a1;
            __builtin_amdgcn_sched_barrier(0);
        }
        if (c < 128) {
#pragma unroll
            for (int k = 0; k < 8; ++k) { u32x4 o; o.x = pk2(x[8 * k], x[8 * k + 1]); o.y = pk2(x[8 * k + 2], x[8 * k + 3]); o.z = pk2(x[8 * k + 4], x[8 * k + 5]); o.w = pk2(x[8 * k + 6], x[8 * k + 7]);
                *(u32x4*)(g_valT + c * 64 + 8 * k) = o; }
        } else {
            const int pd = kperm(c - 128); LAS bf16_t* Ks = (LAS bf16_t*)(L + 118784);
#pragma unroll
            for (int i = 0; i < 64; ++i) Ks[i * 128 + pd] = (bf16_t)(pk2(x[i], 0.f) & 0xffffu);
        }
    } else {
        const int t2 = tid2 - 256;
        {
            const int l = t2 >> 2, kb = t2 & 3; const float eg = egc[l];
#pragma unroll
            for (int k4 = 0; k4 < 4; ++k4) { float v[8];
#pragma unroll
                for (int e = 0; e < 8; ++e) { const int pos = 8 * k4 + e, qq = pos >> 3, jh = (pos >> 2) & 1, r = pos & 3; v[e] = bf2f(Qb[l * 136 + 32 * kb + 16 * jh + 4 * qq + r]) * eg; }
                u32x4 o; o.x = pk2(v[0], v[1]); o.y = pk2(v[2], v[3]); o.z = pk2(v[4], v[5]); o.w = pk2(v[6], v[7]);
                *(u32x4*)(g_qexp + l * 128 + 32 * kb + 8 * k4) = o; }
        }
        {
            const int d = t2 >> 1, kb2 = t2 & 1; const float glast = gcs[63];
#pragma unroll
            for (int k4 = 0; k4 < 4; ++k4) { float v[8];
#pragma unroll
                for (int e = 0; e < 8; ++e) { const int pos = 8 * k4 + e, qq = pos >> 3, jh = (pos >> 2) & 1, r = pos & 3; const int l = 32 * kb2 + 16 * jh + 4 * qq + r; v[e] = bf2f(Kb[l * 136 + d]) * __expf(glast - gcs[l]); }
                u32x4 o; o.x = pk2(v[0], v[1]); o.y = pk2(v[2], v[3]); o.z = pk2(v[4], v[5]); o.w = pk2(v[6], v[7]);
                *(u32x4*)(g_ktT + d * 64 + 32 * kb2 + 8 * k4) = o; }
        }
        if (t2 == 0) GL[item] = egc[63];
    }
    LBAR();
    {
        const LAS u32x4* ks = (const LAS u32x4*)(L + 118784); u32x4* gk = (u32x4*)g_kcd;
        gk[tid] = ks[tid]; gk[tid + 512] = ks[tid + 512];
    }
}

__device__ __forceinline__ void gdn_scan(LAS unsigned char* L, int id, const unsigned char* GDN, const float* GL, bf16_t* P, int tid) {
    const int bh = (id & 7) * 4 + (id >> 4), half = (id >> 3) & 1, h = bh & 7, b = bh >> 3;
    const int wave = tid >> 6, lane = tid & 63, q4 = lane >> 4, c15 = lane & 15;
    constexpr int BUF = 77824;
    LAS float* Lgl = (LAS float*)(L + 2 * BUF);
    if (wave >= 4) {
        const int tl = tid - 256;
        __builtin_amdgcn_s_setprio(3);
        if (tl < 64) Lgl[tl] = GL[bh * 64 + tl];
        u32x4 sa[16], sb[16];
#define LOADC(nn, R) do { const unsigned char* gb_ = GDN + (size_t)(bh * 64 + (nn)) * GDN_ITEM; \
            _Pragma("unroll") for (int k = 0; k < 12; ++k) R[k] = *(const u32x4*)(gb_ + (size_t)(tl + 256 * k) * 16); \
            R[12] = *(const u32x4*)(gb_ + 65536 + tl * 16); R[13] = *(const u32x4*)(gb_ + 65536 + (tl + 256) * 16); \
            R[14] = *(const u32x4*)(gb_ + 49152 + half * 8192 + tl * 16); R[15] = *(const u32x4*)(gb_ + 49152 + half * 8192 + (tl + 256) * 16); } while (0)
#define STOREC(LB_, R) do { \
            _Pragma("unroll") for (int k = 0; k < 8; ++k) { const int cc = tl + 256 * (k & 3); *(LAS u32x4*)((LB_) + (k >> 2) * 18432 + (cc >> 4) * 288 + (cc & 15) * 16) = R[k]; } \
            _Pragma("unroll") for (int k = 8; k < 12; ++k) { const int cc = tl + 256 * (k - 8); *(LAS u32x4*)((LB_) + 36864 + (cc >> 3) * 160 + (cc & 7) * 16) = R[k]; } \
            _Pragma("unroll") for (int k = 12; k < 14; ++k) { const int cc = tl + 256 * (k - 12); *(LAS u32x4*)((LB_) + 57344 + (cc >> 3) * 160 + (cc & 7) * 16) = R[k]; } \
            _Pragma("unroll") for (int k = 14; k < 16; ++k) { const int cc = tl + 256 * (k - 14); *(LAS u32x4*)((LB_) + 67584 + (cc >> 3) * 160 + (cc & 7) * 16) = R[k]; } } while (0)
        LOADC(0, sa); STOREC(L, sa);
        LOADC(1, sa); LOADC(2, sb);
        __syncthreads();
        for (int n = 0; n < 64; n += 2) {
            STOREC(L + BUF, sa);
            if (n + 3 < 64) LOADC(n + 3, sa);
            LBAR();
            if (n + 2 < 64) STOREC(L, sb);
            if (n + 4 < 64) LOADC(n + 4, sb);
            LBAR();
        }
#undef LOADC
#undef STOREC
        __builtin_amdgcn_s_setprio(0);
        return;
    }
    f32x4 S[8];
#pragma unroll
    for (int T = 0; T < 8; ++T) S[T] = (f32x4){0.f, 0.f, 0.f, 0.f};
    __syncthreads();
    for (int n = 0; n < 64; ++n) {
        LAS unsigned char* LB = L + (n & 1) * BUF;
        const float gl = Lgl[n];
        {
            LAS unsigned char* Lq = LB; LAS unsigned char* Lk = LB + 18432; LAS unsigned char* Lt = LB + 36864; LAS unsigned char* Li = LB + 57344; LAS unsigned char* Lv = LB + 67584;
            bf16x8 Sp[4];
#pragma unroll
            for (int kb = 0; kb < 4; ++kb) Sp[kb] = pack8(S[2 * kb], S[2 * kb + 1]);
            u32x2 vr[4];
#pragma unroll
            for (int t = 0; t < 4; ++t) vr[t] = *(const LAS u32x2*)(Lv + (16 * wave + c15) * 160 + (16 * t + 4 * q4) * 2);
            f32x4 pa[4], oo[4];
#pragma unroll
            for (int t = 0; t < 4; ++t) { pa[t] = (f32x4){0.f, 0.f, 0.f, 0.f}; oo[t] = (f32x4){0.f, 0.f, 0.f, 0.f}; }
            bf16x8 fk0[2][4], fq0[2][4], fk1[2][4], fq1[2][4];
#define LDKQ(FK, FQ, hh) do { _Pragma("unroll") for (int tt = 0; tt < 2; ++tt) _Pragma("unroll") for (int kb = 0; kb < 4; ++kb) { \
                FK[tt][kb] = *(const LAS bf16x8*)(Lk + (16 * (2 * (hh) + tt) + c15) * 288 + (32 * kb + 8 * q4) * 2); FQ[tt][kb] = *(const LAS bf16x8*)(Lq + (16 * (2 * (hh) + tt) + c15) * 288 + (32 * kb + 8 * q4) * 2); } } while (0)
#define MMKQ(FK, FQ, hh) do { _Pragma("unroll") for (int kb = 0; kb < 4; ++kb) _Pragma("unroll") for (int tt = 0; tt < 2; ++tt) { \
                pa[2 * (hh) + tt] = __builtin_amdgcn_mfma_f32_16x16x32_bf16(FK[tt][kb], Sp[kb], pa[2 * (hh) + tt], 0, 0, 0); oo[2 * (hh) + tt] = __builtin_amdgcn_mfma_f32_16x16x32_bf16(Sp[kb], FQ[tt][kb], oo[2 * (hh) + tt], 0, 0, 0); } } while (0)
            LDKQ(fk0, fq0, 0);
            __builtin_amdgcn_sched_barrier(0);
            LDKQ(fk1, fq1, 1);
            MMKQ(fk0, fq0, 0);
            __builtin_amdgcn_sched_barrier(0);
            bf16x8 fi[4][2], ft[4][2];
#pragma unroll
            for (int t = 0; t < 4; ++t)
#pragma unroll
                for (int kb = 0; kb < 2; ++kb) { fi[t][kb] = *(const LAS bf16x8*)(Li + (16 * t + c15) * 160 + (32 * kb + 8 * q4) * 2); ft[t][kb] = *(const LAS bf16x8*)(Lt + (16 * t + c15) * 160 + (32 * kb + 8 * q4) * 2); }
            MMKQ(fk1, fq1, 1);
            __builtin_amdgcn_sched_barrier(0);
#undef LDKQ
#undef MMKQ
            f32x4 Vn[4];
#pragma unroll
            for (int t = 0; t < 4; ++t) Vn[t] = (f32x4){bflo(vr[t].x), bfhi(vr[t].x), bflo(vr[t].y), bfhi(vr[t].y)} - pa[t];
            bf16x8 Vp[2];
            Vp[0] = pack8(Vn[0], Vn[1]); Vp[1] = pack8(Vn[2], Vn[3]);
            bf16x8 ft2[4][2];
#pragma unroll
            for (int t = 0; t < 4; ++t)
#pragma unroll
                for (int kb = 0; kb < 2; ++kb) ft2[t][kb] = *(const LAS bf16x8*)(Lt + (16 * (4 + t) + c15) * 160 + (32 * kb + 8 * q4) * 2);
#pragma unroll
            for (int T = 0; T < 4; ++T) S[T] = S[T] * gl;
#pragma unroll
            for (int kb = 0; kb < 2; ++kb)
#pragma unroll
                for (int t = 0; t < 4; ++t) { oo[t] = __builtin_amdgcn_mfma_f32_16x16x32_bf16(Vp[kb], fi[t][kb], oo[t], 0, 0, 0); S[t] = __builtin_amdgcn_mfma_f32_16x16x32_bf16(ft[t][kb], Vp[kb], S[t], 0, 0, 0); }
            __builtin_amdgcn_sched_barrier(0);
#pragma unroll
            for (int T = 4; T < 8; ++T) S[T] = S[T] * gl;
#pragma unroll
            for (int kb = 0; kb < 2; ++kb)
#pragma unroll
                for (int t = 0; t < 4; ++t) S[4 + t] = __builtin_amdgcn_mfma_f32_16x16x32_bf16(ft2[t][kb], Vp[kb], S[4 + t], 0, 0, 0);
            __builtin_amdgcn_sched_barrier(0);
            {
                bf16_t* ob = P + ((size_t)b * SEQL + n * 64 + c15) * PJ + C_Q + h * 128 + half * 64 + 16 * wave + 4 * q4;
#pragma unroll
                for (int t = 0; t < 4; ++t) { u32x2 w; w.x = pk2(oo[t][0], oo[t][1]); w.y = pk2(oo[t][2], oo[t][3]); *(u32x2*)(ob + (size_t)(16 * t) * PJ) = w; }
            }
        }
        LBAR();
    }
}
__device__ __forceinline__ void gdn_finalize(int item, const bf16_t* P, const float* gnorm, bf16_t* MIX, int lane) {
    const int tok = item >> 1, hq = item & 1, c = hq * 512 + lane * 8;
    float o[8], z[8];
    unpack8(*(const u32x4*)(P + (size_t)tok * PJ + C_Q + c), o);
    unpack8(*(const u32x4*)(P + (size_t)tok * PJ + C_Z + c), z);
    float ss = 0.f;
#pragma unroll
    for (int e = 0; e < 8; ++e) ss += o[e] * o[e];
    ss += __shfl_xor(ss, 1); ss += __shfl_xor(ss, 2); ss += __shfl_xor(ss, 4); ss += __shfl_xor(ss, 8);
    const float rstd = 1.0f / sqrtf(ss * (1.0f / 128.f) + EPSF);
    const f32x4 g0 = *(const f32x4*)(gnorm + (c & 127)), g1 = *(const f32x4*)(gnorm + (c & 127) + 4);
    float r[8];
#pragma unroll
    for (int e = 0; e < 8; ++e) { const float gg = e < 4 ? g0[e & 3] : g1[e & 3]; r[e] = o[e] * rstd * gg * (z[e] * __builtin_amdgcn_rcpf(1.0f + __expf(-z[e]))); }
    u32x4 w; w.x = pk2(r[0], r[1]); w.y = pk2(r[2], r[3]); w.z = pk2(r[4], r[5]); w.w = pk2(r[6], r[7]);
    *(u32x4*)(MIX + (size_t)tok * DM + 1024 + c) = w;
}

__device__ __forceinline__ void sgu_item(LAS unsigned char* L, int item, const bf16_t* P, const float* sgw, const float* sgb, const float* lng, const float* lnb, const float* ona, bf16_t* MIX, int tid) {
    const int h = item & 3, n = (item >> 2) & 31, b = item >> 7;
    const size_t tok0 = (size_t)b * SEQL + n * 128;
    const int wave = tid >> 6, lane = tid & 63, q4 = lane >> 4, c15 = lane & 15;
    LAS bf16_t* Wl = (LAS bf16_t*)L;
    LAS bf16_t* Vt = (LAS bf16_t*)(L + 34816);
    {
        const int t = tid >> 2, s0 = (tid & 3) * 32; const float* wr = sgw + (size_t)h * 16384 + t * 128 + s0;
#pragma unroll
        for (int k = 0; k < 4; ++k) { const f32x4 a = *(const f32x4*)(wr + 8 * k), c = *(const f32x4*)(wr + 8 * k + 4); float v[8] = {a[0], a[1], a[2], a[3], c[0], c[1], c[2], c[3]};
#pragma unroll
            for (int e = 0; e < 8; ++e) v[e] = (s0 + 8 * k + e <= t) ? v[e] : 0.f;
            u32x4 o; o.x = pk2(v[0], v[1]); o.y = pk2(v[2], v[3]); o.z = pk2(v[4], v[5]); o.w = pk2(v[6], v[7]);
            *(LAS u32x4*)(Wl + t * 136 + s0 + 8 * k) = o; }
    }
    {
        const int s = tid >> 2, d0 = (tid & 3) * 32; const bf16_t* vr = P + (tok0 + s) * PJ + C_V + h * 128 + d0;
        float v[32]; float sm = 0.f;
#pragma unroll
        for (int k = 0; k < 4; ++k) { const u32x4 w = *(const u32x4*)(vr + 8 * k); v[8 * k] = bflo(w.x); v[8 * k + 1] = bfhi(w.x); v[8 * k + 2] = bflo(w.y); v[8 * k + 3] = bfhi(w.y); v[8 * k + 4] = bflo(w.z); v[8 * k + 5] = bfhi(w.z); v[8 * k + 6] = bflo(w.w); v[8 * k + 7] = bfhi(w.w); }
#pragma unroll
        for (int e = 0; e < 32; ++e) sm += v[e];
        sm += __shfl_xor(sm, 1); sm += __shfl_xor(sm, 2);
        const float mu = sm * (1.0f / 128.f); float sq = 0.f;
#pragma unroll
        for (int e = 0; e < 32; ++e) { v[e] -= mu; sq += v[e] * v[e]; }
        sq += __shfl_xor(sq, 1); sq += __shfl_xor(sq, 2);
        const float rstd = 1.0f / sqrtf(sq * (1.0f / 128.f) + EPSF);
#pragma unroll
        for (int e = 0; e < 32; ++e) { const float y = v[e] * rstd * lng[h * 128 + d0 + e] + lnb[h * 128 + d0 + e]; Vt[(d0 + e) * 136 + s] = (bf16_t)(pk2(y, 0.f) & 0xffffu); }
    }
    __syncthreads();
    {
        f32x4 D[8];
#pragma unroll
        for (int tj = 0; tj < 8; ++tj) D[tj] = (f32x4){0.f, 0.f, 0.f, 0.f};
        const int nkb = (wave >> 1) + 1;
        for (int kb = 0; kb < nkb; ++kb) {
            const bf16x8 wv = *(const LAS bf16x8*)(Wl + (16 * wave + c15) * 136 + 32 * kb + 8 * q4);
#pragma unroll
            for (int tj = 0; tj < 8; ++tj) { const bf16x8 vv = *(const LAS bf16x8*)(Vt + (16 * tj + c15) * 136 + 32 * kb + 8 * q4); D[tj] = __builtin_amdgcn_mfma_f32_16x16x32_bf16(vv, wv, D[tj], 0, 0, 0); }
        }
        const int t = 16 * wave + c15; const float bias = sgb[h * 128 + t];
        const bf16_t* ur = P + (tok0 + t) * PJ + C_U + h * 128 + 4 * q4;
        u32x2 uw[8];
#pragma unroll
        for (int tj = 0; tj < 8; ++tj) uw[tj] = *(const u32x2*)(ur + 16 * tj);
        float ss = 0.f;
#pragma unroll
        for (int tj = 0; tj < 8; ++tj) { const f32x4 uu = (f32x4){bflo(uw[tj].x), bfhi(uw[tj].x), bflo(uw[tj].y), bfhi(uw[tj].y)}; const f32x4 y = uu * (D[tj] + bias); D[tj] = y; ss += (y[0] * y[0] + y[1] * y[1]) + (y[2] * y[2] + y[3] * y[3]); }
        ss += __shfl_xor(ss, 16); ss += __shfl_xor(ss, 32);
        const float rstd = __builtin_amdgcn_rsqf(ss * (1.0f / 128.f) + EPSF);
        bf16_t* orow = MIX + (tok0 + t) * DM + h * 128 + 4 * q4;
#pragma unroll
        for (int tj = 0; tj < 8; ++tj) { const f32x4 gg = *(const f32x4*)(ona + h * 128 + 16 * tj + 4 * q4); const f32x4 o = D[tj] * rstd * gg;
            u32x2 w; w.x = pk2(o[0], o[1]); w.y = pk2(o[2], o[3]); *(u32x2*)(orow + 16 * tj) = w; }
    }
    __syncthreads();
}

__device__ __forceinline__ void shortconv_token(int tok, const bf16_t* P, const float* scw, const float* onb, bf16_t* MIX, int lane) {
    const int c = lane * 8, pos = tok & (SEQL - 1);
    const bf16_t* row = P + (size_t)tok * PJ;
    float gb[8], acc[8];
    unpack8(*(const u32x4*)(row + C_GB + c), gb);
#pragma unroll
    for (int e = 0; e < 8; ++e) acc[e] = 0.f;
#pragma unroll
    for (int j = 0; j < 3; ++j) {
        const int back = 2 - j;
        if (pos - back >= 0) { float g[8], xi[8]; const bf16_t* r2 = row - (size_t)back * PJ;
            unpack8(*(const u32x4*)(r2 + C_GC + c), g); unpack8(*(const u32x4*)(r2 + C_XI + c), xi);
            const f32x4 w0 = *(const f32x4*)(scw + j * 512 + c), w1 = *(const f32x4*)(scw + j * 512 + c + 4);
#pragma unroll
            for (int e = 0; e < 4; ++e) { acc[e] += w0[e] * (g[e] * xi[e]); acc[4 + e] += w1[e] * (g[4 + e] * xi[4 + e]); } }
    }
    float ss = 0.f;
#pragma unroll
    for (int e = 0; e < 8; ++e) { acc[e] *= gb[e]; ss += acc[e] * acc[e]; }
    ss += __shfl_xor(ss, 1); ss += __shfl_xor(ss, 2); ss += __shfl_xor(ss, 4); ss += __shfl_xor(ss, 8);
    const float rstd = 1.0f / sqrtf(ss * (1.0f / 128.f) + EPSF);
    const f32x4 g0 = *(const f32x4*)(onb + c), g1 = *(const f32x4*)(onb + c + 4);
    u32x4 o; o.x = pk2(acc[0] * rstd * g0[0], acc[1] * rstd * g0[1]); o.y = pk2(acc[2] * rstd * g0[2], acc[3] * rstd * g0[3]);
    o.z = pk2(acc[4] * rstd * g1[0], acc[5] * rstd * g1[1]); o.w = pk2(acc[6] * rstd * g1[2], acc[7] * rstd * g1[3]);
    *(u32x4*)(MIX + (size_t)tok * DM + 512 + c) = o;
}


#define XB_TMO      128
#define XB_XCNT(j)  (256  + 64 * (j))
#define XB_XSUB(j)  (1280 + 64 * (j))
#define XB_XGEN(j)  (2304 + 64 * (j))
#define XB_TOP      3328
#define XB_TOPGEN   3392
#define XCD_BAR_WORDS 3456
#define XB_SPIN_CAP (1u << 22)
__device__ __forceinline__ unsigned xb_ld(unsigned* p)              { return __hip_atomic_load(p, __ATOMIC_RELAXED, __HIP_MEMORY_SCOPE_AGENT); }
__device__ __forceinline__ unsigned xb_add(unsigned* p, unsigned v) { return __hip_atomic_fetch_add(p, v, __ATOMIC_RELAXED, __HIP_MEMORY_SCOPE_AGENT); }
__device__ __forceinline__ unsigned xb_xcc_id() { return (unsigned)__builtin_amdgcn_s_getreg((3 << 11) | 20) & 0xFu; }
#define XB_SPIN(cond, bar) do { unsigned _sp = 0; while (cond) { __builtin_amdgcn_s_sleep(1); \
    if ((++_sp & 255u) == 0u) { if (xb_ld(&(bar)[XB_TMO])) break; if (_sp > XB_SPIN_CAP) { atomicAdd(&(bar)[XB_TMO], 1u); break; } } } } while (0)
struct XcdBarrier { unsigned* bar; unsigned x; volatile LAS unsigned* st; };
__device__ __forceinline__ XcdBarrier xcd_barrier_post(unsigned* bar, volatile LAS unsigned* st, int tid) {
    XcdBarrier b; b.bar = bar; b.x = xb_xcc_id(); b.st = st;
    if (tid == 0) (void)xb_add(&bar[XB_XCNT(b.x)], 1u);
    return b;
}
__device__ __forceinline__ void xcd_barrier_complete(unsigned* bar, unsigned x, unsigned& nloc, unsigned& nx) {
    const unsigned G = gridDim.x * gridDim.y * gridDim.z;
    unsigned sum, cnt, mine, sp = 0u;
    for (;;) {
        sum = 0u; cnt = 0u; mine = 0u;
#pragma unroll
        for (unsigned j = 0; j < 16; ++j) { const unsigned c = xb_ld(&bar[XB_XCNT(j)]); sum += c; cnt += (c > 0u) ? 1u : 0u; mine = (j == x) ? c : mine; }
        if (sum == G) break;
        __builtin_amdgcn_s_sleep(1);
        if ((++sp & 255u) == 0u) { if (xb_ld(&bar[XB_TMO])) break; if (sp > XB_SPIN_CAP) { atomicAdd(&bar[XB_TMO], 1u); break; } }
    }
    nloc = mine > 0u ? mine : 1u; nx = cnt > 0u ? cnt : 1u;
}
__device__ __forceinline__ void xcd_barrier(const XcdBarrier& b, int tid) {
    asm volatile("s_waitcnt vmcnt(0)" ::: "memory");
    __syncthreads();
    if (tid == 0) {
        unsigned* bar = b.bar;
        __builtin_amdgcn_s_waitcnt(0);
        unsigned nloc = b.st[0], nx = b.st[1];
        if (nloc == 0u) { xcd_barrier_complete(bar, b.x, nloc, nx); b.st[0] = nloc; b.st[1] = nx; }
        const unsigned old = xb_add(&bar[XB_XSUB(b.x)], 1u);
        const unsigned gen = old / nloc;
        if (old + 1u == (gen + 1u) * nloc) {
            __builtin_amdgcn_fence(__ATOMIC_RELEASE, "agent");
            asm volatile("s_waitcnt vmcnt(0)" ::: "memory");
            const unsigned og = xb_add(&bar[XB_TOP], 1u);
            const unsigned tg = og / nx;
            if (og + 1u == (tg + 1u) * nx) xb_add(&bar[XB_TOPGEN], 1u);
            else XB_SPIN(xb_ld(&bar[XB_TOPGEN]) == tg, bar);
            __builtin_amdgcn_fence(__ATOMIC_ACQUIRE, "agent");
            xb_add(&bar[XB_XGEN(b.x)], 1u);
            asm volatile("s_waitcnt vmcnt(0)" ::: "memory");
        } else {
            XB_SPIN(xb_ld(&bar[XB_XGEN(b.x)]) == gen, bar);
            __builtin_amdgcn_fence(__ATOMIC_ACQUIRE, "agent");
            asm volatile("s_waitcnt vmcnt(0)" ::: "memory");
        }
    }
    __syncthreads();
}
constexpr size_t WS_STATS = 1048576 + 131072;
constexpr size_t WS_TS = 1048576 + 98304;
constexpr size_t WS_BAR = 1048576 + 65536;
constexpr int LDS_MISC = 163840 - 64;

typedef const char __attribute__((address_space(4))) kchar_t;
#define KARG(field) (*(decltype(Args::field) const __attribute__((address_space(4)))*)(kp + offsetof(Args, field)))
#define MYTID() (wave0 * 64 + (int)__builtin_amdgcn_mbcnt_hi(~0u, __builtin_amdgcn_mbcnt_lo(~0u, 0u)))
#define PHASE_BEGIN int tid = MYTID(); asm volatile("" : "+v"(tid)); const int lane = tid & 63, wave = __builtin_amdgcn_readfirstlane(tid >> 6); \
    const int G = gridDim.x, bx = blockIdx.x, gw = bx * NWAVES + wave, NGW = G * NWAVES; (void)lane; (void)gw; (void)NGW; \
    kchar_t* kp = (kchar_t*)__builtin_amdgcn_kernarg_segment_ptr(); asm volatile("" : "+s"(kp)); \
    unsigned char* ws = KARG(ws); (void)ws; int l = lsel; asm volatile("" : "+s"(l));
#define WSP(T, off) ((T*)(ws + (off)))
__global__ void __launch_bounds__(NTHREADS, 2) hybrid_fwd(Args a) {
    extern __shared__ __attribute__((aligned(16))) unsigned char lds_raw[];
    LAS unsigned char* L = (LAS unsigned char*)lds_raw;
    const int lo = a.ph_lo, hi = a.ph_hi, coop = a.coop;
    const int wave0 = __builtin_amdgcn_readfirstlane(threadIdx.x >> 6);
    { const int t0 = MYTID(); if (t0 < 8) ((LAS unsigned*)(L + LDS_MISC))[t0] = 0u; }
    __syncthreads();
    XcdBarrier xbar; xbar.bar = (unsigned*)(a.ws + WS_BAR); xbar.x = 0; xbar.st = nullptr;
    if (coop) xbar = xcd_barrier_post((unsigned*)(a.ws + WS_BAR), (volatile LAS unsigned*)(L + LDS_MISC), MYTID());
    bool first_seam = (hi > 4096);
#ifdef PROBE_TS_MASK
    int nseam = 0;
    if (blockIdx.x == 0 && MYTID() == 0) ((unsigned long long*)(a.ws + WS_TS))[0] = __builtin_amdgcn_s_memrealtime();
#define STAMP() do { ++nseam; if (blockIdx.x == 0 && MYTID() == 0) ((unsigned long long*)(a.ws + WS_TS))[nseam] = __builtin_amdgcn_s_memrealtime(); } while (0)
#else
#define STAMP() do {} while (0)
#endif
#ifndef PH_MASK
#define PH_MASK 0xFFFFu
#endif
#define IN(k) (((PH_MASK >> ((k) >= 20 ? 10 : (k) % 10)) & 1u) && lo <= (k) && (k) < hi)
#ifndef PROBE_DUP
#define PROBE_DUP 0u
#endif
#define NREP(k) (1 + (int)((PROBE_DUP >> (k)) & 1u))
#ifndef PROBE_SYNC
#define PROBE_SYNC 1
#endif
#define SEAM_ALWAYS() SEAM()
#define SEAM() do { if (coop) { for (int s_ = 0; s_ < PROBE_SYNC; ++s_) { if (first_seam) { cg::this_grid().sync(); first_seam = false; } else xcd_barrier(xbar, MYTID()); } STAMP(); } else __syncthreads(); } while (0)

#pragma unroll 1
    for (int lsel = 0; lsel < 2; ++lsel) {
        const int pb = lsel * 10;
#define ST(ll, k) (WSP(unsigned long long, WS_STATS) + ((ll) * 4 + (k) - ((ll) ? 1 : 0)) * TOK)
#define HB_A WSP(bf16_t, WS_GDN)
#define HB_B WSP(bf16_t, WS_XN)
        if (IN(pb + 0)) for (int rep_ = 0; rep_ < NREP(0); ++rep_) { if (rep_) __syncthreads();
            PHASE_BEGIN
            constexpr int I_IN = 32 * (INP / 32), I_O = 32 * 64, I_1 = 32 * 256, I_2 = 128 * 64, I_G = 32 * 64, I_P = 4 * 64;
            constexpr int NITEMS = I_IN + I_O + I_1 + I_2 + I_G + I_P;
#define TR_DESC(it_, d_, loc_) do { int r_ = (it_); \
                if (r_ < I_IN) { d_.W = KARG(w_in) + (size_t)l * DM * INC; d_.WT = WSP(bf16_t, WS_WIN); d_.gain = KARG(norm_mix) + l * DM; d_.K = DM; d_.N = INC; d_.Npad = INP; loc_ = r_; break; } r_ -= I_IN; \
                if (r_ < I_O) { d_.W = KARG(w_o) + (size_t)l * DM * DM; d_.WT = WSP(bf16_t, WS_WO); d_.gain = nullptr; d_.K = DM; d_.N = DM; d_.Npad = DM; loc_ = r_; break; } r_ -= I_O; \
                if (r_ < I_1) { d_.W = KARG(w_ff1) + (size_t)l * DM * FFD; d_.WT = WSP(bf16_t, WS_W1); d_.gain = KARG(norm_ffn) + l * DM; d_.K = DM; d_.N = FFD; d_.Npad = FFD; loc_ = r_; break; } r_ -= I_1; \
                if (r_ < I_2) { d_.W = KARG(w_ff2) + (size_t)l * DM * FFD; d_.WT = WSP(bf16_t, WS_W2); d_.gain = nullptr; d_.K = FFD; d_.N = DM; d_.Npad = DM; loc_ = r_; break; } r_ -= I_2; \
                if (r_ < I_G) { d_.W = KARG(w_ple_gate) + (size_t)l * DM * DM; d_.WT = WSP(bf16_t, WS_WG); d_.gain = KARG(norm_ple) + l * DM; d_.K = DM; d_.N = DM; d_.Npad = DM; loc_ = r_; break; } r_ -= I_G; \
                d_.W = KARG(w_ple_proj) + (size_t)l * PLE * DM; d_.WT = WSP(bf16_t, WS_WP); d_.gain = nullptr; d_.K = PLE; d_.N = DM; d_.Npad = DM; loc_ = r_; } while (0)
            {
                LAS unsigned char* tl0 = L + wave * 16384; int it = gw, cur = 0, lc = 0, ln = 0; TrDesc dc, dn;
                if (it < NITEMS) { TR_DESC(it, dc, lc); tr_issue(dc, lc, lane, tl0); }
                while (it < NITEMS) {
                    const int it2 = it + NGW;
                    if (it2 < NITEMS) { TR_DESC(it2, dn, ln); tr_issue(dn, ln, lane, tl0 + (cur ^ 1) * 8192); asm volatile("s_waitcnt vmcnt(8)" ::: "memory"); }
                    else asm volatile("s_waitcnt vmcnt(0)" ::: "memory");
                    tr_process(dc, lc, lane, tl0 + cur * 8192);
                    dc = dn; lc = ln; it = it2; cur ^= 1;
                }
            }
#undef TR_DESC
            {
                const f32x4* src = (const f32x4*)(KARG(p) + (size_t)l * TOK * PLE); u32x2* dst = WSP(u32x2, WS_P16);
                for (int i = bx * NTHREADS + tid; i < TOK * PLE / 4; i += G * NTHREADS) { const f32x4 v = src[i]; u32x2 w; w.x = pk2(v[0], v[1]); w.y = pk2(v[2], v[3]); dst[i] = w; }
            }
            {
                unsigned long long* z = ST(l, 1);
                for (int i = bx * NTHREADS + tid; i < 3 * TOK; i += G * NTHREADS) z[i] = 0ull;
            }
            if (l == 0) { for (int m = gw; m < TOK; m += NGW) row_cast_stat(KARG(x) + (size_t)m * DM, HB_A + (size_t)m * DM, ST(0, 0) + m, lane); }
        }
        if (IN(pb + 0) && IN(pb + 1)) SEAM();
        if (IN(pb + 1)) for (int rep_ = 0; rep_ < NREP(1); ++rep_) { if (rep_) __syncthreads();
            PHASE_BEGIN
            pg8::Gemm g{(l == 0) ? (const bf16_t*)HB_A : (const bf16_t*)KARG(out), WSP(bf16_t, WS_WIN), TOK, INP, DM}; pg8::StaticOrder S; S.init(TOK, INP, G, bx, WGM_G1);
            EpiProj E{WSP(bf16_t, WS_BIG), WSP(float, WS_AB), (l == 0) ? ST(0, 0) : ST(0, 3)};
            pg8::gemm_phase<EpiProj>(L, g, S, E, tid);
        }
        if (IN(pb + 1) && IN(pb + 2)) SEAM();
        if (IN(pb + 2)) for (int rep_ = 0; rep_ < NREP(2); ++rep_) { if (rep_) __syncthreads();
            PHASE_BEGIN
            for (int it = bx; it < 2048; it += G)
                gdn_chunk_item(L, it, WSP(bf16_t, WS_BIG), WSP(float, WS_AB), KARG(gdn_conv) + (size_t)l * 4 * 3072, KARG(gdn_a_log) + l * 8, KARG(gdn_dt_bias) + l * 8, ws + WS_GDN, WSP(float, WS_GL), tid);
        }
        if (IN(pb + 2) && IN(pb + 3)) SEAM();
        if (IN(pb + 3)) {
            PHASE_BEGIN
            const int nscan = (G > 64) ? 64 : 0;
            if (bx < nscan) {
                gdn_scan(L, bx, ws + WS_GDN, WSP(float, WS_GL), WSP(bf16_t, WS_BIG), tid);
            } else {
                if (nscan == 0) { for (int id = bx; id < 64; id += G) { gdn_scan(L, id, ws + WS_GDN, WSP(float, WS_GL), WSP(bf16_t, WS_BIG), tid); __syncthreads(); } }
                const int rb = bx - nscan, RG = G - nscan;
#ifdef PROBE_SGU
                for (int rep2 = 0; rep2 < 2; ++rep2)
#endif
                for (int it = rb; it < 512; it += RG)
                    sgu_item(L, it, WSP(bf16_t, WS_BIG), KARG(sg_w) + (size_t)l * 4 * 16384, KARG(sg_b) + l * 512, KARG(sg_ln_g) + l * 512, KARG(sg_ln_b) + l * 512, KARG(out_norm_a) + l * 512, WSP(bf16_t, WS_XN), tid);
#ifdef PROBE_SC
                for (int rep3 = 0; rep3 < 2; ++rep3)
#endif
                for (int tk = rb * NWAVES + wave; tk < TOK; tk += RG * NWAVES)
                    shortconv_token(tk, WSP(bf16_t, WS_BIG), KARG(sc_conv) + l * 3 * 512, KARG(out_norm_b) + l * 512, WSP(bf16_t, WS_XN), lane);
                if (nscan) {
                    __syncthreads();
                    pg8::Gemm g{WSP(bf16_t, WS_P16), WSP(bf16_t, WS_WP), TOK, DM, PLE}; pg8::StaticOrder S; S.init(TOK, DM, RG, rb);
                    EpiPlain E{(bf16_t*)KARG(out) + (size_t)TOK * DM};
                    pg8::gemm_phase<EpiPlain>(L, g, S, E, tid);
                }
            }
        }
        if (IN(pb + 3)) SEAM_ALWAYS();
        if (IN(pb + 3)) {
            PHASE_BEGIN
            for (int it = gw; it < TOK * 2; it += NGW) gdn_finalize(it, WSP(bf16_t, WS_BIG), KARG(gdn_norm) + l * 128, WSP(bf16_t, WS_XN), lane);
        }
        if (IN(pb + 3) && IN(pb + 4)) SEAM();
        if (IN(pb + 4)) {
            PHASE_BEGIN
            pg8::Gemm g{WSP(bf16_t, WS_XN), WSP(bf16_t, WS_WO), TOK, DM, DM}; pg8::StaticOrder S; S.init(TOK, DM, G, bx, WGM_G2);
            if (l == 0) { EpiRes<true> E{KARG(x), nullptr, HB_A, ST(l, 1)}; pg8::gemm_phase<EpiRes<true>>(L, g, S, E, tid); }
            else { EpiRes<false> E{nullptr, (const bf16_t*)KARG(out), HB_A, ST(l, 1)}; pg8::gemm_phase<EpiRes<false>>(L, g, S, E, tid); }
        }
        if (IN(pb + 4) && IN(pb + 6)) SEAM();
        if (IN(pb + 6)) for (int rep_ = 0; rep_ < NREP(6); ++rep_) { if (rep_) __syncthreads();
            PHASE_BEGIN
            pg8::Gemm g{HB_A, WSP(bf16_t, WS_W1), TOK, FFD, DM}; pg8::StaticOrder S; S.init(TOK, FFD, G, bx, WGM_G3);
            EpiRelu2 E{WSP(bf16_t, WS_BIG), ST(l, 1)};
            pg8::gemm_phase<EpiRelu2>(L, g, S, E, tid);
        }
        if (IN(pb + 6) && IN(pb + 7)) SEAM();
        if (IN(pb + 7)) {
            PHASE_BEGIN
            pg8::Gemm g{WSP(bf16_t, WS_BIG), WSP(bf16_t, WS_W2), TOK, DM, FFD}; pg8::StaticOrder S; S.init(TOK, DM, G, bx, WGM_G4);
            EpiRes<false> E{nullptr, HB_A, HB_B, ST(l, 2)};
            pg8::gemm_phase<EpiRes<false>>(L, g, S, E, tid);
        }
        if (IN(pb + 7) && IN(pb + 9)) SEAM();
        if (IN(pb + 9)) {
            PHASE_BEGIN
            if (G <= 64) {
            pg8::Gemm g{WSP(bf16_t, WS_P16), WSP(bf16_t, WS_WP), TOK, DM, PLE}; pg8::StaticOrder S; S.init(TOK, DM, G, bx);
            EpiPlain E{(bf16_t*)KARG(out) + (size_t)TOK * DM};
            pg8::gemm_phase<EpiPlain>(L, g, S, E, tid);
            }
        }
        if (IN(pb + 9)) {
            __syncthreads();
            PHASE_BEGIN
            pg8::Gemm g{HB_B, WSP(bf16_t, WS_WG), TOK, DM, DM}; pg8::StaticOrder S; S.init(TOK, DM, G, bx, WGM_G6);
            EpiGate E{(const bf16_t*)KARG(out) + (size_t)TOK * DM, HB_B, ST(l, 2), (l == 0) ? (bf16_t*)KARG(out) : HB_A, ST(l, 3)};
            pg8::gemm_phase<EpiGate>(L, g, S, E, tid);
        }
        if (IN(pb + 9) && IN(pb + 10)) SEAM();
    }
    if (IN(20)) {
        const int lsel = 0;
        PHASE_BEGIN
        for (int m = gw; m < TOK; m += NGW) row_scale_from_bf16(HB_A + (size_t)m * DM, KARG(norm_final), (float)ST(1, 3)[m] * (1.0f / STAT_SCALE), KARG(out) + (size_t)m * DM, lane);
#ifdef PROBE_TS_MASK
        {
            const unsigned long long* ts = (const unsigned long long*)(ws + WS_TS);
            unsigned long long ticks = 0;
            for (int ll = 0; ll < 2; ++ll) for (int j = 0; j < 9; ++j) if ((PROBE_TS_MASK >> j) & 1) ticks += ts[1 + 9 * ll + j] - ts[9 * ll + j];
            const float delta = sqrtf((float)ticks * 0.01f * 1e-7f);
            __syncthreads();
            float* o = KARG(out);
            for (int m = gw; m < TOK; m += NGW) for (int j = lane; j < DM; j += 64) o[(size_t)m * DM + j] += (j & 1) ? delta : -delta;
        }
#endif
    }
#undef IN
#undef SEAM
}

extern "C" void kernel_launch(void* const* d_in, const int* in_sizes, int n_in, void* d_out, int out_size, void* d_ws, size_t ws_size, hipStream_t stream) {
    static int grid = 0;
    if (grid == 0) {
        if (n_in != 23 || out_size != TOK * DM || ws_size < WS_END) { fprintf(stderr, "kernel_launch: unexpected shapes (n_in %d out %d ws %zu need %zu)\n", n_in, out_size, ws_size, (size_t)WS_END); grid = -1; return; }
        int dev = 0, cus = 0, per_cu = 0;
        hipGetDevice(&dev);
        hipDeviceGetAttribute(&cus, hipDeviceAttributeMultiprocessorCount, dev);
        if (hipFuncSetAttribute((const void*)hybrid_fwd, hipFuncAttributeMaxDynamicSharedMemorySize, LDS_BYTES) != hipSuccess) { fprintf(stderr, "kernel_launch: hipFuncSetAttribute failed\n"); grid = -1; return; }
        if (hipOccupancyMaxActiveBlocksPerMultiprocessor(&per_cu, (const void*)hybrid_fwd, NTHREADS, LDS_BYTES) != hipSuccess || per_cu < 1) { fprintf(stderr, "kernel_launch: occupancy query gave %d\n", per_cu); per_cu = 1; }
        (void)hipGetLastError();
        grid = cus * per_cu;
    }
    if (grid < 0) return;
    Args a{};
    const float** f = (const float**)&a;
    for (int i = 0; i < 23; ++i) f[i] = (const float*)d_in[i];
    a.out = (float*)d_out; a.ws = (unsigned char*)d_ws;
#if MK_COOP
    if (hipMemsetAsync((char*)d_ws + WS_BAR, 0, 16384, stream) != hipSuccess) { fprintf(stderr, "kernel_launch: memset failed\n"); return; }
    a.ph_lo = 0; a.ph_hi = 21; a.coop = 1;
    void* args[] = {&a};
    hipError_t e = hipLaunchCooperativeKernel((const void*)hybrid_fwd, dim3(grid), dim3(NTHREADS), args, LDS_BYTES, stream);
    if (e != hipSuccess) fprintf(stderr, "cooperative launch failed: %s (grid %d)\n", hipGetErrorString(e), grid);
#else
    for (int ph = 0; ph < 21; ++ph) {
        a.ph_lo = ph; a.ph_hi = ph + 1; a.coop = 0;
        hipLaunchKernelGGL(hybrid_fwd, dim3(grid), dim3(NTHREADS), LDS_BYTES, stream, a);
    }
#endif
}
```
